# Optimizing an MI355X kernel written in HIP

```python
import jax, jax.numpy as jnp
from jax import lax
import numpy as np

D_MODEL = 4096
BATCH = 1
SEQ = 8192
DEPTH = 1
DEC_BATCH = 16
DEC_SEQ = 32
PAST_LEN = 2048

CHUNK = 64
POOL_WIDTH = D_MODEL // 2
POOL_WINDOWS = (2, 4, 8, 16)
POOL_GROUP = POOL_WIDTH // len(POOL_WINDOWS)
POOL_HIST = max(POOL_WINDOWS) - 1
ATTN_WIDTH = D_MODEL - POOL_WIDTH
HEAD_DIM = 128
N_HEADS = ATTN_WIDTH // HEAD_DIM
PROJ_WIDTH = POOL_WIDTH + 3 * ATTN_WIDTH + N_HEADS
D_FF = 4 * D_MODEL
Q_BLOCK = 128
NORM_EPS = 1e-6
ATTN_SCALE = HEAD_DIM ** -0.5
MASK_VALUE = -1e30
FORGET_BIAS_INIT = 2.0

kernel_name = 'hymba_pool_fox_stream_step'


def rms_norm(x, g):
    xf = x.astype(jnp.float32)
    y = xf * lax.rsqrt(jnp.mean(xf * xf, axis=-1, keepdims=True) + NORM_EPS)
    return (y * g.astype(jnp.float32)).astype(x.dtype)


def pool_mixer(u, hist, pos, w_pool, pool_scale):
    B, S, _ = u.shape
    ext = jnp.concatenate([hist.astype(u.dtype), u], axis=1)
    extf = ext.astype(jnp.float32)
    csum = jnp.concatenate([jnp.zeros((B, 1, POOL_WIDTH), jnp.float32),
                            lax.cumsum(extf, axis=1)], axis=1)
    end = csum[:, POOL_HIST + 1:]
    cur = extf[:, POOL_HIST:]
    outs = []
    for g, w in enumerate(POOL_WINDOWS):
        lo, hi = g * POOL_GROUP, (g + 1) * POOL_GROUP
        start = csum[:, POOL_HIST + 1 - w:POOL_HIST + 1 - w + S, lo:hi]
        cnt = jnp.minimum(pos + 1, w).astype(jnp.float32)[None, :, None]
        d = (end[..., lo:hi] - start) / cnt - cur[..., lo:hi]
        outs.append(jnp.einsum('bsc,cd->bsd', d, w_pool[g].astype(jnp.float32)))
    out = jnp.concatenate(outs, axis=-1) * pool_scale.astype(jnp.float32)
    return out.astype(u.dtype), ext[:, -POOL_HIST:]


def fox_block(q, k, v, cq, ck, qpos, kpos):
    s = jnp.einsum('bqhd,bkhd->bhqk', q, k).astype(jnp.float32) * ATTN_SCALE
    s = s + (jnp.swapaxes(cq, 1, 2)[..., :, None] - jnp.swapaxes(ck, 1, 2)[..., None, :])
    s = jnp.where(kpos[None, :] <= qpos[:, None], s, MASK_VALUE)
    p = jax.nn.softmax(s, axis=-1)
    return jnp.einsum('bhqk,bkhd->bqhd', p.astype(v.dtype), v)


def layer(x, pool_hist, past_k, past_v, past_logf, attn_norm_g, w_in, b_f, q_norm_g, k_norm_g,
          w_pool, pool_scale, w_out, mlp_norm_g, w_up, w_down):
    B, S, _ = x.shape
    P = past_k.shape[1]
    pos = jnp.arange(P, P + S)
    kpos = jnp.arange(P + S)
    h = rms_norm(x, attn_norm_g)
    proj = jnp.einsum('bsd,de->bse', h, w_in)
    a0 = POOL_WIDTH
    u = proj[..., :a0]
    q = proj[..., a0:a0 + ATTN_WIDTH].reshape(B, S, N_HEADS, HEAD_DIM)
    k = proj[..., a0 + ATTN_WIDTH:a0 + 2 * ATTN_WIDTH].reshape(B, S, N_HEADS, HEAD_DIM)
    v = proj[..., a0 + 2 * ATTN_WIDTH:a0 + 3 * ATTN_WIDTH].reshape(B, S, N_HEADS, HEAD_DIM)
    f_logit = proj[..., a0 + 3 * ATTN_WIDTH:]
    q = rms_norm(q, q_norm_g)
    k = rms_norm(k, k_norm_g)
    logf = jax.nn.log_sigmoid(f_logit.astype(jnp.float32) + b_f.astype(jnp.float32))
    pool_out, new_hist = pool_mixer(u, pool_hist, pos, w_pool, pool_scale)
    k_all = jnp.concatenate([past_k.astype(k.dtype), k], axis=1)
    v_all = jnp.concatenate([past_v.astype(v.dtype), v], axis=1)
    c_all = lax.cumsum(jnp.concatenate([past_logf.astype(jnp.float32), logf], axis=1), axis=1)
    cq = c_all[:, P:]
    if S <= Q_BLOCK:
        attn = fox_block(q, k_all, v_all, cq, c_all, pos, kpos)
    else:
        nb = S // Q_BLOCK
        qb = jnp.swapaxes(q.reshape(B, nb, Q_BLOCK, N_HEADS, HEAD_DIM), 0, 1)
        cqb = jnp.swapaxes(cq.reshape(B, nb, Q_BLOCK, N_HEADS), 0, 1)
        qposb = pos.reshape(nb, Q_BLOCK)
        outb = lax.map(lambda a: fox_block(a[0], k_all, v_all, a[1], c_all, a[2], kpos),
                       (qb, cqb, qposb))
        attn = jnp.swapaxes(outb, 0, 1).reshape(B, S, N_HEADS, HEAD_DIM)
    mixed = jnp.concatenate([pool_out, attn.reshape(B, S, ATTN_WIDTH).astype(pool_out.dtype)], axis=-1)
    x = x + jnp.einsum('bse,ed->bsd', mixed, w_out)
    h2 = rms_norm(x, mlp_norm_g)
    hid = jnp.square(jax.nn.relu(jnp.einsum('bsd,df->bsf', h2, w_up)))
    x = x + jnp.einsum('bsf,fd->bsd', hid, w_down)
    return x, k, v, logf, new_hist


def setup_inputs(seed: int = 0) -> dict:
    key = jax.random.key(seed)
    ks = jax.random.split(key, 20)
    n = jax.random.normal
    f32 = jnp.float32
    x_prompt = n(ks[0], (BATCH, SEQ, D_MODEL), f32)
    x_sample = n(ks[1], (DEC_BATCH, DEC_SEQ, D_MODEL), f32)
    cache_k = n(ks[2], (DEPTH, DEC_BATCH, PAST_LEN, N_HEADS, HEAD_DIM), f32)
    cache_v = n(ks[3], (DEPTH, DEC_BATCH, PAST_LEN, N_HEADS, HEAD_DIM), f32)
    cache_logf = jax.nn.log_sigmoid(FORGET_BIAS_INIT + n(ks[4], (DEPTH, DEC_BATCH, PAST_LEN, N_HEADS), f32))
    state_pool = n(ks[5], (DEPTH, DEC_BATCH, POOL_HIST, POOL_WIDTH), f32)
    attn_norm_g = 1.0 + 0.02 * n(ks[6], (DEPTH, D_MODEL), f32)
    w_in = n(ks[7], (DEPTH, D_MODEL, PROJ_WIDTH), f32) * D_MODEL ** -0.5
    b_f = FORGET_BIAS_INIT + 0.1 * n(ks[8], (DEPTH, N_HEADS), f32)
    q_norm_g = 1.0 + 0.02 * n(ks[9], (DEPTH, HEAD_DIM), f32)
    k_norm_g = 1.0 + 0.02 * n(ks[10], (DEPTH, HEAD_DIM), f32)
    w_pool = n(ks[11], (DEPTH, len(POOL_WINDOWS), POOL_GROUP, POOL_GROUP), f32) * POOL_GROUP ** -0.5
    pool_scale = 1.0 + 0.1 * n(ks[12], (DEPTH, POOL_WIDTH), f32)
    w_out = n(ks[13], (DEPTH, D_MODEL, D_MODEL), f32) * D_MODEL ** -0.5
    mlp_norm_g = 1.0 + 0.02 * n(ks[14], (DEPTH, D_MODEL), f32)
    w_up = n(ks[15], (DEPTH, D_MODEL, D_FF), f32) * D_MODEL ** -0.5
    w_down = n(ks[16], (DEPTH, D_FF, D_MODEL), f32) * D_FF ** -0.5
    return {'x_prompt': x_prompt, 'x_sample': x_sample, 'cache_k': cache_k, 'cache_v': cache_v,
            'cache_logf': cache_logf, 'state_pool': state_pool, 'attn_norm_g': attn_norm_g,
            'w_in': w_in, 'b_f': b_f, 'q_norm_g': q_norm_g, 'k_norm_g': k_norm_g, 'w_pool': w_pool,
            'pool_scale': pool_scale, 'w_out': w_out, 'mlp_norm_g': mlp_norm_g, 'w_up': w_up,
            'w_down': w_down}


def reference(x_prompt, x_sample, cache_k, cache_v, cache_logf, state_pool, attn_norm_g, w_in, b_f,
              q_norm_g, k_norm_g, w_pool, pool_scale, w_out, mlp_norm_g, w_up, w_down):
    yp, ys = x_prompt, x_sample
    bp = x_prompt.shape[0]
    empty_kv = jnp.zeros((bp, 0, N_HEADS, HEAD_DIM), x_prompt.dtype)
    empty_f = jnp.zeros((bp, 0, N_HEADS), jnp.float32)
    zero_hist = jnp.zeros((bp, POOL_HIST, POOL_WIDTH), x_prompt.dtype)
    kp, vp, fp, hp, ksm, vsm, fsm, hsm = [], [], [], [], [], [], [], []
    for l in range(DEPTH):
        wl = (attn_norm_g[l], w_in[l], b_f[l], q_norm_g[l], k_norm_g[l], w_pool[l], pool_scale[l],
              w_out[l], mlp_norm_g[l], w_up[l], w_down[l])
        yp, k1, v1, f1, h1 = layer(yp, zero_hist, empty_kv, empty_kv, empty_f, *wl)
        ys, k2, v2, f2, h2 = layer(ys, state_pool[l], cache_k[l], cache_v[l], cache_logf[l], *wl)
        kp.append(k1); vp.append(v1); fp.append(f1); hp.append(h1)
        ksm.append(k2); vsm.append(v2); fsm.append(f2); hsm.append(h2)
    return (yp, ys, jnp.stack(kp), jnp.stack(vp), jnp.stack(fp), jnp.stack(hp),
            jnp.stack(ksm), jnp.stack(vsm), jnp.stack(fsm), jnp.stack(hsm))
```

```cpp
#include <hip/hip_runtime.h>
#include <cstdio>
#include <cstdint>

#define LAS __attribute__((address_space(3)))
#define GAS __attribute__((address_space(1)))
typedef unsigned short bf16_t;
typedef short bf16x8 __attribute__((ext_vector_type(8)));
typedef short s16x4 __attribute__((ext_vector_type(4)));
typedef float f32x2 __attribute__((ext_vector_type(2)));
typedef float f32x4 __attribute__((ext_vector_type(4)));
typedef float f32x16 __attribute__((ext_vector_type(16)));
typedef unsigned u32x2 __attribute__((ext_vector_type(2)));
typedef unsigned u32x4 __attribute__((ext_vector_type(4)));

constexpr int DM = 4096, SEQ = 8192, DB = 16, DS = 32, PAST = 2048;
constexpr int MP = SEQ, MS = DB * DS, M = MP + MS;
constexpr int PW = 2048, AW = 2048, NH = 16, HD = 128, PH = 15, PG = 512;
constexpr int NPROJ = PW + 3 * AW + NH;
constexpr int NPROJ_PAD = 8448;
constexpr int PP = 8192;
constexpr int DFF = 16384;
constexpr float EPS = 1e-6f;
constexpr float QSCALE = 0.08838834764831845f * 1.4426950408889634f;
constexpr float LOG2E = 1.4426950408889634f;
constexpr float PRUNE_T = 40.0f;
constexpr size_t O_YP = 0, O_YS = (size_t)MP * DM, O_KP = O_YS + (size_t)MS * DM, O_VP = O_KP + (size_t)MP * AW, O_FP = O_VP + (size_t)MP * AW,
                 O_HP = O_FP + (size_t)MP * NH, O_KS = O_HP + (size_t)PH * PW, O_VS = O_KS + (size_t)MS * AW, O_FS = O_VS + (size_t)MS * AW,
                 O_HS = O_FS + (size_t)MS * NH, O_END = O_HS + (size_t)DB * PH * PW;
static_assert(O_END == 71964672, "output size");
constexpr size_t MiB = 1u << 20;
constexpr size_t WS_CTL = 0, CTL_ZERO_BYTES = 1 * MiB;
constexpr size_t WS_WI = 2 * MiB, WS_WP = 68 * MiB, WS_WO = 70 * MiB, WS_WU = 102 * MiB, WS_WD = 230 * MiB, WS_XN = 358 * MiB, WS_PROJ = 426 * MiB,
                 WS_FL = 562 * MiB, WS_CB = 563 * MiB, WS_CS = 564 * MiB, WS_DP = 567 * MiB, WS_MIX = 601 * MiB, WS_X1G = 669 * MiB, WS_HID = 737 * MiB, WS_END = 1009 * MiB;
static_assert(WS_WI + (size_t)NPROJ_PAD * DM * 2 <= WS_WP && WS_XN + (size_t)M * DM * 2 <= WS_PROJ && WS_PROJ + (size_t)M * PP * 2 <= WS_FL && WS_CS + (size_t)DB * NH * 2080 * 4 <= WS_DP &&
              WS_DP + (size_t)M * PW * 2 <= WS_MIX && WS_HID + (size_t)M * DFF * 2 <= WS_END, "ws map");
constexpr int CW_BAR = 4096;
constexpr int CW_JLO = 16384;
constexpr int CW_RSS = 32768;
static_assert((CW_RSS + M) * 4 <= (int)CTL_ZERO_BYTES, "ctl");
constexpr int LDS_BYTES = 147456;
constexpr int MISC_OFF = 131072 + 320;

__device__ __forceinline__ int fresh_lane() { int l; asm volatile("v_mbcnt_lo_u32_b32 %0, -1, 0\n\tv_mbcnt_hi_u32_b32 %0, -1, %0" : "=v"(l)); return l; }
template <int X> __device__ __forceinline__ float swz_xor(float v) { return __int_as_float(__builtin_amdgcn_ds_swizzle(__float_as_int(v), (X << 10) | 0x1f)); }
__device__ __forceinline__ float half_sum(float v) { auto rr = __builtin_amdgcn_permlane32_swap(__float_as_uint(v), __float_as_uint(v), false, false); return __uint_as_float(rr[0]) + __uint_as_float(rr[1]); }
__device__ __forceinline__ float half_max(float v) { auto rr = __builtin_amdgcn_permlane32_swap(__float_as_uint(v), __float_as_uint(v), false, false); return fmaxf(__uint_as_float(rr[0]), __uint_as_float(rr[1])); }
__device__ __forceinline__ unsigned cvt_pk_bf16(float lo, float hi) { unsigned r; asm volatile("v_cvt_pk_bf16_f32 %0, %1, %2" : "=v"(r) : "v"(lo), "v"(hi)); return r; }
__device__ __forceinline__ float bf_lo(unsigned w) { return __uint_as_float(w << 16); }
__device__ __forceinline__ float bf_hi(unsigned w) { return __uint_as_float(w & 0xffff0000u); }
__device__ __forceinline__ bf16x8 pack8(f32x4 a, f32x4 b) { u32x4 w = {cvt_pk_bf16(a[0], a[1]), cvt_pk_bf16(a[2], a[3]), cvt_pk_bf16(b[0], b[1]), cvt_pk_bf16(b[2], b[3])}; return __builtin_bit_cast(bf16x8, w); }

namespace pg8 {
constexpr int BM = 256, BK = 64, HALF = 128, HTB = HALF * BK * 2, STAGE_BYTES = 8 * HTB, NXCD = 8, WGM = 8;
__host__ __device__ __forceinline__ int lds_byte(int r, int c) { const int st = (r >> 4) * 2 + (c >> 5), rr = r & 15, cc = c & 31, ob = rr * 64 + cc * 2; return st * 1024 + (ob ^ (((ob >> 9) & 1) << 5)); }
__host__ __device__ __forceinline__ void stage_rc(int b, int& R, int& C) { const int st = b / 1024, sb = b % 1024, swz = sb ^ (((sb >> 9) & 1) << 5); R = (st >> 1) * 16 + swz / 64; C = (st & 1) * 32 + (swz % 64) / 2; }
__host__ __device__ __forceinline__ int perm32(int rho) { const int n = rho >> 4, i = rho & 15; return 8 * (i >> 2) + 4 * n + (i & 3); }
struct Unit { int pm, pn; };
struct Gemm { const bf16_t* A; const bf16_t* Bt; int M, N, K, lda, adiv; };
struct StaticOrder {
    int nM, nN, nwg, G, c;
    __host__ __device__ void init(int M_, int N_, int G_, int c_) { nM = M_ / BM; nN = N_ / BM; nwg = nM * nN; G = G_; c = c_; }
    __host__ __device__ bool next(int i, Unit& u) const {
        const long L = (long)i * G + c; if (L >= nwg) return false;
        int wgid = (int)L; { const int q = nwg / NXCD, r = nwg % NXCD, xcd = wgid % NXCD, off = wgid / NXCD; wgid = (xcd < r ? xcd * (q + 1) : r * (q + 1) + (xcd - r) * q) + off; }
        const int nig = WGM * nN, gid = wgid / nig, fm = gid * WGM, gsz = (nM - fm) < WGM ? (nM - fm) : WGM;
        u.pm = fm + ((wgid % nig) % gsz); u.pn = (wgid % nig) / gsz; return true;
    }
};
template <class Epi, class Sched>
__device__ __forceinline__ void gemm_phase(LAS unsigned char* lds, const Gemm g, const Sched& S, const Epi& E, const int wid) {
    const int lane = fresh_lane(), tid = wid * 64 + lane, wr = wid >> 2, wc = wid & 3, fr = lane & 15, fq = lane >> 4;
    const int K = g.K, nt = K / BK;
    unsigned voffA[2], voffB[2];
#pragma unroll
    for (int i = 0; i < 2; ++i) { int R, C; stage_rc(tid * 16 + i * 8192, R, C); const int Rb = (R & ~31) + perm32(R & 31);
        voffA[i] = (unsigned)(R * g.lda + C) * 2u; voffB[i] = (unsigned)(Rb * K + C) * 2u; }
    const size_t kstep = (size_t)(BK * 2);
    const size_t hstepA = (size_t)HALF * g.lda * 2, hstepB = (size_t)HALF * K * 2;
    const size_t tstepA = 2 * hstepA, tstepB = 2 * hstepB;
    const unsigned ldsw = (unsigned)wid * 1024u;
    const int aoff = lds_byte(wr * 64 + fr, fq * 8), boff = lds_byte(wc * 32 + fr, fq * 8);
#define PG8_SA(b, h) (((b) * 2 + (h)) * HTB)
#define PG8_SB(b, h) ((4 + (b) * 2 + (h)) * HTB)
#define PG8_STAGE(bufoff, gbase, voff) do { _Pragma("unroll") for (int _i = 0; _i < 2; ++_i) \
        __builtin_amdgcn_global_load_lds((const unsigned*)((const char*)(gbase) + (voff)[_i]), (LAS unsigned*)(lds + (bufoff) + ldsw + _i * 8192), 16, 0, 0); } while (0)
#define PG8_LDA(dst, b, h) do { _Pragma("unroll") for (int m = 0; m < 4; ++m) _Pragma("unroll") for (int k = 0; k < 2; ++k) dst[m][k] = *(const LAS bf16x8*)(lds + PG8_SA(b, h) + aoff + m * 2048 + k * 1024); } while (0)
#define PG8_LDB(dst, b, h) do { _Pragma("unroll") for (int n = 0; n < 2; ++n) _Pragma("unroll") for (int k = 0; k < 2; ++k) dst[n][k] = *(const LAS bf16x8*)(lds + PG8_SB(b, h) + boff + n * 2048 + k * 1024); } while (0)
#define PG8_MMA(ai, bj, At, Bt) do { __builtin_amdgcn_s_setprio(1); _Pragma("unroll") for (int m = 0; m < 4; ++m) _Pragma("unroll") for (int n = 0; n < 2; ++n) _Pragma("unroll") for (int k = 0; k < 2; ++k) \
        acc[ai][bj][m][n] = __builtin_amdgcn_mfma_f32_16x16x32_bf16(Bt[n][k], At[m][k], acc[ai][bj][m][n], 0, 0, 0); __builtin_amdgcn_s_setprio(0); } while (0)
#define PG8_WAIT_V(n) asm volatile("s_waitcnt vmcnt(" #n ")" ::: "memory")
#define PG8_WAIT_L(n) asm volatile("s_waitcnt lgkmcnt(" #n ")" ::: "memory")
#define PG8_BAR __builtin_amdgcn_s_barrier()
#define PG8_SCHED __builtin_amdgcn_sched_barrier(0)
    Unit cur, nxt; int ui = 0;
    if (!S.next(0, cur)) return;
    f32x4 acc[2][2][4][2];
#pragma unroll
    for (int a = 0; a < 2; ++a)
#pragma unroll
        for (int b = 0; b < 2; ++b)
#pragma unroll
            for (int m = 0; m < 4; ++m)
#pragma unroll
                for (int n = 0; n < 2; ++n) acc[a][b][m][n] = (f32x4){0.f, 0.f, 0.f, 0.f};
    bf16x8 At[4][2], B0[2][2], B1[2][2];
    const char* cA = (const char*)g.A + (size_t)cur.pm * tstepA + (size_t)(cur.pn / g.adiv) * K * 2; const char* cB = (const char*)g.Bt + (size_t)cur.pn * tstepB;
    PG8_STAGE(PG8_SB(0, 0), cB, voffB); PG8_STAGE(PG8_SB(0, 1), cB + hstepB, voffB); PG8_STAGE(PG8_SA(0, 0), cA, voffA); PG8_STAGE(PG8_SA(0, 1), cA + hstepA, voffA);
    if (wr == 1) PG8_BAR;
    PG8_WAIT_V(2); PG8_BAR;
    PG8_STAGE(PG8_SB(1, 0), cB + kstep, voffB); PG8_STAGE(PG8_SA(1, 0), cA + kstep, voffA); PG8_STAGE(PG8_SB(1, 1), cB + hstepB + kstep, voffB);
    PG8_WAIT_V(6); PG8_BAR;
    for (;;) {
        const bool has_next = S.next(ui + 1, nxt);
        const char* nA = has_next ? (const char*)g.A + (size_t)nxt.pm * tstepA + (size_t)(nxt.pn / g.adiv) * K * 2 : cA; const char* nB = has_next ? (const char*)g.Bt + (size_t)nxt.pn * tstepB : cB;
        for (int t = 0; t < nt; t += 2) {
            const bool last = (t == nt - 2);
            const char* a1 = cA + (size_t)(t + 1) * kstep;
            const char* a2 = last ? nA : cA + (size_t)(t + 2) * kstep; const char* b2 = last ? nB : cB + (size_t)(t + 2) * kstep;
            const char* a3 = a2 + kstep; const char* b3 = b2 + kstep;
            PG8_LDB(B0, 0, 0); PG8_LDB(B1, 0, 1); PG8_SCHED; PG8_LDA(At, 0, 0); PG8_STAGE(PG8_SA(1, 1), a1 + hstepA, voffA);
            PG8_WAIT_V(8); PG8_WAIT_L(0); PG8_BAR; PG8_MMA(0, 0, At, B0); PG8_MMA(0, 1, At, B1); PG8_BAR; PG8_SCHED;
            PG8_LDA(At, 0, 1); PG8_STAGE(PG8_SB(0, 0), b2, voffB); PG8_STAGE(PG8_SB(0, 1), b2 + hstepB, voffB); PG8_STAGE(PG8_SA(0, 0), a2, voffA);
            PG8_WAIT_V(8); PG8_WAIT_L(0); PG8_BAR; PG8_MMA(1, 0, At, B0); PG8_MMA(1, 1, At, B1); PG8_BAR; PG8_SCHED;
            PG8_LDB(B0, 1, 0); PG8_LDB(B1, 1, 1); PG8_SCHED; PG8_LDA(At, 1, 0); PG8_STAGE(PG8_SA(0, 1), a2 + hstepA, voffA);
            PG8_WAIT_V(8); PG8_WAIT_L(0); PG8_BAR; PG8_MMA(0, 0, At, B0); PG8_MMA(0, 1, At, B1); PG8_BAR; PG8_SCHED;
            PG8_LDA(At, 1, 1); PG8_STAGE(PG8_SB(1, 0), b3, voffB); PG8_STAGE(PG8_SB(1, 1), b3 + hstepB, voffB); PG8_STAGE(PG8_SA(1, 0), a3, voffA);
            PG8_WAIT_V(8); PG8_WAIT_L(0); PG8_BAR; PG8_MMA(1, 0, At, B0); PG8_MMA(1, 1, At, B1); PG8_BAR; PG8_SCHED;
        }
        if (wr == 0) PG8_BAR;
        E(acc, cur, wr, wc, fr, fq);
        if (!has_next) break;
#pragma unroll
        for (int a = 0; a < 2; ++a)
#pragma unroll
            for (int b = 0; b < 2; ++b)
#pragma unroll
                for (int m = 0; m < 4; ++m)
#pragma unroll
                    for (int n = 0; n < 2; ++n) acc[a][b][m][n] = (f32x4){0.f, 0.f, 0.f, 0.f};
        cur = nxt; cA = nA; cB = nB; ++ui;
        if (wr == 1) PG8_BAR;
    }
    PG8_WAIT_V(0);
    PG8_BAR;
#undef PG8_SA
#undef PG8_SB
#undef PG8_STAGE
#undef PG8_LDA
#undef PG8_LDB
#undef PG8_MMA
#undef PG8_WAIT_V
#undef PG8_WAIT_L
#undef PG8_BAR
#undef PG8_SCHED
}

struct EpiProj {
    bf16_t* O; float* FL;
    __device__ __forceinline__ void operator()(const f32x4 (&acc)[2][2][4][2], const Unit& u, int wr, int wc, int fr, int fq) const {
        const int row0 = u.pm * BM + wr * 64 + fr;
        if (u.pn < 32) {
            const int col0 = u.pn * BM + wc * 32 + 8 * fq;
#pragma unroll
            for (int ai = 0; ai < 2; ++ai)
#pragma unroll
                for (int m = 0; m < 4; ++m) { bf16_t* rowp = O + (size_t)(row0 + ai * HALF + m * 16) * PP + col0;
#pragma unroll
                    for (int bj = 0; bj < 2; ++bj) { const f32x4 v0 = acc[ai][bj][m][0], v1 = acc[ai][bj][m][1];
                        u32x4 w; w.x = cvt_pk_bf16(v0[0], v0[1]); w.y = cvt_pk_bf16(v0[2], v0[3]); w.z = cvt_pk_bf16(v1[0], v1[1]); w.w = cvt_pk_bf16(v1[2], v1[3]);
                        *(u32x4*)(rowp + bj * HALF) = w; } }
        } else if (wc == 0 && fq < 2) {
#pragma unroll
            for (int ai = 0; ai < 2; ++ai)
#pragma unroll
                for (int m = 0; m < 4; ++m) { float* rowp = FL + (size_t)(row0 + ai * HALF + m * 16) * NH + 8 * fq;
                    *(f32x4*)rowp = acc[ai][0][m][0]; *(f32x4*)(rowp + 4) = acc[ai][0][m][1]; }
        }
    }
};
struct EpiPool {
    bf16_t* O; const float* scale;
    __device__ __forceinline__ void operator()(const f32x4 (&acc)[2][2][4][2], const Unit& u, int wr, int wc, int fr, int fq) const {
        const int row0 = u.pm * BM + wr * 64 + fr, col0 = u.pn * BM + wc * 32 + 8 * fq;
        f32x4 sv[2][2];
#pragma unroll
        for (int bj = 0; bj < 2; ++bj)
#pragma unroll
            for (int n = 0; n < 2; ++n) sv[bj][n] = *(const f32x4*)(scale + col0 + bj * HALF + 4 * n);
#pragma unroll
        for (int ai = 0; ai < 2; ++ai)
#pragma unroll
            for (int m = 0; m < 4; ++m) { bf16_t* rowp = O + (size_t)(row0 + ai * HALF + m * 16) * DM + col0;
#pragma unroll
                for (int bj = 0; bj < 2; ++bj) { const f32x4 v0 = acc[ai][bj][m][0] * sv[bj][0], v1 = acc[ai][bj][m][1] * sv[bj][1];
                    u32x4 w; w.x = cvt_pk_bf16(v0[0], v0[1]); w.y = cvt_pk_bf16(v0[2], v0[3]); w.z = cvt_pk_bf16(v1[0], v1[1]); w.w = cvt_pk_bf16(v1[2], v1[3]);
                    *(u32x4*)(rowp + bj * HALF) = w; } }
    }
};
struct EpiOut {
    const float* xp; const float* xs; float* Y; bf16_t* X1G; const float* g2; float* rowss;
    __device__ __forceinline__ void operator()(const f32x4 (&acc)[2][2][4][2], const Unit& u, int wr, int wc, int fr, int fq) const {
        const int row0 = u.pm * BM + wr * 64 + fr, col0 = u.pn * BM + wc * 32 + 8 * fq;
        const float* xin = (u.pm < MP / BM) ? xp : xs - (size_t)MP * DM;
        f32x4 gv[2][2];
#pragma unroll
        for (int bj = 0; bj < 2; ++bj)
#pragma unroll
            for (int n = 0; n < 2; ++n) gv[bj][n] = *(const f32x4*)(g2 + col0 + bj * HALF + 4 * n);
#pragma unroll
        for (int ai = 0; ai < 2; ++ai)
#pragma unroll
            for (int m = 0; m < 4; ++m) { const int row = row0 + ai * HALF + m * 16; const size_t off = (size_t)row * DM + col0; float ss = 0.f;
#pragma unroll
                for (int bj = 0; bj < 2; ++bj) {
                    const f32x4 v0 = *(const f32x4*)(xin + off + bj * HALF) + acc[ai][bj][m][0], v1 = *(const f32x4*)(xin + off + bj * HALF + 4) + acc[ai][bj][m][1];
                    *(f32x4*)(Y + off + bj * HALF) = v0; *(f32x4*)(Y + off + bj * HALF + 4) = v1;
                    ss += (v0[0] * v0[0] + v0[1] * v0[1]) + (v0[2] * v0[2] + v0[3] * v0[3]) + (v1[0] * v1[0] + v1[1] * v1[1]) + (v1[2] * v1[2] + v1[3] * v1[3]);
                    const f32x4 w0 = v0 * gv[bj][0], w1 = v1 * gv[bj][1];
                    u32x4 w; w.x = cvt_pk_bf16(w0[0], w0[1]); w.y = cvt_pk_bf16(w0[2], w0[3]); w.z = cvt_pk_bf16(w1[0], w1[1]); w.w = cvt_pk_bf16(w1[2], w1[3]);
                    *(u32x4*)(X1G + off + bj * HALF) = w; }
                ss += swz_xor<16>(ss); ss = half_sum(ss);
                if (fq == 0) __hip_atomic_fetch_add(rowss + row, ss, __ATOMIC_RELAXED, __HIP_MEMORY_SCOPE_AGENT);
                asm volatile("" ::: "memory"); }
    }
};
struct EpiUp {
    bf16_t* O; const float* rowss;
    __device__ __forceinline__ void operator()(const f32x4 (&acc)[2][2][4][2], const Unit& u, int wr, int wc, int fr, int fq) const {
        const int row0 = u.pm * BM + wr * 64 + fr, col0 = u.pn * BM + wc * 32 + 8 * fq;
#pragma unroll
        for (int ai = 0; ai < 2; ++ai)
#pragma unroll
            for (int m = 0; m < 4; ++m) { const int row = row0 + ai * HALF + m * 16; bf16_t* rowp = O + (size_t)row * DFF + col0;
                const float rs = __builtin_amdgcn_rsqf(rowss[row] * (1.0f / DM) + EPS);
#pragma unroll
                for (int bj = 0; bj < 2; ++bj) { f32x4 v0 = acc[ai][bj][m][0] * rs, v1 = acc[ai][bj][m][1] * rs;
#pragma unroll
                    for (int j = 0; j < 4; ++j) { v0[j] = fmaxf(v0[j], 0.f); v1[j] = fmaxf(v1[j], 0.f); }
                    v0 = v0 * v0; v1 = v1 * v1;
                    u32x4 w; w.x = cvt_pk_bf16(v0[0], v0[1]); w.y = cvt_pk_bf16(v0[2], v0[3]); w.z = cvt_pk_bf16(v1[0], v1[1]); w.w = cvt_pk_bf16(v1[2], v1[3]);
                    *(u32x4*)(rowp + bj * HALF) = w; } }
    }
};
struct EpiDown {
    float* Y;
    __device__ __forceinline__ void operator()(const f32x4 (&acc)[2][2][4][2], const Unit& u, int wr, int wc, int fr, int fq) const {
        const int row0 = u.pm * BM + wr * 64 + fr, col0 = u.pn * BM + wc * 32 + 8 * fq;
#pragma unroll
        for (int ai = 0; ai < 2; ++ai)
#pragma unroll
            for (int m = 0; m < 4; ++m) { float* rowp = Y + (size_t)(row0 + ai * HALF + m * 16) * DM + col0;
#pragma unroll
                for (int bj = 0; bj < 2; ++bj) {
                    const f32x4 v0 = *(const f32x4*)(rowp + bj * HALF) + acc[ai][bj][m][0], v1 = *(const f32x4*)(rowp + bj * HALF + 4) + acc[ai][bj][m][1];
                    *(f32x4*)(rowp + bj * HALF) = v0; *(f32x4*)(rowp + bj * HALF + 4) = v1; }
                asm volatile("" ::: "memory"); }
    }
};
}

namespace att {
constexpr int D = 128, NW = 8, QBLK = 32, KVBLK = 64, QB = NW * QBLK;
constexpr int SHM_V = KVBLK * D * 2, SHM_K = KVBLK * D * 2;
constexpr int OFF_K = 2 * SHM_V, OFF_WS = 2 * SHM_V + 2 * SHM_K, OFF_CB = OFF_WS + NW * 64 * 4, LDS_NEED = OFF_CB + 8192 * 4;
constexpr int PO = DM;
constexpr float THR2 = 8.f * LOG2E;
typedef LAS char* lptr;
#define KSWZ(row, colB) ((row) * 256 + ((colB) ^ (((row) & 7) << 4)))
#define SBAR() __builtin_amdgcn_sched_barrier(0)
__device__ __forceinline__ int v_st(int k, int c) { const int kk = (k & ~0xC) | ((k & 4) << 1) | ((k & 8) >> 1); return ((kk >> 3) * 4 + (c >> 5)) * 512 + ((kk & 7) * 32 + (c & 31)) * 2; }
__device__ __forceinline__ int v_rd_base(int lane) { return ((lane & 3) << 3) | (((lane >> 2) & 3) << 6) | (((lane >> 4) & 1) << 5) | (((lane >> 5) & 1) << 8); }
constexpr int v_rd_off(int d0, int ks, int half) { return d0 * 512 + ks * 4096 + half * 2048; }
__device__ __forceinline__ int crow(int r, int hi) { return (r & 3) + 8 * (r >> 2) + 4 * hi; }
__device__ __forceinline__ bf16x8 load8(const bf16_t* p) { return *reinterpret_cast<const bf16x8*>(p); }
__device__ __forceinline__ void mask_tile(f32x16& p0, f32x16& p1, int dq) {
    const float NEG = -__builtin_inff();
#pragma unroll
    for (int r = 0; r < 16; ++r) { const int c = (r & 3) + 8 * (r >> 2);
        if (dq - c < 0) p0[r] = NEG;
        if (dq - c - 32 < 0) p1[r] = NEG; }
}
__device__ __forceinline__ void partialSM(f32x16& p0, f32x16& p1, float& m_reg, float& mn, float& alpha) {
    float pmax = p0[0];
#pragma unroll
    for (int r = 1; r < 16; ++r) pmax = fmaxf(pmax, p0[r]);
#pragma unroll
    for (int r = 0; r < 16; ++r) pmax = fmaxf(pmax, p1[r]);
    { auto rr = __builtin_amdgcn_permlane32_swap(__float_as_uint(pmax), __float_as_uint(pmax), false, false);
      pmax = fmaxf(__uint_as_float(rr[0]), __uint_as_float(rr[1])); }
    if (__builtin_expect(__all((pmax - m_reg) <= THR2), 1)) { mn = m_reg; alpha = 1.f; }
    else { mn = fmaxf(m_reg, pmax); alpha = __builtin_amdgcn_exp2f(m_reg - mn); m_reg = mn; }
#pragma unroll
    for (int r = 0; r < 16; ++r) p0[r] = p0[r] - mn;
#pragma unroll
    for (int r = 0; r < 16; ++r) p1[r] = p1[r] - mn;
#pragma unroll
    for (int r = 0; r < 16; ++r) p0[r] = __builtin_amdgcn_exp2f(p0[r]);
}
__device__ __forceinline__ void finishSM(f32x16& p0, f32x16& p1, float alpha, float& l_reg, bf16x8& pa0, bf16x8& pa1, bf16x8& pa2, bf16x8& pa3) {
#pragma unroll
    for (int r = 0; r < 16; ++r) p1[r] = __builtin_amdgcn_exp2f(p1[r]);
    float ps = 0;
#pragma unroll
    for (int r = 0; r < 16; ++r) ps += p0[r];
#pragma unroll
    for (int r = 0; r < 16; ++r) ps += p1[r];
    { auto rr = __builtin_amdgcn_permlane32_swap(__float_as_uint(ps), __float_as_uint(ps), false, false);
      ps = __uint_as_float(rr[0]) + __uint_as_float(rr[1]); }
    l_reg = l_reg * alpha + ps;
#define PK4(P, B_, OUT) do { unsigned a0 = cvt_pk_bf16(P[B_+0], P[B_+1]), a1 = cvt_pk_bf16(P[B_+2], P[B_+3]);                          \
        unsigned b0 = cvt_pk_bf16(P[B_+4], P[B_+5]), b1 = cvt_pk_bf16(P[B_+6], P[B_+7]);                                             \
        auto r0 = __builtin_amdgcn_permlane32_swap(a0, b0, false, false); auto r1 = __builtin_amdgcn_permlane32_swap(a1, b1, false, false); \
        u32x4 w = {r0[0], r1[0], r0[1], r1[1]}; OUT = __builtin_bit_cast(bf16x8, w); } while (0)
    PK4(p0, 0, pa0); PK4(p0, 8, pa1); PK4(p1, 0, pa2); PK4(p1, 8, pa3);
}
template <int KB>
__device__ __forceinline__ void qkt(f32x16& p0, f32x16& p1, lptr K_lds, const LAS float* cbt, int r32, int hi, const bf16x8* qr) {
#pragma unroll
    for (int i = 0; i < 4; ++i) { const f32x4 b0 = *(const LAS f32x4*)(cbt + 8 * i), b1 = *(const LAS f32x4*)(cbt + 32 + 8 * i);
        p0[4 * i] = b0[0]; p0[4 * i + 1] = b0[1]; p0[4 * i + 2] = b0[2]; p0[4 * i + 3] = b0[3];
        p1[4 * i] = b1[0]; p1[4 * i + 1] = b1[1]; p1[4 * i + 2] = b1[2]; p1[4 * i + 3] = b1[3]; }
    lptr kb[4];
#pragma unroll
    for (int dd = 0; dd < 4; ++dd) kb[dd] = K_lds + KB * SHM_K + KSWZ(r32, (dd * 16 + hi * 8) * 2);
#pragma unroll
    for (int d0 = 0; d0 < 8; ++d0) { lptr a = kb[d0 & 3] + (d0 >> 2) * 128;
        bf16x8 b0 = *reinterpret_cast<const LAS bf16x8*>(a);
        bf16x8 b1 = *reinterpret_cast<const LAS bf16x8*>(a + 32 * 256);
        p0 = __builtin_amdgcn_mfma_f32_32x32x16_bf16(b0, qr[d0], p0, 0, 0, 0);
        p1 = __builtin_amdgcn_mfma_f32_32x32x16_bf16(b1, qr[d0], p1, 0, 0, 0); }
}
template <int VB>
__device__ __forceinline__ void pv_tile(f32x16* o, int vb0, bf16x8 pa0, bf16x8 pa1, bf16x8 pa2, bf16x8 pa3) {
#define TRRD(dst, off) asm volatile("ds_read_b64_tr_b16 %0, %1 offset:%2" : "=&v"(dst) : "v"(vb0), "i"(off) : "memory")
#define PV_D0(d0) do { s16x4 l0, l1, l2, l3, h0, h1, h2, h3; constexpr int b_ = VB * SHM_V + v_rd_off(d0, 0, 0);   \
        TRRD(l0, b_); TRRD(h0, b_ + 2048); TRRD(l1, b_ + 4096); TRRD(h1, b_ + 6144); TRRD(l2, b_ + 8192); TRRD(h2, b_ + 10240); TRRD(l3, b_ + 12288); TRRD(h3, b_ + 14336); \
        asm volatile("s_waitcnt lgkmcnt(0)" ::: "memory"); SBAR();   \
        o[d0] = __builtin_amdgcn_mfma_f32_32x32x16_bf16(pa0, (bf16x8){l0[0], l0[1], l0[2], l0[3], h0[0], h0[1], h0[2], h0[3]}, o[d0], 0, 0, 0);   \
        o[d0] = __builtin_amdgcn_mfma_f32_32x32x16_bf16(pa1, (bf16x8){l1[0], l1[1], l1[2], l1[3], h1[0], h1[1], h1[2], h1[3]}, o[d0], 0, 0, 0);   \
        o[d0] = __builtin_amdgcn_mfma_f32_32x32x16_bf16(pa2, (bf16x8){l2[0], l2[1], l2[2], l2[3], h2[0], h2[1], h2[2], h2[3]}, o[d0], 0, 0, 0);   \
        o[d0] = __builtin_amdgcn_mfma_f32_32x32x16_bf16(pa3, (bf16x8){l3[0], l3[1], l3[2], l3[3], h3[0], h3[1], h3[2], h3[3]}, o[d0], 0, 0, 0); } while (0)
    PV_D0(0); PV_D0(1); PV_D0(2); PV_D0(3);
#undef PV_D0
#undef TRRD
}
struct Blk { int h, qb, jlo; };
struct Seam { bf16x8 qr[8]; bf16x8 st_v0, st_v1, st_k0, st_k1; };
#define VMW() asm volatile("s_waitcnt vmcnt(0)" ::: "memory")
#define VMWN(n) asm volatile("s_waitcnt vmcnt(%0)" :: "i"(n) : "memory")
#define SLOAD_H(hh, k0) do { const bf16_t* kt_ = PROJ + (size_t)(k0) * PP + (PW + AW) + (hh) * HD;                                         \
                         S.st_v0 = load8(kt_ + AW + toff); S.st_v1 = load8(kt_ + AW + 32 * PP + toff);                                      \
                         S.st_k0 = load8(kt_ + toff); S.st_k1 = load8(kt_ + 32 * PP + toff); } while (0)
#define QLOAD(hh, qq) do { const bf16_t* qt_ = PROJ + (size_t)((qq) * QB + wid * QBLK) * PP + PW + (hh) * HD;                                \
                         _Pragma("unroll") for (int d0 = 0; d0 < 8; ++d0) S.qr[d0] = load8(qt_ + qoff + d0 * 16); } while (0)
#define SWRITE_HK(bf) do { *(LAS bf16x8*)(K_lds + (bf) * SHM_K + kws) = S.st_k0; *(LAS bf16x8*)(K_lds + (bf) * SHM_K + kws + 32 * 256) = S.st_k1; } while (0)
#define SWRITE_HV(bf) do { *(LAS bf16x8*)(V_lds + (bf) * SHM_V + vst0) = S.st_v0; *(LAS bf16x8*)(V_lds + (bf) * SHM_V + vst1) = S.st_v1; } while (0)
#define SWRITE_H(bf) do { SWRITE_HV(bf); SWRITE_HK(bf); } while (0)
__device__ __forceinline__ void attn_prime(const Blk cur, const bf16_t* PROJ, lptr lds, Seam& S, const int wid) {
    const int lane = fresh_lane(), tid = wid * 64 + lane, r32 = lane & 31, hi = lane >> 5;
    const int sr = tid >> 4, sc = (tid & 15) * 8, kws = KSWZ(sr, sc * 2); lptr K_lds = lds + OFF_K;
    const unsigned toff = (unsigned)(sr * PP + sc), qoff = (unsigned)(r32 * PP + hi * 8);
    QLOAD(cur.h, cur.qb);
    SLOAD_H(cur.h, cur.jlo * KVBLK); VMW(); SWRITE_HK(0);
    __syncthreads();
}
__device__ __forceinline__ void attn_block(const Blk cur, const Blk nxt, const bf16_t* PROJ, bf16_t* MIX, const float* CB, lptr lds, Seam& S, const int wid) {
    const int lane = fresh_lane(), tid = wid * 64 + lane, r32 = lane & 31, hi = lane >> 5;
    const int P0 = cur.qb * QB, j_lo = cur.jlo, j_hi = (P0 + QB - 1) / KVBLK + 1;
    const int NT = j_hi - j_lo;
    const int qlo = P0 + wid * QBLK, qm = qlo + r32 - 4 * hi;
    lptr V_lds = lds; lptr K_lds = lds + OFF_K;
    LAS float* ws = (LAS float*)(lds + OFF_WS) + wid * 64; LAS float* li_l = ws; LAS float* al_l = ws + 32;
    LAS float* cb = (LAS float*)(lds + OFF_CB);
    float m_reg = -1e30f, l_reg = 0; f32x16 o[4] = {};
    const int sr = tid >> 4, sc = (tid & 15) * 8, vst0 = v_st(sr, sc), vst1 = v_st(32 + sr, sc), kws = KSWZ(sr, sc * 2);
    const unsigned toff = (unsigned)(sr * PP + sc);
    const int vb0 = (int)(unsigned)(size_t)V_lds + v_rd_base(lane);
    const int hh = cur.h;
    { const float* c2 = CB + (size_t)hh * SEQ; const float cref = c2[P0]; const float* csrc = c2 + j_lo * KVBLK;
      for (int i = tid * 4; i < NT * KVBLK; i += 2048) { const f32x4 c = *(const f32x4*)(csrc + i); *(LAS f32x4*)(cb + i) = cref - c; }
      __syncthreads(); }
    const LAS float* cbl = cb + 4 * hi;
#define RESC(a) do { if (__any((a) < 1.f)) { if (hi == 0) al_l[r32] = (a); asm volatile("s_waitcnt lgkmcnt(0)" ::: "memory");              \
                     _Pragma("unroll") for (int d_ = 0; d_ < 4; ++d_) _Pragma("unroll") for (int r = 0; r < 16; ++r) o[d_][r] *= al_l[crow(r, hi)]; } } while (0)
#define KBASE(t) ((j_lo + (t)) * KVBLK)
#define MASKT(P0_, P1_, t) do { const int kb_ = KBASE(t); if (kb_ + KVBLK - 1 > qlo) mask_tile(P0_, P1_, qm - kb_); } while (0)
#define SEAM_K0() do { VMWN(8); SWRITE_HK(0); SBAR(); } while (0)
    f32x16 pA0, pA1, pB0, pB1; float mnA, mnB, alA, alB; bf16x8 pa0, pa1, pa2, pa3;
    SWRITE_HV(0); SBAR();
    if (NT > 1) { SLOAD_H(hh, KBASE(1)); }
    SBAR(); qkt<0>(pA0, pA1, K_lds, cbl, r32, hi, S.qr);
    MASKT(pA0, pA1, 0); partialSM(pA0, pA1, m_reg, mnA, alA);
    if (NT > 1) { VMW(); SWRITE_H(1); }
    __syncthreads();
#define HALF_STEP(PX0, PX1, mnX, alX, PY0, PY1, alY, t, KB, VB, SB) do {                                                      \
        SBAR(); qkt<KB>(PX0, PX1, K_lds, cbl + (t) * KVBLK, r32, hi, S.qr);                                                   \
        finishSM(PY0, PY1, alY, l_reg, pa0, pa1, pa2, pa3); SBAR();                                                           \
        if ((t) + 1 < NT) { SLOAD_H(hh, KBASE((t) + 1)); SBAR(); }                                                            \
        pv_tile<VB>(o, vb0, pa0, pa1, pa2, pa3); MASKT(PX0, PX1, (t)); partialSM(PX0, PX1, m_reg, mnX, alX);                   \
        __syncthreads();                                                                                                      \
        if ((t) + 1 < NT) { VMW(); SWRITE_H(SB); }                                                                            \
        RESC(alX); __syncthreads(); } while (0)
    for (int t = 1; t + 1 < NT; t += 2) {
        HALF_STEP(pB0, pB1, mnB, alB, pA0, pA1, alA, t, 1, 0, 0);
        HALF_STEP(pA0, pA1, mnA, alA, pB0, pB1, alB, t + 1, 0, 1, 1);
    }
    const bool even = (NT & 1) == 0;
    const int l2_ = fresh_lane(), r32b_ = l2_ & 31, hib_ = l2_ >> 5, qmb_ = qlo + r32b_ - 4 * hib_;
    { const int r32 = r32b_, hi = hib_, qm = qmb_;
    if (even) { SBAR(); qkt<1>(pB0, pB1, K_lds, cbl + (NT - 1) * KVBLK, r32, hi, S.qr); SBAR(); }
    SLOAD_H(nxt.h, nxt.jlo * KVBLK); SBAR();
    { const unsigned qoff = (unsigned)(r32 * PP + hi * 8); QLOAD(nxt.h, nxt.qb); }
    SBAR();
    finishSM(pA0, pA1, alA, l_reg, pa0, pa1, pa2, pa3); SBAR();
    pv_tile<0>(o, vb0, pa0, pa1, pa2, pa3);
    if (even) { MASKT(pB0, pB1, NT - 1); partialSM(pB0, pB1, m_reg, mnB, alB); __syncthreads(); RESC(alB);
        finishSM(pB0, pB1, alB, l_reg, pa0, pa1, pa2, pa3); SBAR(); pv_tile<1>(o, vb0, pa0, pa1, pa2, pa3); }
    SBAR(); SEAM_K0();
    if (hi == 0) li_l[r32] = l_reg; asm volatile("s_waitcnt lgkmcnt(0)" ::: "memory");
    bf16_t* Ow = MIX + (size_t)(P0 + wid * QBLK) * PO + PW + hh * HD;
    const unsigned ooff = (unsigned)(4 * hi * PO + r32);
#pragma unroll
    for (int r = 0; r < 16; ++r) { const float rl = __builtin_amdgcn_rcpf(li_l[crow(r, hi)]);
#pragma unroll
        for (int d0 = 0; d0 < 4; ++d0) { const float v = o[d0][r] * rl;
            const float vn = swz_xor<1>(v);
            if ((r32 & 1) == 0) *(unsigned*)(Ow + ooff + (unsigned)(((r & 3) + 8 * (r >> 2)) * PO + d0 * 32)) = cvt_pk_bf16(v, vn); } }
    }
    __syncthreads();
#undef RESC
#undef KBASE
#undef MASKT
#undef SEAM_K0
#undef HALF_STEP
}
#undef QLOAD
#undef SLOAD_H
#undef SWRITE_HK
#undef SWRITE_HV
#undef SWRITE_H

constexpr int SOFF_ML = 0, SOFF_OT = 2048, SLDS_NEED = 2048 + 8 * 64 * 32 * 4;
template <bool NEWK>
__device__ __forceinline__ void samp_chunk(const float* Kc, const float* Vc, const bf16_t* Kn, const bf16_t* Vn, const float* bias, const bf16x8* qr,
                                           float& m_reg, float& l_reg, f32x16* oT, int r32, int hi) {
    f32x16 s;
#pragma unroll
    for (int i = 0; i < 4; ++i) { const f32x4 b = *(const f32x4*)(bias + 8 * i + 4 * hi); s[4 * i] = b[0]; s[4 * i + 1] = b[1]; s[4 * i + 2] = b[2]; s[4 * i + 3] = b[3]; }
    bf16x8 kf[8];
    if constexpr (NEWK) {
#pragma unroll
        for (int d0 = 0; d0 < 8; ++d0) kf[d0] = load8(Kn + (size_t)r32 * PP + d0 * 16 + hi * 8);
    } else {
        const float* kp = Kc + (size_t)r32 * (NH * HD) + hi * 8;
#pragma unroll
        for (int d0 = 0; d0 < 8; ++d0) kf[d0] = pack8(*(const f32x4*)(kp + d0 * 16), *(const f32x4*)(kp + d0 * 16 + 4));
    }
#pragma unroll
    for (int d0 = 0; d0 < 8; ++d0) s = __builtin_amdgcn_mfma_f32_32x32x16_bf16(kf[d0], qr[d0], s, 0, 0, 0);
    if constexpr (NEWK) {
        const float NEG = -__builtin_inff();
#pragma unroll
        for (int r = 0; r < 16; ++r) if (crow(r, hi) > r32) s[r] = NEG;
    }
    float pmax = s[0];
#pragma unroll
    for (int r = 1; r < 16; ++r) pmax = fmaxf(pmax, s[r]);
    { auto rr = __builtin_amdgcn_permlane32_swap(__float_as_uint(pmax), __float_as_uint(pmax), false, false); pmax = fmaxf(__uint_as_float(rr[0]), __uint_as_float(rr[1])); }
    const float mn = fmaxf(m_reg, pmax), alpha = __builtin_amdgcn_exp2f(m_reg - mn); m_reg = mn;
    float ps = 0.f;
#pragma unroll
    for (int r = 0; r < 16; ++r) { s[r] = __builtin_amdgcn_exp2f(s[r] - mn); ps += s[r]; }
    { auto rr = __builtin_amdgcn_permlane32_swap(__float_as_uint(ps), __float_as_uint(ps), false, false); ps = __uint_as_float(rr[0]) + __uint_as_float(rr[1]); }
    l_reg = l_reg * alpha + ps;
    if (__any(alpha < 1.f)) {
#pragma unroll
        for (int d0 = 0; d0 < 4; ++d0) oT[d0] = oT[d0] * alpha;
    }
    bf16x8 pa0, pa1; PK4(s, 0, pa0); PK4(s, 8, pa1);
#pragma unroll
    for (int ks = 0; ks < 2; ++ks) {
#pragma unroll
        for (int d0 = 0; d0 < 4; ++d0) {
            bf16x8 vf;
            if constexpr (NEWK) {
                const bf16_t* vp = Vn + (size_t)(16 * ks + 8 * hi) * PP + 32 * d0 + r32;
                short e[8];
#pragma unroll
                for (int j = 0; j < 8; ++j) e[j] = (short)vp[(size_t)j * PP];
                vf = (bf16x8){e[0], e[1], e[2], e[3], e[4], e[5], e[6], e[7]};
            } else {
                const float* vp = Vc + (size_t)(16 * ks + 8 * hi) * (NH * HD) + 32 * d0 + r32;
                float e[8];
#pragma unroll
                for (int j = 0; j < 8; ++j) e[j] = vp[(size_t)j * (NH * HD)];
                vf = pack8((f32x4){e[0], e[1], e[2], e[3]}, (f32x4){e[4], e[5], e[6], e[7]});
            }
            oT[d0] = __builtin_amdgcn_mfma_f32_32x32x16_bf16(vf, ks == 0 ? pa0 : pa1, oT[d0], 0, 0, 0);
        }
    }
}
#undef PK4
__device__ __forceinline__ void samp_unit(int b, int h, const bf16_t* PROJ, const float* cache_k, const float* cache_v, const float* CS, bf16_t* MIX, lptr lds, const int wid) {
    const int lane = fresh_lane(), tid = wid * 64 + lane, r32 = lane & 31, hi = lane >> 5;
    const bf16_t* Qp = PROJ + (size_t)(MP + b * DS) * PP + PW + h * HD;
    const bf16_t* Kn = PROJ + (size_t)(MP + b * DS) * PP + PW + AW + h * HD;
    const bf16_t* Vn = PROJ + (size_t)(MP + b * DS) * PP + PW + 2 * AW + h * HD;
    const float* bias = CS + (size_t)(b * NH + h) * 2080;
    bf16x8 qr[8];
#pragma unroll
    for (int d0 = 0; d0 < 8; ++d0) qr[d0] = load8(Qp + (size_t)r32 * PP + d0 * 16 + hi * 8);
    float m_reg = -1e30f, l_reg = 0.f; f32x16 oT[4] = {};
    const float* Kc = cache_k + ((size_t)(b * PAST + wid * 256) * NH + h) * HD;
    const float* Vc = cache_v + ((size_t)(b * PAST + wid * 256) * NH + h) * HD;
    for (int c = 0; c < 8; ++c)
        samp_chunk<false>(Kc + (size_t)c * 32 * NH * HD, Vc + (size_t)c * 32 * NH * HD, nullptr, nullptr, bias + wid * 256 + c * 32, qr, m_reg, l_reg, oT, r32, hi);
    if (wid == 7) samp_chunk<true>(nullptr, nullptr, Kn, Vn, bias + PAST, qr, m_reg, l_reg, oT, r32, hi);
    LAS float* ML = (LAS float*)(lds + SOFF_ML); LAS float* OT = (LAS float*)(lds + SOFF_OT);
    if (hi == 0) { ML[(wid * 32 + r32) * 2] = m_reg; ML[(wid * 32 + r32) * 2 + 1] = l_reg; }
    __syncthreads();
    float Mx = -1e30f;
#pragma unroll
    for (int w = 0; w < 8; ++w) Mx = fmaxf(Mx, ML[(w * 32 + r32) * 2]);
    float L = 0.f;
#pragma unroll
    for (int w = 0; w < 8; ++w) L += ML[(w * 32 + r32) * 2 + 1] * __builtin_amdgcn_exp2f(ML[(w * 32 + r32) * 2] - Mx);
    const float f = __builtin_amdgcn_exp2f(m_reg - Mx) / L;
#pragma unroll
    for (int half = 0; half < 2; ++half) {
#pragma unroll
        for (int dd = 0; dd < 2; ++dd)
#pragma unroll
            for (int r = 0; r < 16; ++r) OT[(wid * 64 + dd * 32 + crow(r, hi)) * 32 + r32] = oT[half * 2 + dd][r] * f;
        __syncthreads();
        float acc4[4] = {0.f, 0.f, 0.f, 0.f};
#pragma unroll
        for (int w = 0; w < 8; ++w)
#pragma unroll
            for (int j = 0; j < 4; ++j) acc4[j] += OT[(w * 64 + 8 * wid + 4 * hi + j) * 32 + r32];
        u32x2 o2; o2.x = cvt_pk_bf16(acc4[0], acc4[1]); o2.y = cvt_pk_bf16(acc4[2], acc4[3]);
        *(u32x2*)(MIX + (size_t)(MP + b * DS + r32) * DM + PW + h * HD + half * 64 + 8 * wid + 4 * hi) = o2;
        __syncthreads();
    }
}
}

#define XB_TMO      128
#define XB_XCNT(j)  (256  + 64 * (j))
#define XB_XSUB(j)  (1280 + 64 * (j))
#define XB_XGEN(j)  (2304 + 64 * (j))
#define XB_TOP      3328
#define XB_TOPGEN   3392
#define XCD_BAR_WORDS 3456
#define XB_SPIN_CAP (1u << 22)
__device__ __forceinline__ unsigned xb_ld(unsigned* p)              { return __hip_atomic_load(p, __ATOMIC_RELAXED, __HIP_MEMORY_SCOPE_AGENT); }
__device__ __forceinline__ unsigned xb_add(unsigned* p, unsigned v) { return __hip_atomic_fetch_add(p, v, __ATOMIC_RELAXED, __HIP_MEMORY_SCOPE_AGENT); }
__device__ __forceinline__ unsigned xb_xcc_id() { return (unsigned)__builtin_amdgcn_s_getreg((3 << 11) | 20) & 0xFu; }
#define XB_SPIN(cond, bar) do { unsigned _sp = 0; while (cond) { __builtin_amdgcn_s_sleep(1); \
    if ((++_sp & 255u) == 0u) { if (xb_ld(&(bar)[XB_TMO])) break; if (_sp > XB_SPIN_CAP) { atomicAdd(&(bar)[XB_TMO], 1u); break; } } } } while (0)
struct XcdBarrier { unsigned* bar; unsigned x; volatile LAS unsigned* st; };
__device__ __forceinline__ XcdBarrier xcd_barrier_post(unsigned* bar, volatile LAS unsigned* st, bool leader) {
    XcdBarrier b; b.bar = bar; b.x = xb_xcc_id(); b.st = st;
    if (leader) (void)xb_add(&bar[XB_XCNT(b.x)], 1u);
    return b;
}
__device__ __forceinline__ void xcd_barrier_complete(unsigned* bar, unsigned x, unsigned& nloc, unsigned& nx) {
    const unsigned G = gridDim.x * gridDim.y * gridDim.z;
    unsigned sum, cnt, mine, sp = 0u;
    for (;;) {
        sum = 0u; cnt = 0u; mine = 0u;
#pragma unroll
        for (unsigned j = 0; j < 16; ++j) { const unsigned c = xb_ld(&bar[XB_XCNT(j)]); sum += c; cnt += (c > 0u) ? 1u : 0u; mine = (j == x) ? c : mine; }
        if (sum == G) break;
        __builtin_amdgcn_s_sleep(1);
        if ((++sp & 255u) == 0u) { if (xb_ld(&bar[XB_TMO])) break; if (sp > XB_SPIN_CAP) { atomicAdd(&bar[XB_TMO], 1u); break; } }
    }
    nloc = mine > 0u ? mine : 1u; nx = cnt > 0u ? cnt : 1u;
}
__device__ __forceinline__ void xcd_barrier(const XcdBarrier& b, bool leader) {
    asm volatile("s_waitcnt vmcnt(0)" ::: "memory");
    __syncthreads();
    if (leader) {
        unsigned* bar = b.bar;
        __builtin_amdgcn_s_waitcnt(0);
        unsigned nloc = b.st[0], nx = b.st[1];
        if (nloc == 0u) { xcd_barrier_complete(bar, b.x, nloc, nx); b.st[0] = nloc; b.st[1] = nx; }
        const unsigned old = xb_add(&bar[XB_XSUB(b.x)], 1u);
        const unsigned gen = old / nloc;
        if (old + 1u == (gen + 1u) * nloc) {
            __builtin_amdgcn_fence(__ATOMIC_RELEASE, "agent");
            asm volatile("s_waitcnt vmcnt(0)" ::: "memory");
            const unsigned og = xb_add(&bar[XB_TOP], 1u);
            const unsigned tg = og / nx;
            if (og + 1u == (tg + 1u) * nx) xb_add(&bar[XB_TOPGEN], 1u);
            else XB_SPIN(xb_ld(&bar[XB_TOPGEN]) == tg, bar);
            __builtin_amdgcn_fence(__ATOMIC_ACQUIRE, "agent");
            xb_add(&bar[XB_XGEN(b.x)], 1u);
            asm volatile("s_waitcnt vmcnt(0)" ::: "memory");
        } else {
            XB_SPIN(xb_ld(&bar[XB_XGEN(b.x)]) == gen, bar);
            __builtin_amdgcn_fence(__ATOMIC_ACQUIRE, "agent");
            asm volatile("s_waitcnt vmcnt(0)" ::: "memory");
        }
    }
    __syncthreads();
}

#ifndef PHASES
#define PHASES 0xfff
#endif
struct Args {
    const float *x_prompt, *x_sample, *cache_k, *cache_v, *cache_logf, *state_pool, *attn_norm_g, *w_in, *b_f, *q_norm_g, *k_norm_g, *w_pool, *pool_scale, *w_out, *mlp_norm_g, *w_up, *w_down;
    float* out; unsigned char* ws;
};
__device__ __forceinline__ float wave_sum(float v) { v += swz_xor<1>(v); v += swz_xor<2>(v); v += swz_xor<4>(v); v += swz_xor<8>(v); v += swz_xor<16>(v); return half_sum(v); }
__device__ __forceinline__ float wave_max(float v) { v = fmaxf(v, swz_xor<1>(v)); v = fmaxf(v, swz_xor<2>(v)); v = fmaxf(v, swz_xor<4>(v)); v = fmaxf(v, swz_xor<8>(v)); v = fmaxf(v, swz_xor<16>(v)); return half_max(v); }
__device__ __forceinline__ void p0_transpose_item(const float* W, int K, int N, bf16_t* WT, LAS float* scr, int kb, int nb, int lane) {
    const int k0 = 64 * kb, n0 = 32 * nb; const int nn = n0 + (lane & 31);
#pragma unroll 8
    for (int i = 0; i < 32; ++i) { const int kk = 2 * i + (lane >> 5); scr[kk * 33 + (lane & 31)] = nn < N ? W[(size_t)(k0 + kk) * N + nn] : 0.f; }
    asm volatile("s_waitcnt lgkmcnt(0)" ::: "memory");
    const int c = lane & 7;
#pragma unroll
    for (int j = 0; j < 4; ++j) { const int n = (lane >> 3) + 8 * j; const LAS float* s = scr + (8 * c) * 33 + n;
        u32x4 o; o.x = cvt_pk_bf16(s[0 * 33], s[1 * 33]); o.y = cvt_pk_bf16(s[2 * 33], s[3 * 33]); o.z = cvt_pk_bf16(s[4 * 33], s[5 * 33]); o.w = cvt_pk_bf16(s[6 * 33], s[7 * 33]);
        *(u32x4*)(WT + (size_t)(n0 + n) * K + k0 + 8 * c) = o; }
    asm volatile("s_waitcnt lgkmcnt(0)" ::: "memory");
}
__device__ __forceinline__ float log_sigmoid(float x) { return fminf(x, 0.f) - log1pf(__expf(-fabsf(x))); }

__global__ void __launch_bounds__(512, 2) hymba_fwd(Args a) {
    extern __shared__ __attribute__((aligned(16))) unsigned char lds_raw[];
    LAS unsigned char* lds = (LAS unsigned char*)lds_raw;
    volatile LAS unsigned* MISC = (volatile LAS unsigned*)(lds + MISC_OFF);
    const int wave = __builtin_amdgcn_readfirstlane((int)threadIdx.x >> 6);
    const int G = gridDim.x; const int bx = blockIdx.x; const int vcu = (G % 8 == 0) ? (bx % 8) * (G / 8) + bx / 8 : bx;
    unsigned char* ws = a.ws;
    unsigned* ctl = (unsigned*)(ws + WS_CTL);
    bf16_t* WI = (bf16_t*)(ws + WS_WI); bf16_t* WP = (bf16_t*)(ws + WS_WP); bf16_t* WO = (bf16_t*)(ws + WS_WO); bf16_t* WU = (bf16_t*)(ws + WS_WU); bf16_t* WD = (bf16_t*)(ws + WS_WD);
    bf16_t* XN = (bf16_t*)(ws + WS_XN); bf16_t* PROJ = (bf16_t*)(ws + WS_PROJ); float* FL = (float*)(ws + WS_FL); float* CB = (float*)(ws + WS_CB); float* CS = (float*)(ws + WS_CS);
    bf16_t* DP = (bf16_t*)(ws + WS_DP); bf16_t* MIX = (bf16_t*)(ws + WS_MIX); bf16_t* X1G = (bf16_t*)(ws + WS_X1G); bf16_t* HID = (bf16_t*)(ws + WS_HID);
    int* JLO = (int*)(ctl + CW_JLO); float* RSS = (float*)(ctl + CW_RSS);
    float* out = a.out;
    for (int u = wave * 64 + fresh_lane(); u < (LDS_BYTES - 131072) / 4; u += 512) ((LAS unsigned*)(lds + 131072))[u] = 0u;
    __syncthreads();
    XcdBarrier bar = xcd_barrier_post(ctl + CW_BAR, MISC + 8, wave == 0 && fresh_lane() == 0);
    const int gw = vcu * 8 + wave, NGW = G * 8;

    if constexpr (PHASES & 1) {
        const int lane = fresh_lane();
        LAS float* scr = (LAS float*)(lds + wave * 16384);
        constexpr int NB_I = NPROJ_PAD / 32, I_I = (DM / 64) * NB_I, I_P = 4 * (PG / 64) * (PG / 32), I_O = (DM / 64) * (DM / 32), I_U = (DM / 64) * (DFF / 32), I_D = (DFF / 64) * (DM / 32);
        constexpr int NITEMS = I_I + I_P + I_O + I_U + I_D;
        for (int it = gw; it < NITEMS; it += NGW) {
            int r = it;
            if (r < I_I) { p0_transpose_item(a.w_in, DM, NPROJ, WI, scr, r / NB_I, r % NB_I, lane); continue; } r -= I_I;
            if (r < I_P) { const int g = r / ((PG / 64) * (PG / 32)), q = r % ((PG / 64) * (PG / 32)); p0_transpose_item(a.w_pool + (size_t)g * PG * PG, PG, PG, WP + (size_t)g * PG * PG, scr, q / (PG / 32), q % (PG / 32), lane); continue; } r -= I_P;
            if (r < I_O) { p0_transpose_item(a.w_out, DM, DM, WO, scr, r / (DM / 32), r % (DM / 32), lane); continue; } r -= I_O;
            if (r < I_U) { p0_transpose_item(a.w_up, DM, DFF, WU, scr, r / (DFF / 32), r % (DFF / 32), lane); continue; } r -= I_U;
            p0_transpose_item(a.w_down, DFF, DM, WD, scr, r / (DM / 32), r % (DM / 32), lane);
        }
        for (int m = gw; m < M; m += NGW) {
            const float* xrow = (m < MP) ? a.x_prompt + (size_t)m * DM : a.x_sample + (size_t)(m - MP) * DM;
            f32x4 v[16]; float s = 0.f;
#pragma unroll
            for (int j = 0; j < 16; ++j) { v[j] = *(const f32x4*)(xrow + 256 * j + 4 * lane); s += (v[j][0] * v[j][0] + v[j][1] * v[j][1]) + (v[j][2] * v[j][2] + v[j][3] * v[j][3]); }
            const float rstd = __builtin_amdgcn_rsqf(wave_sum(s) * (1.0f / DM) + EPS);
#pragma unroll
            for (int j = 0; j < 16; ++j) { const f32x4 gg = *(const f32x4*)(a.attn_norm_g + 256 * j + 4 * lane); const f32x4 y = v[j] * rstd * gg;
                u32x2 o; o.x = cvt_pk_bf16(y[0], y[1]); o.y = cvt_pk_bf16(y[2], y[3]); *(u32x2*)(XN + (size_t)m * DM + 256 * j + 4 * lane) = o; }
        }
    }
    xcd_barrier(bar, wave == 0 && fresh_lane() == 0);

    if constexpr (PHASES & 2) {
        pg8::Gemm g{XN, WI, M, NPROJ_PAD, DM, DM, 1 << 30}; pg8::StaticOrder S; S.init(M, NPROJ_PAD, G, bx);
        pg8::EpiProj E{PROJ, FL};
        pg8::gemm_phase<pg8::EpiProj, pg8::StaticOrder>(lds, g, S, E, wave);
    }
    xcd_barrier(bar, wave == 0 && fresh_lane() == 0);

    if constexpr (PHASES & 4) {
        const int lane = fresh_lane(), tid = wave * 64 + lane;
        if (vcu < 16) {
            const int h = vcu; LAS float* cl = (LAS float*)lds; LAS double* tot = (LAS double*)(lds + 65536);
            const float bf = a.b_f[h]; float lf[16]; double run = 0.0;
#pragma unroll
            for (int j = 0; j < 16; ++j) lf[j] = log_sigmoid(FL[(size_t)(tid * 16 + j) * NH + h] + bf);
#pragma unroll
            for (int j = 0; j < 16; ++j) { out[O_FP + (size_t)(tid * 16 + j) * NH + h] = lf[j]; run += (double)lf[j]; }
            tot[tid] = run; __syncthreads();
            if (tid == 0) { double s = 0.0; for (int i = 0; i < 512; ++i) { const double t = tot[i]; tot[i] = s; s += t; } }
            __syncthreads();
            double c = tot[tid];
#pragma unroll
            for (int j = 0; j < 16; ++j) { c += (double)lf[j]; cl[tid * 16 + j] = (float)c; CB[(size_t)h * SEQ + tid * 16 + j] = (float)(c * (double)LOG2E); }
            __syncthreads();
            if (tid < 64) {
                float gq = fmaxf(fabsf(a.q_norm_g[tid]), fabsf(a.q_norm_g[tid + 64])), gk = fmaxf(fabsf(a.k_norm_g[tid]), fabsf(a.k_norm_g[tid + 64]));
                gq = wave_max(gq); gk = wave_max(gk);
                const float U = 11.3137085f * gq * gk; const float thr = -(2.f * U + PRUNE_T);
                if (tid < 32) { const int qb = tid; const float cP = cl[qb * 256]; int j = 0; while (j < 4 * qb && (cP - cl[64 * j + 63]) < thr) ++j; JLO[h * 32 + qb] = j; }
            }
            __syncthreads();
        } else if (vcu < 32) {
            const int b = vcu - 16, h = tid & 15, seg = tid >> 4; LAS double* tot = (LAS double*)(lds + 65536);
            const float* lsrc = a.cache_logf + ((size_t)b * PAST + seg * 64) * NH + h;
            double run = 0.0;
#pragma unroll 16
            for (int j = 0; j < 64; ++j) run += (double)lsrc[(size_t)j * NH];
            tot[tid] = run; __syncthreads();
            double c = 0.0; for (int s = 0; s < seg; ++s) c += tot[s * 16 + h];
            double ctot = 0.0; for (int s = 0; s < 32; ++s) ctot += tot[s * 16 + h];
            const float bf = a.b_f[h];
            const float lf0 = log_sigmoid(FL[(size_t)(MP + b * DS) * NH + h] + bf);
            const double cref = ctot + (double)lf0;
            float* csd = CS + (size_t)(b * NH + h) * 2080;
#pragma unroll 16
            for (int j = 0; j < 64; ++j) { c += (double)lsrc[(size_t)j * NH]; csd[seg * 64 + j] = (float)((cref - c) * (double)LOG2E); }
            if (seg == 31) {
                double cn = ctot;
                for (int s = 0; s < DS; ++s) { const float l = log_sigmoid(FL[(size_t)(MP + b * DS + s) * NH + h] + bf); out[O_FS + (size_t)(b * DS + s) * NH + h] = l; cn += (double)l; csd[PAST + s] = (float)((cref - cn) * (double)LOG2E); }
            }
            __syncthreads();
        }
        for (int m = gw; m < M; m += NGW) {
            bf16_t* pr = PROJ + (size_t)m * PP + 32 * lane;
            float* ko = ((m < MP) ? out + O_KP + (size_t)m * AW : out + O_KS + (size_t)(m - MP) * AW) + 32 * lane;
            float* vo = ((m < MP) ? out + O_VP + (size_t)m * AW : out + O_VS + (size_t)(m - MP) * AW) + 32 * lane;
            const int dofs = (32 * lane) & 127;
#pragma unroll
            for (int which = 0; which < 2; ++which) {
                bf16_t* p = pr + PW + which * AW; const float* gsrc = (which == 0 ? a.q_norm_g : a.k_norm_g) + dofs;
                u32x4 w4[4];
#pragma unroll
                for (int j = 0; j < 4; ++j) w4[j] = *(const u32x4*)(p + 8 * j);
                float v[32]; float ss = 0.f;
#pragma unroll
                for (int j = 0; j < 4; ++j)
#pragma unroll
                    for (int e = 0; e < 4; ++e) { v[8 * j + 2 * e] = bf_lo(w4[j][e]); v[8 * j + 2 * e + 1] = bf_hi(w4[j][e]); }
#pragma unroll
                for (int i = 0; i < 32; ++i) ss += v[i] * v[i];
                ss += swz_xor<1>(ss); ss += swz_xor<2>(ss);
                const float rs = __builtin_amdgcn_rsqf(ss * (1.0f / HD) + EPS) * (which == 0 ? QSCALE : 1.0f);
#pragma unroll
                for (int j = 0; j < 8; ++j) { const f32x4 gg = *(const f32x4*)(gsrc + 4 * j);
#pragma unroll
                    for (int e = 0; e < 4; ++e) v[4 * j + e] = v[4 * j + e] * rs * gg[e]; }
#pragma unroll
                for (int j = 0; j < 4; ++j) { u32x4 w; w.x = cvt_pk_bf16(v[8 * j], v[8 * j + 1]); w.y = cvt_pk_bf16(v[8 * j + 2], v[8 * j + 3]); w.z = cvt_pk_bf16(v[8 * j + 4], v[8 * j + 5]); w.w = cvt_pk_bf16(v[8 * j + 6], v[8 * j + 7]);
                    *(u32x4*)(p + 8 * j) = w; }
                if (which == 1) {
#pragma unroll
                    for (int j = 0; j < 8; ++j) *(f32x4*)(ko + 4 * j) = (f32x4){v[4 * j], v[4 * j + 1], v[4 * j + 2], v[4 * j + 3]};
                }
            }
            {
                u32x4 vw[4];
#pragma unroll
                for (int j = 0; j < 4; ++j) vw[j] = *(const u32x4*)(pr + PW + 2 * AW + 8 * j);
#pragma unroll
                for (int j = 0; j < 4; ++j) { *(f32x4*)(vo + 8 * j) = (f32x4){bf_lo(vw[j][0]), bf_hi(vw[j][0]), bf_lo(vw[j][1]), bf_hi(vw[j][1])};
                    *(f32x4*)(vo + 8 * j + 4) = (f32x4){bf_lo(vw[j][2]), bf_hi(vw[j][2]), bf_lo(vw[j][3]), bf_hi(vw[j][3])}; }
            }
        }
        for (int task = gw; task < (M / 32) * 4; task += NGW) {
            const int chunk = task >> 2, g = task & 3, w = 2 << g; const int col = g * PG + 8 * lane;
            const bool samp = chunk >= MP / 32; const int r0 = chunk * 32; const int b = chunk - MP / 32;
            const float inv_w = 1.0f / (float)w;
            auto ld8 = [&](int e, float (&v)[8]) {
                if (e >= 0 || (!samp && r0 + e >= 0)) { const u32x4 wv = *(const u32x4*)(PROJ + (size_t)(r0 + e) * PP + col);
#pragma unroll
                    for (int i = 0; i < 4; ++i) { v[2 * i] = bf_lo(wv[i]); v[2 * i + 1] = bf_hi(wv[i]); } }
                else if (samp) { const float* sp = a.state_pool + ((size_t)b * PH + (PH + e)) * PW + col; const f32x4 x0 = *(const f32x4*)sp, x1 = *(const f32x4*)(sp + 4);
                    v[0] = x0[0]; v[1] = x0[1]; v[2] = x0[2]; v[3] = x0[3]; v[4] = x1[0]; v[5] = x1[1]; v[6] = x1[2]; v[7] = x1[3]; }
                else {
#pragma unroll
                    for (int i = 0; i < 8; ++i) v[i] = 0.f; }
            };
            float Sx[8];
#pragma unroll
            for (int i = 0; i < 8; ++i) Sx[i] = 0.f;
            for (int e = -(w - 1); e < 0; ++e) { float t[8]; ld8(e, t);
#pragma unroll
                for (int i = 0; i < 8; ++i) Sx[i] += t[i]; }
            for (int e = 0; e < 32; ++e) {
                float cur[8], old[8]; ld8(e, cur); ld8(e - w + 1, old);
#pragma unroll
                for (int i = 0; i < 8; ++i) Sx[i] += cur[i];
                float ic = inv_w; if (!samp) { const int pos = r0 + e; if (pos + 1 < w) ic = 1.0f / (float)(pos + 1); }
                float d[8];
#pragma unroll
                for (int i = 0; i < 8; ++i) d[i] = Sx[i] * ic - cur[i];
                u32x4 o; o.x = cvt_pk_bf16(d[0], d[1]); o.y = cvt_pk_bf16(d[2], d[3]); o.z = cvt_pk_bf16(d[4], d[5]); o.w = cvt_pk_bf16(d[6], d[7]);
                *(u32x4*)(DP + (size_t)(r0 + e) * PW + col) = o;
#pragma unroll
                for (int i = 0; i < 8; ++i) Sx[i] -= old[i];
            }
        }
        for (int t = gw; t < PH * (1 + DB); t += NGW) {
            const int s = t / PH, j = t % PH;
            const int row = (s == 0) ? (MP - PH + j) : (MP + (s - 1) * DS + (DS - PH) + j);
            float* dst = (s == 0) ? out + O_HP + (size_t)j * PW : out + O_HS + ((size_t)(s - 1) * PH + j) * PW;
#pragma unroll
            for (int i = 0; i < 4; ++i) { const u32x4 wv = *(const u32x4*)(PROJ + (size_t)row * PP + 32 * lane + 8 * i);
                *(f32x4*)(dst + 32 * lane + 8 * i) = (f32x4){bf_lo(wv[0]), bf_hi(wv[0]), bf_lo(wv[1]), bf_hi(wv[1])};
                *(f32x4*)(dst + 32 * lane + 8 * i + 4) = (f32x4){bf_lo(wv[2]), bf_hi(wv[2]), bf_lo(wv[3]), bf_hi(wv[3])}; }
        }
    }
    xcd_barrier(bar, wave == 0 && fresh_lane() == 0);

    if constexpr (PHASES & 8) {
        if constexpr (PHASES & 128) {
            pg8::Gemm g{DP, WP, M, PW, PG, PW, 2}; pg8::StaticOrder S; S.init(M, PW, G, bx);
            pg8::EpiPool E{MIX, a.pool_scale};
            pg8::gemm_phase<pg8::EpiPool, pg8::StaticOrder>(lds, g, S, E, wave);
        }
        if constexpr (PHASES & 256) {
            int nblk = 0; for (int it = vcu; it < 256; it += G) nblk += 2;
            auto ref = [&](int i) { const int item = vcu + (i >> 1) * G, h = item >> 4, x = item & 15, qb = (i & 1) ? 31 - x : x;
                att::Blk r; r.h = h; r.qb = qb; r.jlo = JLO[h * 32 + qb]; return r; };
            if (nblk > 0) {
                att::Seam S; att::Blk cur = ref(0);
                att::attn_prime(cur, PROJ, (att::lptr)lds, S, wave);
                for (int i = 0; i < nblk; ++i) { const att::Blk nxt = (i + 1 < nblk) ? ref(i + 1) : cur; att::attn_block(cur, nxt, PROJ, MIX, CB, (att::lptr)lds, S, wave); cur = nxt; }
            }
        }
        asm volatile("s_waitcnt vmcnt(0)" ::: "memory"); __syncthreads();
        if constexpr (PHASES & 512) for (int u = vcu; u < DB * NH; u += G) att::samp_unit(u >> 4, u & 15, PROJ, a.cache_k, a.cache_v, CS, MIX, (att::lptr)lds, wave);
    }
    xcd_barrier(bar, wave == 0 && fresh_lane() == 0);

    if constexpr (PHASES & 16) {
        pg8::Gemm g{MIX, WO, M, DM, DM, DM, 1 << 30}; pg8::StaticOrder S; S.init(M, DM, G, bx);
        pg8::EpiOut E{a.x_prompt, a.x_sample, out, X1G, a.mlp_norm_g, RSS};
        pg8::gemm_phase<pg8::EpiOut, pg8::StaticOrder>(lds, g, S, E, wave);
    }
    xcd_barrier(bar, wave == 0 && fresh_lane() == 0);

    if constexpr (PHASES & 32) {
        pg8::Gemm g{X1G, WU, M, DFF, DM, DM, 1 << 30}; pg8::StaticOrder S; S.init(M, DFF, G, bx);
        pg8::EpiUp E{HID, RSS};
        pg8::gemm_phase<pg8::EpiUp, pg8::StaticOrder>(lds, g, S, E, wave);
    }
    xcd_barrier(bar, wave == 0 && fresh_lane() == 0);

    if constexpr (PHASES & 64) {
        pg8::Gemm g{HID, WD, M, DM, DFF, DFF, 1 << 30}; pg8::StaticOrder S; S.init(M, DM, G, bx);
        pg8::EpiDown E{out};
        pg8::gemm_phase<pg8::EpiDown, pg8::StaticOrder>(lds, g, S, E, wave);
    }
}

extern "C" void kernel_launch(void* const* d_in, const int* in_sizes, int n_in, void* d_out, int out_size, void* d_ws, size_t ws_size, hipStream_t stream) {
    static int grid = 0;
    if (grid == 0) {
        if (n_in != 17 || in_sizes[0] != MP * DM || (size_t)out_size != O_END || ws_size < WS_END) {
            fprintf(stderr, "kernel_launch: shape mismatch (n_in %d, in0 %d, out %d, ws %zu; need 17, %d, %zu, >= %zu)\n", n_in, n_in > 0 ? in_sizes[0] : -1, out_size, ws_size, MP * DM, (size_t)O_END, (size_t)WS_END);
            grid = -1; return; }
        int dev = 0, cus = 0, per_cu = 0;
        if (hipGetDevice(&dev) != hipSuccess || hipDeviceGetAttribute(&cus, hipDeviceAttributeMultiprocessorCount, dev) != hipSuccess) { grid = -1; return; }
        if (hipFuncSetAttribute((const void*)hymba_fwd, hipFuncAttributeMaxDynamicSharedMemorySize, LDS_BYTES) != hipSuccess) { fprintf(stderr, "kernel_launch: hipFuncSetAttribute failed\n"); grid = -1; return; }
        if (hipOccupancyMaxActiveBlocksPerMultiprocessor(&per_cu, (const void*)hymba_fwd, 512, LDS_BYTES) != hipSuccess || per_cu < 1) { fprintf(stderr, "kernel_launch: occupancy query says %d\n", per_cu); }
        (void)hipGetLastError();
        grid = cus;
    }
    if (grid < 0) return;
    if (hipMemsetAsync((char*)d_ws + WS_CTL, 0, CTL_ZERO_BYTES, stream) != hipSuccess) { fprintf(stderr, "kernel_launch: memset failed\n"); return; }
    Args a{};
    a.x_prompt = (const float*)d_in[0]; a.x_sample = (const float*)d_in[1]; a.cache_k = (const float*)d_in[2]; a.cache_v = (const float*)d_in[3]; a.cache_logf = (const float*)d_in[4];
    a.state_pool = (const float*)d_in[5]; a.attn_norm_g = (const float*)d_in[6]; a.w_in = (const float*)d_in[7]; a.b_f = (const float*)d_in[8]; a.q_norm_g = (const float*)d_in[9];
    a.k_norm_g = (const float*)d_in[10]; a.w_pool = (const float*)d_in[11]; a.pool_scale = (const float*)d_in[12]; a.w_out = (const float*)d_in[13]; a.mlp_norm_g = (const float*)d_in[14];
    a.w_up = (const float*)d_in[15]; a.w_down = (const float*)d_in[16];
    a.out = (float*)d_out; a.ws = (unsigned char*)d_ws;
    hipLaunchKernelGGL(hymba_fwd, dim3(grid), dim3(512), LDS_BYTES, stream, a);
    const hipError_t le = hipPeekAtLastError();
    if (le != hipSuccess) fprintf(stderr, "kernel_launch: launch failed: %s\n", hipGetErrorName(le));
}
```

```cpp
#include <hip/hip_runtime.h>
#include <cstdio>
#include <cstdint>

#define LAS __attribute__((address_space(3)))
#define GAS __attribute__((address_space(1)))
typedef unsigned short bf16_t;
typedef short bf16x8 __attribute__((ext_vector_type(8)));
typedef short s16x4 __attribute__((ext_vector_type(4)));
typedef float f32x2 __attribute__((ext_vector_type(2)));
typedef float f32x4 __attribute__((ext_vector_type(4)));
typedef float f32x16 __attribute__((ext_vector_type(16)));
typedef unsigned u32x2 __attribute__((ext_vector_type(2)));
typedef unsigned u32x4 __attribute__((ext_vector_type(4)));

constexpr int DM = 4096, SEQ = 8192, DB = 16, DS = 32, PAST = 2048;
constexpr int MP = SEQ, MS = DB * DS, M = MP + MS;
constexpr int PW = 2048, AW = 2048, NH = 16, HD = 128, PH = 15, PG = 512;
constexpr int NPROJ = PW + 3 * AW + NH;
constexpr int NPROJ_PAD = 8448;
constexpr int PP = 8192;
constexpr int DFF = 16384;
constexpr float EPS = 1e-6f;
constexpr float QSCALE = 0.08838834764831845f * 1.4426950408889634f;
constexpr float LOG2E = 1.4426950408889634f;
constexpr float PRUNE_T = 40.0f;
constexpr size_t O_YP = 0, O_YS = (size_t)MP * DM, O_KP = O_YS + (size_t)MS * DM, O_VP = O_KP + (size_t)MP * AW, O_FP = O_VP + (size_t)MP * AW,
                 O_HP = O_FP + (size_t)MP * NH, O_KS = O_HP + (size_t)PH * PW, O_VS = O_KS + (size_t)MS * AW, O_FS = O_VS + (size_t)MS * AW,
                 O_HS = O_FS + (size_t)MS * NH, O_END = O_HS + (size_t)DB * PH * PW;
static_assert(O_END == 71964672, "output size");
constexpr size_t MiB = 1u << 20;
constexpr size_t WS_CTL = 0, CTL_ZERO_BYTES = 1 * MiB;
constexpr size_t WS_WI = 2 * MiB, WS_WP = 68 * MiB, WS_WO = 70 * MiB, WS_WU = 102 * MiB, WS_WD = 230 * MiB, WS_XN = 358 * MiB, WS_PROJ = 426 * MiB,
                 WS_FL = 562 * MiB, WS_CB = 565 * MiB, WS_CS = 566 * MiB, WS_DP = 569 * MiB, WS_MIX = 603 * MiB, WS_X1G = 671 * MiB, WS_HID = 739 * MiB, WS_PART = 1011 * MiB, WS_END = 1075 * MiB;
static_assert(WS_WI + (size_t)NPROJ_PAD * DM * 2 <= WS_WP && WS_XN + (size_t)M * DM * 2 <= WS_PROJ && WS_PROJ + (size_t)M * PP * 2 <= WS_FL && WS_FL + (size_t)4 * M * NH * 4 <= WS_CB && WS_CS + (size_t)DB * NH * 2080 * 4 <= WS_DP &&
              WS_DP + (size_t)M * PW * 2 <= WS_MIX && WS_HID + (size_t)M * DFF * 2 <= WS_PART && WS_PART + (size_t)256 * 65536 * 4 <= WS_END, "ws map");
constexpr int CW_BAR = 4096;
constexpr int CW_JLO = 16384;
constexpr int CW_RSS = 32768;
constexpr int CW_SPLIT = 65536;
static_assert((CW_RSS + M) <= CW_SPLIT && (CW_SPLIT + 4 * 8192) * 4 <= (int)CTL_ZERO_BYTES, "ctl");
constexpr int LDS_BYTES = 147456;
constexpr int MISC_OFF = 131072 + 320;

__device__ __forceinline__ int fresh_lane() { int l; asm volatile("v_mbcnt_lo_u32_b32 %0, -1, 0\n\tv_mbcnt_hi_u32_b32 %0, -1, %0" : "=v"(l)); return l; }
template <int X> __device__ __forceinline__ float swz_xor(float v) { return __int_as_float(__builtin_amdgcn_ds_swizzle(__float_as_int(v), (X << 10) | 0x1f)); }
__device__ __forceinline__ float half_sum(float v) { auto rr = __builtin_amdgcn_permlane32_swap(__float_as_uint(v), __float_as_uint(v), false, false); return __uint_as_float(rr[0]) + __uint_as_float(rr[1]); }
__device__ __forceinline__ float half_max(float v) { auto rr = __builtin_amdgcn_permlane32_swap(__float_as_uint(v), __float_as_uint(v), false, false); return fmaxf(__uint_as_float(rr[0]), __uint_as_float(rr[1])); }
__device__ __forceinline__ unsigned cvt_pk_bf16(float lo, float hi) { unsigned r; asm volatile("v_cvt_pk_bf16_f32 %0, %1, %2" : "=v"(r) : "v"(lo), "v"(hi)); return r; }
__device__ __forceinline__ float bf_lo(unsigned w) { return __uint_as_float(w << 16); }
__device__ __forceinline__ float bf_hi(unsigned w) { return __uint_as_float(w & 0xffff0000u); }
__device__ __forceinline__ bf16x8 pack8(f32x4 a, f32x4 b) { u32x4 w = {cvt_pk_bf16(a[0], a[1]), cvt_pk_bf16(a[2], a[3]), cvt_pk_bf16(b[0], b[1]), cvt_pk_bf16(b[2], b[3])}; return __builtin_bit_cast(bf16x8, w); }

namespace pg8 {
constexpr int BM = 256, BK = 64, HALF = 128, HTB = HALF * BK * 2, STAGE_BYTES = 8 * HTB, NXCD = 8, WGM = 8;
__host__ __device__ __forceinline__ int lds_byte(int r, int c) { const int st = (r >> 4) * 2 + (c >> 5), rr = r & 15, cc = c & 31, ob = rr * 64 + cc * 2; return st * 1024 + (ob ^ (((ob >> 9) & 1) << 5)); }
__host__ __device__ __forceinline__ void stage_rc(int b, int& R, int& C) { const int st = b / 1024, sb = b % 1024, swz = sb ^ (((sb >> 9) & 1) << 5); R = (st >> 1) * 16 + swz / 64; C = (st & 1) * 32 + (swz % 64) / 2; }
__host__ __device__ __forceinline__ int perm32(int rho) { const int n = rho >> 4, i = rho & 15; return 8 * (i >> 2) + 4 * n + (i & 3); }
struct Unit { int pm, pn, kt0, nt, part; };
struct Gemm { const bf16_t* A; const bf16_t* Bt; int M, N, K, lda, adiv; };
struct SplitOrder {
    int nM, nN, nwg, G, c, R, r, s, ntK, nfull; float* part; unsigned* cnt;
    __device__ __forceinline__ void init(int M_, int N_, int K_, int G_, int c_, float* part_, unsigned* cnt_) {
        nM = M_ / BM; nN = N_ / BM; nwg = nM * nN; G = G_; c = c_; ntK = K_ / BK; part = part_; cnt = cnt_;
        r = 0; s = 1; nfull = nwg;
        if (G == 256 && part_ != nullptr) { const int rem = nwg % 256; if (rem != 0 && 256 % rem == 0) { const int ss = 256 / rem; if (ntK % ss == 0 && ((ntK / ss) & 1) == 0 && ntK / ss >= 4) { r = rem; s = ss; nfull = nwg - rem; } } }
    }
    __device__ __forceinline__ void map(int wgid, Unit& u) const {
        { const int q = nwg / NXCD, rr = nwg % NXCD, xcd = wgid % NXCD, off = wgid / NXCD; wgid = (xcd < rr ? xcd * (q + 1) : rr * (q + 1) + (xcd - rr) * q) + off; }
        const int nig = WGM * nN, gid = wgid / nig, fm = gid * WGM, gsz = (nM - fm) < WGM ? (nM - fm) : WGM;
        u.pm = fm + ((wgid % nig) % gsz); u.pn = (wgid % nig) / gsz;
    }
    __device__ __forceinline__ bool next(int i, Unit& u) const {
        int wg, kt0 = 0, nt = ntK, part = -1; bool ok;
        if (r) {
            if (i == 0) { wg = nfull + c / s; nt = ntK / s; kt0 = (c % s) * nt; part = c; ok = true; }
            else { const long L = (long)(i - 1) * G + c; ok = L < nfull; wg = ok ? (int)L : 0; }
        } else { const long L = (long)i * G + c; ok = L < nwg; wg = ok ? (int)L : 0; }
        Unit t; map(wg, t); t.kt0 = kt0; t.nt = nt; t.part = part; u = t; return ok;
    }
};
__device__ __forceinline__ void store16_sc1(float* p, f32x4 v) { asm volatile("global_store_dwordx4 %0, %1, off sc1\n\ts_nop 1" :: "v"(p), "v"(v) : "memory"); }
template <class Epi, class Sched>
__device__ __forceinline__ void gemm_phase(LAS unsigned char* lds, const Gemm g, const Sched& S, const Epi& E, const int wid) {
    const int lane = fresh_lane(), tid = wid * 64 + lane, wr = wid >> 2, wc = wid & 3, fr = lane & 15, fq = lane >> 4;
    const int K = g.K;
    unsigned voffA[2], voffB[2];
#pragma unroll
    for (int i = 0; i < 2; ++i) { int R, C; stage_rc(tid * 16 + i * 8192, R, C); const int Rb = (R & ~31) + perm32(R & 31);
        voffA[i] = (unsigned)(R * g.lda + C) * 2u; voffB[i] = (unsigned)(Rb * K + C) * 2u; }
    const size_t kstep = (size_t)(BK * 2);
    const size_t hstepA = (size_t)HALF * g.lda * 2, hstepB = (size_t)HALF * K * 2;
    const size_t tstepA = 2 * hstepA, tstepB = 2 * hstepB;
    const unsigned ldsw = (unsigned)wid * 1024u;
    const int aoff = lds_byte(wr * 64 + fr, fq * 8), boff = lds_byte(wc * 32 + fr, fq * 8);
#define PG8_SA(b, h) (((b) * 2 + (h)) * HTB)
#define PG8_SB(b, h) ((4 + (b) * 2 + (h)) * HTB)
#define PG8_STAGE(bufoff, gbase, voff) do { _Pragma("unroll") for (int _i = 0; _i < 2; ++_i) \
        __builtin_amdgcn_global_load_lds((const unsigned*)((const char*)(gbase) + (voff)[_i]), (LAS unsigned*)(lds + (bufoff) + ldsw + _i * 8192), 16, 0, 0); } while (0)
#define PG8_LDA(dst, b, h) do { _Pragma("unroll") for (int m = 0; m < 4; ++m) _Pragma("unroll") for (int k = 0; k < 2; ++k) dst[m][k] = *(const LAS bf16x8*)(lds + PG8_SA(b, h) + aoff + m * 2048 + k * 1024); } while (0)
#define PG8_LDB(dst, b, h) do { _Pragma("unroll") for (int n = 0; n < 2; ++n) _Pragma("unroll") for (int k = 0; k < 2; ++k) dst[n][k] = *(const LAS bf16x8*)(lds + PG8_SB(b, h) + boff + n * 2048 + k * 1024); } while (0)
#define PG8_MMA(ai, bj, At, Bt) do { __builtin_amdgcn_s_setprio(1); _Pragma("unroll") for (int m = 0; m < 4; ++m) _Pragma("unroll") for (int n = 0; n < 2; ++n) _Pragma("unroll") for (int k = 0; k < 2; ++k) \
        acc[ai][bj][m][n] = __builtin_amdgcn_mfma_f32_16x16x32_bf16(Bt[n][k], At[m][k], acc[ai][bj][m][n], 0, 0, 0); __builtin_amdgcn_s_setprio(0); } while (0)
#define PG8_WAIT_V(n) asm volatile("s_waitcnt vmcnt(" #n ")" ::: "memory")
#define PG8_WAIT_L(n) asm volatile("s_waitcnt lgkmcnt(" #n ")" ::: "memory")
#define PG8_BAR __builtin_amdgcn_s_barrier()
#define PG8_SCHED __builtin_amdgcn_sched_barrier(0)
    Unit cur, nxt; int ui = 0;
    if (!S.next(0, cur)) return;
    f32x4 acc[2][2][4][2];
#pragma unroll
    for (int a = 0; a < 2; ++a)
#pragma unroll
        for (int b = 0; b < 2; ++b)
#pragma unroll
            for (int m = 0; m < 4; ++m)
#pragma unroll
                for (int n = 0; n < 2; ++n) acc[a][b][m][n] = (f32x4){0.f, 0.f, 0.f, 0.f};
    bf16x8 At[4][2], B0[2][2], B1[2][2];
    const char* cA = (const char*)g.A + (size_t)cur.pm * tstepA + (size_t)(cur.pn / g.adiv) * K * 2 + (size_t)cur.kt0 * kstep; const char* cB = (const char*)g.Bt + (size_t)cur.pn * tstepB + (size_t)cur.kt0 * kstep;
    PG8_STAGE(PG8_SB(0, 0), cB, voffB); PG8_STAGE(PG8_SB(0, 1), cB + hstepB, voffB); PG8_STAGE(PG8_SA(0, 0), cA, voffA); PG8_STAGE(PG8_SA(0, 1), cA + hstepA, voffA);
    if (wr == 1) PG8_BAR;
    PG8_WAIT_V(2); PG8_BAR;
    PG8_STAGE(PG8_SB(1, 0), cB + kstep, voffB); PG8_STAGE(PG8_SA(1, 0), cA + kstep, voffA); PG8_STAGE(PG8_SB(1, 1), cB + hstepB + kstep, voffB);
    PG8_WAIT_V(6); PG8_BAR;
    for (;;) {
        const bool has_next = S.next(ui + 1, nxt);
        const char* nA = has_next ? (const char*)g.A + (size_t)nxt.pm * tstepA + (size_t)(nxt.pn / g.adiv) * K * 2 + (size_t)nxt.kt0 * kstep : cA; const char* nB = has_next ? (const char*)g.Bt + (size_t)nxt.pn * tstepB + (size_t)nxt.kt0 * kstep : cB;
        const int nt = cur.nt;
        for (int t = 0; t < nt; t += 2) {
            const bool last = (t == nt - 2);
            const char* a1 = cA + (size_t)(t + 1) * kstep;
            const char* a2 = last ? nA : cA + (size_t)(t + 2) * kstep; const char* b2 = last ? nB : cB + (size_t)(t + 2) * kstep;
            const char* a3 = a2 + kstep; const char* b3 = b2 + kstep;
            PG8_LDB(B0, 0, 0); PG8_LDB(B1, 0, 1); PG8_SCHED; PG8_LDA(At, 0, 0); PG8_STAGE(PG8_SA(1, 1), a1 + hstepA, voffA);
            PG8_WAIT_V(8); PG8_WAIT_L(0); PG8_BAR; PG8_MMA(0, 0, At, B0); PG8_MMA(0, 1, At, B1); PG8_BAR; PG8_SCHED;
            PG8_LDA(At, 0, 1); PG8_STAGE(PG8_SB(0, 0), b2, voffB); PG8_STAGE(PG8_SB(0, 1), b2 + hstepB, voffB); PG8_STAGE(PG8_SA(0, 0), a2, voffA);
            PG8_WAIT_V(8); PG8_WAIT_L(0); PG8_BAR; PG8_MMA(1, 0, At, B0); PG8_MMA(1, 1, At, B1); PG8_BAR; PG8_SCHED;
            PG8_LDB(B0, 1, 0); PG8_LDB(B1, 1, 1); PG8_SCHED; PG8_LDA(At, 1, 0); PG8_STAGE(PG8_SA(0, 1), a2 + hstepA, voffA);
            PG8_WAIT_V(8); PG8_WAIT_L(0); PG8_BAR; PG8_MMA(0, 0, At, B0); PG8_MMA(0, 1, At, B1); PG8_BAR; PG8_SCHED;
            PG8_LDA(At, 1, 1); PG8_STAGE(PG8_SB(1, 0), b3, voffB); PG8_STAGE(PG8_SB(1, 1), b3 + hstepB, voffB); PG8_STAGE(PG8_SA(1, 0), a3, voffA);
            PG8_WAIT_V(8); PG8_WAIT_L(0); PG8_BAR; PG8_MMA(1, 0, At, B0); PG8_MMA(1, 1, At, B1); PG8_BAR; PG8_SCHED;
        }
        if (wr == 0) PG8_BAR;
        if (cur.part >= 0) {
            float* pb = S.part + (size_t)cur.part * 65536 + (size_t)(wr * 64 + fr) * 256 + wc * 32 + 8 * fq;
#pragma unroll
            for (int ai = 0; ai < 2; ++ai)
#pragma unroll
                for (int m = 0; m < 4; ++m)
#pragma unroll
                    for (int bj = 0; bj < 2; ++bj)
#pragma unroll
                        for (int n = 0; n < 2; ++n) store16_sc1(pb + (size_t)(ai * HALF + m * 16) * 256 + bj * HALF + 4 * n, acc[ai][bj][m][n]);
            asm volatile("s_waitcnt vmcnt(0)" ::: "memory");
            if (lane == 0) __hip_atomic_fetch_add(S.cnt + 64 * (cur.part / S.s), 1u, __ATOMIC_RELAXED, __HIP_MEMORY_SCOPE_AGENT);
        } else E(acc, cur, wr, wc, fr, fq);
        if (!has_next) break;
#pragma unroll
        for (int a = 0; a < 2; ++a)
#pragma unroll
            for (int b = 0; b < 2; ++b)
#pragma unroll
                for (int m = 0; m < 4; ++m)
#pragma unroll
                    for (int n = 0; n < 2; ++n) acc[a][b][m][n] = (f32x4){0.f, 0.f, 0.f, 0.f};
        cur = nxt; cA = nA; cB = nB; ++ui;
        if (wr == 1) PG8_BAR;
    }
    PG8_WAIT_V(0);
    PG8_BAR;
    if (S.r) {
        const int su = S.c / S.s, j = S.c % S.s, rows = BM / S.s; Unit fu; S.map(S.nfull + su, fu);
        if (wid == 0) { unsigned* cw = S.cnt + 64 * su; unsigned sp = 0;
            while ((unsigned)__builtin_amdgcn_readfirstlane(__hip_atomic_load(cw, __ATOMIC_RELAXED, __HIP_MEMORY_SCOPE_AGENT)) < 8u * (unsigned)S.s) { __builtin_amdgcn_s_sleep(2); if (++sp > (1u << 22)) break; }
            __builtin_amdgcn_fence(__ATOMIC_ACQUIRE, "agent"); asm volatile("s_waitcnt vmcnt(0)" ::: "memory"); }
        __syncthreads();
        const float* pbase = S.part + (size_t)(su * S.s) * 65536;
        for (int rr = wid; rr < rows; rr += 8) { const int row = j * rows + rr; f32x4 v = {0.f, 0.f, 0.f, 0.f};
            for (int q = 0; q < S.s; ++q) v += *(const f32x4*)(pbase + (size_t)q * 65536 + row * 256 + lane * 4);
            E.fix(v, fu.pm * BM + row, fu.pn * BM + lane * 4, lane); }
    }
#undef PG8_SA
#undef PG8_SB
#undef PG8_STAGE
#undef PG8_LDA
#undef PG8_LDB
#undef PG8_MMA
#undef PG8_WAIT_V
#undef PG8_WAIT_L
#undef PG8_BAR
#undef PG8_SCHED
}

struct EpiProj {
    bf16_t* O;
    __device__ __forceinline__ void fix(f32x4 v, int row, int col, int) const { u32x2 w; w.x = cvt_pk_bf16(v[0], v[1]); w.y = cvt_pk_bf16(v[2], v[3]); *(u32x2*)(O + (size_t)row * PP + col) = w; }
    __device__ __forceinline__ void operator()(const f32x4 (&acc)[2][2][4][2], const Unit& u, int wr, int wc, int fr, int fq) const {
        const int row0 = u.pm * BM + wr * 64 + fr;
        const int col0 = u.pn * BM + wc * 32 + 8 * fq;
#pragma unroll
        for (int ai = 0; ai < 2; ++ai)
#pragma unroll
            for (int m = 0; m < 4; ++m) { bf16_t* rowp = O + (size_t)(row0 + ai * HALF + m * 16) * PP + col0;
#pragma unroll
                for (int bj = 0; bj < 2; ++bj) { const f32x4 v0 = acc[ai][bj][m][0], v1 = acc[ai][bj][m][1];
                    u32x4 w; w.x = cvt_pk_bf16(v0[0], v0[1]); w.y = cvt_pk_bf16(v0[2], v0[3]); w.z = cvt_pk_bf16(v1[0], v1[1]); w.w = cvt_pk_bf16(v1[2], v1[3]);
                    *(u32x4*)(rowp + bj * HALF) = w; } }
    }
};
struct EpiPool {
    bf16_t* O; const float* scale;
    __device__ __forceinline__ void fix(f32x4, int, int, int) const {}
    __device__ __forceinline__ void operator()(const f32x4 (&acc)[2][2][4][2], const Unit& u, int wr, int wc, int fr, int fq) const {
        const int row0 = u.pm * BM + wr * 64 + fr, col0 = u.pn * BM + wc * 32 + 8 * fq;
        f32x4 sv[2][2];
#pragma unroll
        for (int bj = 0; bj < 2; ++bj)
#pragma unroll
            for (int n = 0; n < 2; ++n) sv[bj][n] = *(const f32x4*)(scale + col0 + bj * HALF + 4 * n);
#pragma unroll
        for (int ai = 0; ai < 2; ++ai)
#pragma unroll
            for (int m = 0; m < 4; ++m) { bf16_t* rowp = O + (size_t)(row0 + ai * HALF + m * 16) * DM + col0;
#pragma unroll
                for (int bj = 0; bj < 2; ++bj) { const f32x4 v0 = acc[ai][bj][m][0] * sv[bj][0], v1 = acc[ai][bj][m][1] * sv[bj][1];
                    u32x4 w; w.x = cvt_pk_bf16(v0[0], v0[1]); w.y = cvt_pk_bf16(v0[2], v0[3]); w.z = cvt_pk_bf16(v1[0], v1[1]); w.w = cvt_pk_bf16(v1[2], v1[3]);
                    *(u32x4*)(rowp + bj * HALF) = w; } }
    }
};
struct EpiOut {
    const float* xp; const float* xs; float* Y; bf16_t* X1G; const float* g2; float* rowss;
    __device__ __forceinline__ void fix(f32x4 v, int row, int col, int lane) const {
        const float* xin = (row < MP) ? xp + (size_t)row * DM : xs + (size_t)(row - MP) * DM;
        const f32x4 x1 = *(const f32x4*)(xin + col) + v; *(f32x4*)(Y + (size_t)row * DM + col) = x1;
        const f32x4 w = x1 * *(const f32x4*)(g2 + col); u32x2 o; o.x = cvt_pk_bf16(w[0], w[1]); o.y = cvt_pk_bf16(w[2], w[3]); *(u32x2*)(X1G + (size_t)row * DM + col) = o;
        float ss = (x1[0] * x1[0] + x1[1] * x1[1]) + (x1[2] * x1[2] + x1[3] * x1[3]);
        ss += swz_xor<1>(ss); ss += swz_xor<2>(ss); ss += swz_xor<4>(ss); ss += swz_xor<8>(ss); ss += swz_xor<16>(ss); ss = half_sum(ss);
        if (lane == 0) __hip_atomic_fetch_add(rowss + row, ss, __ATOMIC_RELAXED, __HIP_MEMORY_SCOPE_AGENT);
    }
    __device__ __forceinline__ void operator()(const f32x4 (&acc)[2][2][4][2], const Unit& u, int wr, int wc, int fr, int fq) const {
        const int row0 = u.pm * BM + wr * 64 + fr, col0 = u.pn * BM + wc * 32 + 8 * fq;
        const float* xin = (u.pm < MP / BM) ? xp : xs - (size_t)MP * DM;
        f32x4 gv[2][2];
#pragma unroll
        for (int bj = 0; bj < 2; ++bj)
#pragma unroll
            for (int n = 0; n < 2; ++n) gv[bj][n] = *(const f32x4*)(g2 + col0 + bj * HALF + 4 * n);
#pragma unroll
        for (int ai = 0; ai < 2; ++ai)
#pragma unroll
            for (int m = 0; m < 4; ++m) { const int row = row0 + ai * HALF + m * 16; const size_t off = (size_t)row * DM + col0; float ss = 0.f;
#pragma unroll
                for (int bj = 0; bj < 2; ++bj) {
                    const f32x4 v0 = *(const f32x4*)(xin + off + bj * HALF) + acc[ai][bj][m][0], v1 = *(const f32x4*)(xin + off + bj * HALF + 4) + acc[ai][bj][m][1];
                    *(f32x4*)(Y + off + bj * HALF) = v0; *(f32x4*)(Y + off + bj * HALF + 4) = v1;
                    ss += (v0[0] * v0[0] + v0[1] * v0[1]) + (v0[2] * v0[2] + v0[3] * v0[3]) + (v1[0] * v1[0] + v1[1] * v1[1]) + (v1[2] * v1[2] + v1[3] * v1[3]);
                    const f32x4 w0 = v0 * gv[bj][0], w1 = v1 * gv[bj][1];
                    u32x4 w; w.x = cvt_pk_bf16(w0[0], w0[1]); w.y = cvt_pk_bf16(w0[2], w0[3]); w.z = cvt_pk_bf16(w1[0], w1[1]); w.w = cvt_pk_bf16(w1[2], w1[3]);
                    *(u32x4*)(X1G + off + bj * HALF) = w; }
                ss += swz_xor<16>(ss); ss = half_sum(ss);
                if (fq == 0) __hip_atomic_fetch_add(rowss + row, ss, __ATOMIC_RELAXED, __HIP_MEMORY_SCOPE_AGENT);
                asm volatile("" ::: "memory"); }
    }
};
struct EpiUp {
    bf16_t* O; const float* rowss;
    __device__ __forceinline__ void fix(f32x4 v, int row, int col, int) const {
        const float rs = __builtin_amdgcn_rsqf(rowss[row] * (1.0f / DM) + EPS); v = v * rs;
#pragma unroll
        for (int j = 0; j < 4; ++j) v[j] = fmaxf(v[j], 0.f);
        v = v * v; u32x2 o; o.x = cvt_pk_bf16(v[0], v[1]); o.y = cvt_pk_bf16(v[2], v[3]); *(u32x2*)(O + (size_t)row * DFF + col) = o;
    }
    __device__ __forceinline__ void operator()(const f32x4 (&acc)[2][2][4][2], const Unit& u, int wr, int wc, int fr, int fq) const {
        const int row0 = u.pm * BM + wr * 64 + fr, col0 = u.pn * BM + wc * 32 + 8 * fq;
#pragma unroll
        for (int ai = 0; ai < 2; ++ai)
#pragma unroll
            for (int m = 0; m < 4; ++m) { const int row = row0 + ai * HALF + m * 16; bf16_t* rowp = O + (size_t)row * DFF + col0;
                const float rs = __builtin_amdgcn_rsqf(rowss[row] * (1.0f / DM) + EPS);
#pragma unroll
                for (int bj = 0; bj < 2; ++bj) { f32x4 v0 = acc[ai][bj][m][0] * rs, v1 = acc[ai][bj][m][1] * rs;
#pragma unroll
                    for (int j = 0; j < 4; ++j) { v0[j] = fmaxf(v0[j], 0.f); v1[j] = fmaxf(v1[j], 0.f); }
                    v0 = v0 * v0; v1 = v1 * v1;
                    u32x4 w; w.x = cvt_pk_bf16(v0[0], v0[1]); w.y = cvt_pk_bf16(v0[2], v0[3]); w.z = cvt_pk_bf16(v1[0], v1[1]); w.w = cvt_pk_bf16(v1[2], v1[3]);
                    *(u32x4*)(rowp + bj * HALF) = w; } }
    }
};
struct EpiDown {
    float* Y;
    __device__ __forceinline__ void fix(f32x4 v, int row, int col, int) const { float* p = Y + (size_t)row * DM + col; *(f32x4*)p = *(const f32x4*)p + v; }
    __device__ __forceinline__ void operator()(const f32x4 (&acc)[2][2][4][2], const Unit& u, int wr, int wc, int fr, int fq) const {
        const int row0 = u.pm * BM + wr * 64 + fr, col0 = u.pn * BM + wc * 32 + 8 * fq;
#pragma unroll
        for (int ai = 0; ai < 2; ++ai)
#pragma unroll
            for (int m = 0; m < 4; ++m) { float* rowp = Y + (size_t)(row0 + ai * HALF + m * 16) * DM + col0;
#pragma unroll
                for (int bj = 0; bj < 2; ++bj) {
                    const f32x4 v0 = *(const f32x4*)(rowp + bj * HALF) + acc[ai][bj][m][0], v1 = *(const f32x4*)(rowp + bj * HALF + 4) + acc[ai][bj][m][1];
                    *(f32x4*)(rowp + bj * HALF) = v0; *(f32x4*)(rowp + bj * HALF + 4) = v1; }
                asm volatile("" ::: "memory"); }
    }
};
}

namespace att {
constexpr int D = 128, NW = 8, QBLK = 32, KVBLK = 64, QB = NW * QBLK;
constexpr int SHM_V = KVBLK * D * 2, SHM_K = KVBLK * D * 2;
constexpr int OFF_K = 2 * SHM_V, OFF_WS = 2 * SHM_V + 2 * SHM_K, OFF_CB = OFF_WS + NW * 64 * 4, LDS_NEED = OFF_CB + 8192 * 4;
constexpr int PO = DM;
constexpr float THR2 = 8.f * LOG2E;
typedef LAS char* lptr;
#define KSWZ(row, colB) ((row) * 256 + ((colB) ^ (((row) & 7) << 4)))
#define SBAR() __builtin_amdgcn_sched_barrier(0)
__device__ __forceinline__ int v_st(int k, int c) { const int kk = (k & ~0xC) | ((k & 4) << 1) | ((k & 8) >> 1); return ((kk >> 3) * 4 + (c >> 5)) * 512 + ((kk & 7) * 32 + (c & 31)) * 2; }
__device__ __forceinline__ int v_rd_base(int lane) { return ((lane & 3) << 3) | (((lane >> 2) & 3) << 6) | (((lane >> 4) & 1) << 5) | (((lane >> 5) & 1) << 8); }
constexpr int v_rd_off(int d0, int ks, int half) { return d0 * 512 + ks * 4096 + half * 2048; }
__device__ __forceinline__ int crow(int r, int hi) { return (r & 3) + 8 * (r >> 2) + 4 * hi; }
__device__ __forceinline__ bf16x8 load8(const bf16_t* p) { return *reinterpret_cast<const bf16x8*>(p); }
__device__ __forceinline__ void mask_tile(f32x16& p0, f32x16& p1, int dq) {
    const float NEG = -__builtin_inff();
#pragma unroll
    for (int r = 0; r < 16; ++r) { const int c = (r & 3) + 8 * (r >> 2);
        if (dq - c < 0) p0[r] = NEG;
        if (dq - c - 32 < 0) p1[r] = NEG; }
}
__device__ __forceinline__ void partialSM(f32x16& p0, f32x16& p1, float& m_reg, float& mn, float& alpha) {
    float pmax = p0[0];
#pragma unroll
    for (int r = 1; r < 16; ++r) pmax = fmaxf(pmax, p0[r]);
#pragma unroll
    for (int r = 0; r < 16; ++r) pmax = fmaxf(pmax, p1[r]);
    { auto rr = __builtin_amdgcn_permlane32_swap(__float_as_uint(pmax), __float_as_uint(pmax), false, false);
      pmax = fmaxf(__uint_as_float(rr[0]), __uint_as_float(rr[1])); }
    if (__builtin_expect(__all((pmax - m_reg) <= THR2), 1)) { mn = m_reg; alpha = 1.f; }
    else { mn = fmaxf(m_reg, pmax); alpha = __builtin_amdgcn_exp2f(m_reg - mn); m_reg = mn; }
#pragma unroll
    for (int r = 0; r < 16; ++r) p0[r] = p0[r] - mn;
#pragma unroll
    for (int r = 0; r < 16; ++r) p1[r] = p1[r] - mn;
#pragma unroll
    for (int r = 0; r < 16; ++r) p0[r] = __builtin_amdgcn_exp2f(p0[r]);
}
__device__ __forceinline__ void finishSM(f32x16& p0, f32x16& p1, float alpha, float& l_reg, bf16x8& pa0, bf16x8& pa1, bf16x8& pa2, bf16x8& pa3) {
#pragma unroll
    for (int r = 0; r < 16; ++r) p1[r] = __builtin_amdgcn_exp2f(p1[r]);
    float ps = 0;
#pragma unroll
    for (int r = 0; r < 16; ++r) ps += p0[r];
#pragma unroll
    for (int r = 0; r < 16; ++r) ps += p1[r];
    { auto rr = __builtin_amdgcn_permlane32_swap(__float_as_uint(ps), __float_as_uint(ps), false, false);
      ps = __uint_as_float(rr[0]) + __uint_as_float(rr[1]); }
    l_reg = l_reg * alpha + ps;
#define PK4(P, B_, OUT) do { unsigned a0 = cvt_pk_bf16(P[B_+0], P[B_+1]), a1 = cvt_pk_bf16(P[B_+2], P[B_+3]);                          \
        unsigned b0 = cvt_pk_bf16(P[B_+4], P[B_+5]), b1 = cvt_pk_bf16(P[B_+6], P[B_+7]);                                             \
        auto r0 = __builtin_amdgcn_permlane32_swap(a0, b0, false, false); auto r1 = __builtin_amdgcn_permlane32_swap(a1, b1, false, false); \
        u32x4 w = {r0[0], r1[0], r0[1], r1[1]}; OUT = __builtin_bit_cast(bf16x8, w); } while (0)
    PK4(p0, 0, pa0); PK4(p0, 8, pa1); PK4(p1, 0, pa2); PK4(p1, 8, pa3);
}
template <int KB>
__device__ __forceinline__ void qkt(f32x16& p0, f32x16& p1, lptr K_lds, const LAS float* cbt, int r32, int hi, const bf16x8* qr) {
#pragma unroll
    for (int i = 0; i < 4; ++i) { const f32x4 b0 = *(const LAS f32x4*)(cbt + 8 * i), b1 = *(const LAS f32x4*)(cbt + 32 + 8 * i);
        p0[4 * i] = b0[0]; p0[4 * i + 1] = b0[1]; p0[4 * i + 2] = b0[2]; p0[4 * i + 3] = b0[3];
        p1[4 * i] = b1[0]; p1[4 * i + 1] = b1[1]; p1[4 * i + 2] = b1[2]; p1[4 * i + 3] = b1[3]; }
    lptr kb[4];
#pragma unroll
    for (int dd = 0; dd < 4; ++dd) kb[dd] = K_lds + KB * SHM_K + KSWZ(r32, (dd * 16 + hi * 8) * 2);
#pragma unroll
    for (int d0 = 0; d0 < 8; ++d0) { lptr a = kb[d0 & 3] + (d0 >> 2) * 128;
        bf16x8 b0 = *reinterpret_cast<const LAS bf16x8*>(a);
        bf16x8 b1 = *reinterpret_cast<const LAS bf16x8*>(a + 32 * 256);
        p0 = __builtin_amdgcn_mfma_f32_32x32x16_bf16(b0, qr[d0], p0, 0, 0, 0);
        p1 = __builtin_amdgcn_mfma_f32_32x32x16_bf16(b1, qr[d0], p1, 0, 0, 0); }
}
template <int VB>
__device__ __forceinline__ void pv_tile(f32x16* o, int vb0, bf16x8 pa0, bf16x8 pa1, bf16x8 pa2, bf16x8 pa3) {
#define TRRD(dst, off) asm volatile("ds_read_b64_tr_b16 %0, %1 offset:%2" : "=&v"(dst) : "v"(vb0), "i"(off) : "memory")
#define PV_D0(d0) do { s16x4 l0, l1, l2, l3, h0, h1, h2, h3; constexpr int b_ = VB * SHM_V + v_rd_off(d0, 0, 0);   \
        TRRD(l0, b_); TRRD(h0, b_ + 2048); TRRD(l1, b_ + 4096); TRRD(h1, b_ + 6144); TRRD(l2, b_ + 8192); TRRD(h2, b_ + 10240); TRRD(l3, b_ + 12288); TRRD(h3, b_ + 14336); \
        asm volatile("s_waitcnt lgkmcnt(0)" ::: "memory"); SBAR();   \
        o[d0] = __builtin_amdgcn_mfma_f32_32x32x16_bf16(pa0, (bf16x8){l0[0], l0[1], l0[2], l0[3], h0[0], h0[1], h0[2], h0[3]}, o[d0], 0, 0, 0);   \
        o[d0] = __builtin_amdgcn_mfma_f32_32x32x16_bf16(pa1, (bf16x8){l1[0], l1[1], l1[2], l1[3], h1[0], h1[1], h1[2], h1[3]}, o[d0], 0, 0, 0);   \
        o[d0] = __builtin_amdgcn_mfma_f32_32x32x16_bf16(pa2, (bf16x8){l2[0], l2[1], l2[2], l2[3], h2[0], h2[1], h2[2], h2[3]}, o[d0], 0, 0, 0);   \
        o[d0] = __builtin_amdgcn_mfma_f32_32x32x16_bf16(pa3, (bf16x8){l3[0], l3[1], l3[2], l3[3], h3[0], h3[1], h3[2], h3[3]}, o[d0], 0, 0, 0); } while (0)
    PV_D0(0); PV_D0(1); PV_D0(2); PV_D0(3);
#undef PV_D0
#undef TRRD
}
struct Blk { int h, qb, jlo; };
struct Seam { bf16x8 qr[8]; bf16x8 st_v0, st_v1, st_k0, st_k1; };
#define VMW() asm volatile("s_waitcnt vmcnt(0)" ::: "memory")
#define VMWN(n) asm volatile("s_waitcnt vmcnt(%0)" :: "i"(n) : "memory")
#define SLOAD_H(hh, k0) do { const bf16_t* kt_ = PROJ + (size_t)(k0) * PP + (PW + AW) + (hh) * HD;                                         \
                         S.st_v0 = load8(kt_ + AW + toff); S.st_v1 = load8(kt_ + AW + 32 * PP + toff);                                      \
                         S.st_k0 = load8(kt_ + toff); S.st_k1 = load8(kt_ + 32 * PP + toff); } while (0)
#define QLOAD(hh, qq) do { const bf16_t* qt_ = PROJ + (size_t)((qq) * QB + wid * QBLK) * PP + PW + (hh) * HD;                                \
                         _Pragma("unroll") for (int d0 = 0; d0 < 8; ++d0) S.qr[d0] = load8(qt_ + qoff + d0 * 16); } while (0)
#define SWRITE_HK(bf) do { *(LAS bf16x8*)(K_lds + (bf) * SHM_K + kws) = S.st_k0; *(LAS bf16x8*)(K_lds + (bf) * SHM_K + kws + 32 * 256) = S.st_k1; } while (0)
#define SWRITE_HV(bf) do { *(LAS bf16x8*)(V_lds + (bf) * SHM_V + vst0) = S.st_v0; *(LAS bf16x8*)(V_lds + (bf) * SHM_V + vst1) = S.st_v1; } while (0)
#define SWRITE_H(bf) do { SWRITE_HV(bf); SWRITE_HK(bf); } while (0)
__device__ __forceinline__ void attn_prime(const Blk cur, const bf16_t* PROJ, lptr lds, Seam& S, const int wid) {
    const int lane = fresh_lane(), tid = wid * 64 + lane, r32 = lane & 31, hi = lane >> 5;
    const int sr = tid >> 4, sc = (tid & 15) * 8, kws = KSWZ(sr, sc * 2); lptr K_lds = lds + OFF_K;
    const unsigned toff = (unsigned)(sr * PP + sc), qoff = (unsigned)(r32 * PP + hi * 8);
    QLOAD(cur.h, cur.qb);
    SLOAD_H(cur.h, cur.jlo * KVBLK); VMW(); SWRITE_HK(0);
    __syncthreads();
}
__device__ __forceinline__ void attn_block(const Blk cur, const Blk nxt, const bf16_t* PROJ, bf16_t* MIX, const float* CB, lptr lds, Seam& S, const int wid) {
    const int lane = fresh_lane(), tid = wid * 64 + lane, r32 = lane & 31, hi = lane >> 5;
    const int P0 = cur.qb * QB, j_lo = cur.jlo, j_hi = (P0 + QB - 1) / KVBLK + 1;
    const int NT = j_hi - j_lo;
    const int qlo = P0 + wid * QBLK, qm = qlo + r32 - 4 * hi;
    lptr V_lds = lds; lptr K_lds = lds + OFF_K;
    LAS float* ws = (LAS float*)(lds + OFF_WS) + wid * 64; LAS float* li_l = ws; LAS float* al_l = ws + 32;
    LAS float* cb = (LAS float*)(lds + OFF_CB);
    float m_reg = -1e30f, l_reg = 0; f32x16 o[4] = {};
    const int sr = tid >> 4, sc = (tid & 15) * 8, vst0 = v_st(sr, sc), vst1 = v_st(32 + sr, sc), kws = KSWZ(sr, sc * 2);
    const unsigned toff = (unsigned)(sr * PP + sc);
    const int vb0 = (int)(unsigned)(size_t)V_lds + v_rd_base(lane);
    const int hh = cur.h;
    { const float* c2 = CB + (size_t)hh * SEQ; const float cref = c2[P0]; const float* csrc = c2 + j_lo * KVBLK;
      for (int i = tid * 4; i < NT * KVBLK; i += 2048) { const f32x4 c = *(const f32x4*)(csrc + i); *(LAS f32x4*)(cb + i) = cref - c; }
      __syncthreads(); }
    const LAS float* cbl = cb + 4 * hi;
#define RESC(a) do { if (__any((a) < 1.f)) { if (hi == 0) al_l[r32] = (a); asm volatile("s_waitcnt lgkmcnt(0)" ::: "memory");              \
                     _Pragma("unroll") for (int d_ = 0; d_ < 4; ++d_) _Pragma("unroll") for (int r = 0; r < 16; ++r) o[d_][r] *= al_l[crow(r, hi)]; } } while (0)
#define KBASE(t) ((j_lo + (t)) * KVBLK)
#define MASKT(P0_, P1_, t) do { const int kb_ = KBASE(t); if (kb_ + KVBLK - 1 > qlo) mask_tile(P0_, P1_, qm - kb_); } while (0)
#define SEAM_K0() do { VMWN(8); SWRITE_HK(0); SBAR(); } while (0)
    f32x16 pA0, pA1, pB0, pB1; float mnA, mnB, alA, alB; bf16x8 pa0, pa1, pa2, pa3;
    SWRITE_HV(0); SBAR();
    if (NT > 1) { SLOAD_H(hh, KBASE(1)); }
    SBAR(); qkt<0>(pA0, pA1, K_lds, cbl, r32, hi, S.qr);
    MASKT(pA0, pA1, 0); partialSM(pA0, pA1, m_reg, mnA, alA);
    if (NT > 1) { VMW(); SWRITE_H(1); }
    __syncthreads();
#define HALF_STEP(PX0, PX1, mnX, alX, PY0, PY1, alY, t, KB, VB, SB) do {                                                      \
        SBAR(); qkt<KB>(PX0, PX1, K_lds, cbl + (t) * KVBLK, r32, hi, S.qr);                                                   \
        finishSM(PY0, PY1, alY, l_reg, pa0, pa1, pa2, pa3); SBAR();                                                           \
        if ((t) + 1 < NT) { SLOAD_H(hh, KBASE((t) + 1)); SBAR(); }                                                            \
        pv_tile<VB>(o, vb0, pa0, pa1, pa2, pa3); MASKT(PX0, PX1, (t)); partialSM(PX0, PX1, m_reg, mnX, alX);                   \
        __syncthreads();                                                                                                      \
        if ((t) + 1 < NT) { VMW(); SWRITE_H(SB); }                                                                            \
        RESC(alX); __syncthreads(); } while (0)
    for (int t = 1; t + 1 < NT; t += 2) {
        HALF_STEP(pB0, pB1, mnB, alB, pA0, pA1, alA, t, 1, 0, 0);
        HALF_STEP(pA0, pA1, mnA, alA, pB0, pB1, alB, t + 1, 0, 1, 1);
    }
    const bool even = (NT & 1) == 0;
    const int l2_ = fresh_lane(), r32b_ = l2_ & 31, hib_ = l2_ >> 5, qmb_ = qlo + r32b_ - 4 * hib_;
    { const int r32 = r32b_, hi = hib_, qm = qmb_;
    if (even) { SBAR(); qkt<1>(pB0, pB1, K_lds, cbl + (NT - 1) * KVBLK, r32, hi, S.qr); SBAR(); }
    SLOAD_H(nxt.h, nxt.jlo * KVBLK); SBAR();
    { const unsigned qoff = (unsigned)(r32 * PP + hi * 8); QLOAD(nxt.h, nxt.qb); }
    SBAR();
    finishSM(pA0, pA1, alA, l_reg, pa0, pa1, pa2, pa3); SBAR();
    pv_tile<0>(o, vb0, pa0, pa1, pa2, pa3);
    if (even) { MASKT(pB0, pB1, NT - 1); partialSM(pB0, pB1, m_reg, mnB, alB); __syncthreads(); RESC(alB);
        finishSM(pB0, pB1, alB, l_reg, pa0, pa1, pa2, pa3); SBAR(); pv_tile<1>(o, vb0, pa0, pa1, pa2, pa3); }
    SBAR(); SEAM_K0();
    if (hi == 0) li_l[r32] = l_reg; asm volatile("s_waitcnt lgkmcnt(0)" ::: "memory");
    bf16_t* Ow = MIX + (size_t)(P0 + wid * QBLK) * PO + PW + hh * HD;
    const unsigned ooff = (unsigned)(4 * hi * PO + r32);
#pragma unroll
    for (int r = 0; r < 16; ++r) { const float rl = __builtin_amdgcn_rcpf(li_l[crow(r, hi)]);
#pragma unroll
        for (int d0 = 0; d0 < 4; ++d0) { const float v = o[d0][r] * rl;
            const float vn = swz_xor<1>(v);
            if ((r32 & 1) == 0) *(unsigned*)(Ow + ooff + (unsigned)(((r & 3) + 8 * (r >> 2)) * PO + d0 * 32)) = cvt_pk_bf16(v, vn); } }
    }
    __syncthreads();
#undef RESC
#undef KBASE
#undef MASKT
#undef SEAM_K0
#undef HALF_STEP
}
#undef QLOAD
#undef SLOAD_H
#undef SWRITE_HK
#undef SWRITE_HV
#undef SWRITE_H

constexpr int SOFF_ML = 0, SOFF_OT = 2048, SLDS_NEED = 2048 + 8 * 64 * 32 * 4;
template <bool NEWK>
__device__ __forceinline__ void samp_chunk(const float* Kc, const float* Vc, const bf16_t* Kn, const bf16_t* Vn, const float* bias, const bf16x8* qr,
                                           float& m_reg, float& l_reg, f32x16* oT, int r32, int hi) {
    f32x16 s;
#pragma unroll
    for (int i = 0; i < 4; ++i) { const f32x4 b = *(const f32x4*)(bias + 8 * i + 4 * hi); s[4 * i] = b[0]; s[4 * i + 1] = b[1]; s[4 * i + 2] = b[2]; s[4 * i + 3] = b[3]; }
    bf16x8 kf[8];
    if constexpr (NEWK) {
#pragma unroll
        for (int d0 = 0; d0 < 8; ++d0) kf[d0] = load8(Kn + (size_t)r32 * PP + d0 * 16 + hi * 8);
    } else {
        const float* kp = Kc + (size_t)r32 * (NH * HD) + hi * 8;
#pragma unroll
        for (int d0 = 0; d0 < 8; ++d0) kf[d0] = pack8(*(const f32x4*)(kp + d0 * 16), *(const f32x4*)(kp + d0 * 16 + 4));
    }
#pragma unroll
    for (int d0 = 0; d0 < 8; ++d0) s = __builtin_amdgcn_mfma_f32_32x32x16_bf16(kf[d0], qr[d0], s, 0, 0, 0);
    if constexpr (NEWK) {
        const float NEG = -__builtin_inff();
#pragma unroll
        for (int r = 0; r < 16; ++r) if (crow(r, hi) > r32) s[r] = NEG;
    }
    float pmax = s[0];
#pragma unroll
    for (int r = 1; r < 16; ++r) pmax = fmaxf(pmax, s[r]);
    { auto rr = __builtin_amdgcn_permlane32_swap(__float_as_uint(pmax), __float_as_uint(pmax), false, false); pmax = fmaxf(__uint_as_float(rr[0]), __uint_as_float(rr[1])); }
    const float mn = fmaxf(m_reg, pmax), alpha = __builtin_amdgcn_exp2f(m_reg - mn); m_reg = mn;
    float ps = 0.f;
#pragma unroll
    for (int r = 0; r < 16; ++r) { s[r] = __builtin_amdgcn_exp2f(s[r] - mn); ps += s[r]; }
    { auto rr = __builtin_amdgcn_permlane32_swap(__float_as_uint(ps), __float_as_uint(ps), false, false); ps = __uint_as_float(rr[0]) + __uint_as_float(rr[1]); }
    l_reg = l_reg * alpha + ps;
    if (__any(alpha < 1.f)) {
#pragma unroll
        for (int d0 = 0; d0 < 4; ++d0) oT[d0] = oT[d0] * alpha;
    }
    bf16x8 pa0, pa1; PK4(s, 0, pa0); PK4(s, 8, pa1);
#pragma unroll
    for (int ks = 0; ks < 2; ++ks) {
#pragma unroll
        for (int d0 = 0; d0 < 4; ++d0) {
            bf16x8 vf;
            if constexpr (NEWK) {
                const bf16_t* vp = Vn + (size_t)(16 * ks + 8 * hi) * PP + 32 * d0 + r32;
                short e[8];
#pragma unroll
                for (int j = 0; j < 8; ++j) e[j] = (short)vp[(size_t)j * PP];
                vf = (bf16x8){e[0], e[1], e[2], e[3], e[4], e[5], e[6], e[7]};
            } else {
                const float* vp = Vc + (size_t)(16 * ks + 8 * hi) * (NH * HD) + 32 * d0 + r32;
                float e[8];
#pragma unroll
                for (int j = 0; j < 8; ++j) e[j] = vp[(size_t)j * (NH * HD)];
                vf = pack8((f32x4){e[0], e[1], e[2], e[3]}, (f32x4){e[4], e[5], e[6], e[7]});
            }
            oT[d0] = __builtin_amdgcn_mfma_f32_32x32x16_bf16(vf, ks == 0 ? pa0 : pa1, oT[d0], 0, 0, 0);
        }
    }
}
#undef PK4
__device__ __forceinline__ void samp_unit(int b, int h, const bf16_t* PROJ, const float* cache_k, const float* cache_v, const float* CS, bf16_t* MIX, lptr lds, const int wid) {
    const int lane = fresh_lane(), tid = wid * 64 + lane, r32 = lane & 31, hi = lane >> 5;
    const bf16_t* Qp = PROJ + (size_t)(MP + b * DS) * PP + PW + h * HD;
    const bf16_t* Kn = PROJ + (size_t)(MP + b * DS) * PP + PW + AW + h * HD;
    const bf16_t* Vn = PROJ + (size_t)(MP + b * DS) * PP + PW + 2 * AW + h * HD;
    const float* bias = CS + (size_t)(b * NH + h) * 2080;
    bf16x8 qr[8];
#pragma unroll
    for (int d0 = 0; d0 < 8; ++d0) qr[d0] = load8(Qp + (size_t)r32 * PP + d0 * 16 + hi * 8);
    float m_reg = -1e30f, l_reg = 0.f; f32x16 oT[4] = {};
    const float* Kc = cache_k + ((size_t)(b * PAST + wid * 256) * NH + h) * HD;
    const float* Vc = cache_v + ((size_t)(b * PAST + wid * 256) * NH + h) * HD;
    for (int c = 0; c < 8; ++c)
        samp_chunk<false>(Kc + (size_t)c * 32 * NH * HD, Vc + (size_t)c * 32 * NH * HD, nullptr, nullptr, bias + wid * 256 + c * 32, qr, m_reg, l_reg, oT, r32, hi);
    if (wid == 7) samp_chunk<true>(nullptr, nullptr, Kn, Vn, bias + PAST, qr, m_reg, l_reg, oT, r32, hi);
    LAS float* ML = (LAS float*)(lds + SOFF_ML); LAS float* OT = (LAS float*)(lds + SOFF_OT);
    if (hi == 0) { ML[(wid * 32 + r32) * 2] = m_reg; ML[(wid * 32 + r32) * 2 + 1] = l_reg; }
    __syncthreads();
    float Mx = -1e30f;
#pragma unroll
    for (int w = 0; w < 8; ++w) Mx = fmaxf(Mx, ML[(w * 32 + r32) * 2]);
    float L = 0.f;
#pragma unroll
    for (int w = 0; w < 8; ++w) L += ML[(w * 32 + r32) * 2 + 1] * __builtin_amdgcn_exp2f(ML[(w * 32 + r32) * 2] - Mx);
    const float f = __builtin_amdgcn_exp2f(m_reg - Mx) / L;
#pragma unroll
    for (int half = 0; half < 2; ++half) {
#pragma unroll
        for (int dd = 0; dd < 2; ++dd)
#pragma unroll
            for (int r = 0; r < 16; ++r) OT[(wid * 64 + dd * 32 + crow(r, hi)) * 32 + r32] = oT[half * 2 + dd][r] * f;
        __syncthreads();
        float acc4[4] = {0.f, 0.f, 0.f, 0.f};
#pragma unroll
        for (int w = 0; w < 8; ++w)
#pragma unroll
            for (int j = 0; j < 4; ++j) acc4[j] += OT[(w * 64 + 8 * wid + 4 * hi + j) * 32 + r32];
        u32x2 o2; o2.x = cvt_pk_bf16(acc4[0], acc4[1]); o2.y = cvt_pk_bf16(acc4[2], acc4[3]);
        *(u32x2*)(MIX + (size_t)(MP + b * DS + r32) * DM + PW + h * HD + half * 64 + 8 * wid + 4 * hi) = o2;
        __syncthreads();
    }
}
}

#define XB_TMO      128
#define XB_XCNT(j)  (256  + 64 * (j))
#define XB_XSUB(j)  (1280 + 64 * (j))
#define XB_XGEN(j)  (2304 + 64 * (j))
#define XB_TOP      3328
#define XB_TOPGEN   3392
#define XCD_BAR_WORDS 3456
#define XB_SPIN_CAP (1u << 22)
__device__ __forceinline__ unsigned xb_ld(unsigned* p)              { return __hip_atomic_load(p, __ATOMIC_RELAXED, __HIP_MEMORY_SCOPE_AGENT); }
__device__ __forceinline__ unsigned xb_add(unsigned* p, unsigned v) { return __hip_atomic_fetch_add(p, v, __ATOMIC_RELAXED, __HIP_MEMORY_SCOPE_AGENT); }
__device__ __forceinline__ unsigned xb_xcc_id() { return (unsigned)__builtin_amdgcn_s_getreg((3 << 11) | 20) & 0xFu; }
#define XB_SPIN(cond, bar) do { unsigned _sp = 0; while (cond) { __builtin_amdgcn_s_sleep(1); \
    if ((++_sp & 255u) == 0u) { if (xb_ld(&(bar)[XB_TMO])) break; if (_sp > XB_SPIN_CAP) { atomicAdd(&(bar)[XB_TMO], 1u); break; } } } } while (0)
struct XcdBarrier { unsigned* bar; unsigned x; volatile LAS unsigned* st; };
__device__ __forceinline__ XcdBarrier xcd_barrier_post(unsigned* bar, volatile LAS unsigned* st, bool leader) {
    XcdBarrier b; b.bar = bar; b.x = xb_xcc_id(); b.st = st;
    if (leader) (void)xb_add(&bar[XB_XCNT(b.x)], 1u);
    return b;
}
__device__ __forceinline__ void xcd_barrier_complete(unsigned* bar, unsigned x, unsigned& nloc, unsigned& nx) {
    const unsigned G = gridDim.x * gridDim.y * gridDim.z;
    unsigned sum, cnt, mine, sp = 0u;
    for (;;) {
        sum = 0u; cnt = 0u; mine = 0u;
#pragma unroll
        for (unsigned j = 0; j < 16; ++j) { const unsigned c = xb_ld(&bar[XB_XCNT(j)]); sum += c; cnt += (c > 0u) ? 1u : 0u; mine = (j == x) ? c : mine; }
        if (sum == G) break;
        __builtin_amdgcn_s_sleep(1);
        if ((++sp & 255u) == 0u) { if (xb_ld(&bar[XB_TMO])) break; if (sp > XB_SPIN_CAP) { atomicAdd(&bar[XB_TMO], 1u); break; } }
    }
    nloc = mine > 0u ? mine : 1u; nx = cnt > 0u ? cnt : 1u;
}
__device__ __forceinline__ void xcd_barrier(const XcdBarrier& b, bool leader) {
    asm volatile("s_waitcnt vmcnt(0)" ::: "memory");
    __syncthreads();
    if (leader) {
        unsigned* bar = b.bar;
        __builtin_amdgcn_s_waitcnt(0);
        unsigned nloc = b.st[0], nx = b.st[1];
        if (nloc == 0u) { xcd_barrier_complete(bar, b.x, nloc, nx); b.st[0] = nloc; b.st[1] = nx; }
        const unsigned old = xb_add(&bar[XB_XSUB(b.x)], 1u);
        const unsigned gen = old / nloc;
        if (old + 1u == (gen + 1u) * nloc) {
            __builtin_amdgcn_fence(__ATOMIC_RELEASE, "agent");
            asm volatile("s_waitcnt vmcnt(0)" ::: "memory");
            const unsigned og = xb_add(&bar[XB_TOP], 1u);
            const unsigned tg = og / nx;
            if (og + 1u == (tg + 1u) * nx) xb_add(&bar[XB_TOPGEN], 1u);
            else XB_SPIN(xb_ld(&bar[XB_TOPGEN]) == tg, bar);
            __builtin_amdgcn_fence(__ATOMIC_ACQUIRE, "agent");
            xb_add(&bar[XB_XGEN(b.x)], 1u);
            asm volatile("s_waitcnt vmcnt(0)" ::: "memory");
        } else {
            XB_SPIN(xb_ld(&bar[XB_XGEN(b.x)]) == gen, bar);
            __builtin_amdgcn_fence(__ATOMIC_ACQUIRE, "agent");
            asm volatile("s_waitcnt vmcnt(0)" ::: "memory");
        }
    }
    __syncthreads();
}

#ifndef PHASES
#define PHASES 0xfff
#endif
struct Args {
    const float *x_prompt, *x_sample, *cache_k, *cache_v, *cache_logf, *state_pool, *attn_norm_g, *w_in, *b_f, *q_norm_g, *k_norm_g, *w_pool, *pool_scale, *w_out, *mlp_norm_g, *w_up, *w_down;
    float* out; unsigned char* ws;
};
__device__ __forceinline__ float wave_sum(float v) { v += swz_xor<1>(v); v += swz_xor<2>(v); v += swz_xor<4>(v); v += swz_xor<8>(v); v += swz_xor<16>(v); return half_sum(v); }
__device__ __forceinline__ float wave_max(float v) { v = fmaxf(v, swz_xor<1>(v)); v = fmaxf(v, swz_xor<2>(v)); v = fmaxf(v, swz_xor<4>(v)); v = fmaxf(v, swz_xor<8>(v)); v = fmaxf(v, swz_xor<16>(v)); return half_max(v); }
__device__ __forceinline__ void p0_transpose_item(const float* W, int K, int N, bf16_t* WT, LAS float* scr, int kb, int nb, int lane) {
    const int k0 = 64 * kb, n0 = 32 * nb; const int nn = n0 + (lane & 31);
#pragma unroll 8
    for (int i = 0; i < 32; ++i) { const int kk = 2 * i + (lane >> 5); scr[kk * 33 + (lane & 31)] = nn < N ? W[(size_t)(k0 + kk) * N + nn] : 0.f; }
    asm volatile("s_waitcnt lgkmcnt(0)" ::: "memory");
    const int c = lane & 7;
#pragma unroll
    for (int j = 0; j < 4; ++j) { const int n = (lane >> 3) + 8 * j; const LAS float* s = scr + (8 * c) * 33 + n;
        u32x4 o; o.x = cvt_pk_bf16(s[0 * 33], s[1 * 33]); o.y = cvt_pk_bf16(s[2 * 33], s[3 * 33]); o.z = cvt_pk_bf16(s[4 * 33], s[5 * 33]); o.w = cvt_pk_bf16(s[6 * 33], s[7 * 33]);
        *(u32x4*)(WT + (size_t)(n0 + n) * K + k0 + 8 * c) = o; }
    asm volatile("s_waitcnt lgkmcnt(0)" ::: "memory");
}
__device__ __forceinline__ float log_sigmoid(float x) { return fminf(x, 0.f) - log1pf(__expf(-fabsf(x))); }

__global__ void __launch_bounds__(512, 2) hymba_fwd(Args a) {
    extern __shared__ __attribute__((aligned(16))) unsigned char lds_raw[];
    LAS unsigned char* lds = (LAS unsigned char*)lds_raw;
    volatile LAS unsigned* MISC = (volatile LAS unsigned*)(lds + MISC_OFF);
    const int wave = __builtin_amdgcn_readfirstlane((int)threadIdx.x >> 6);
    const int G = gridDim.x; const int bx = blockIdx.x; const int vcu = (G % 8 == 0) ? (bx % 8) * (G / 8) + bx / 8 : bx;
    unsigned char* ws = a.ws;
    unsigned* ctl = (unsigned*)(ws + WS_CTL);
    bf16_t* WI = (bf16_t*)(ws + WS_WI); bf16_t* WP = (bf16_t*)(ws + WS_WP); bf16_t* WO = (bf16_t*)(ws + WS_WO); bf16_t* WU = (bf16_t*)(ws + WS_WU); bf16_t* WD = (bf16_t*)(ws + WS_WD);
    bf16_t* XN = (bf16_t*)(ws + WS_XN); bf16_t* PROJ = (bf16_t*)(ws + WS_PROJ); float* FL = (float*)(ws + WS_FL); float* CB = (float*)(ws + WS_CB); float* CS = (float*)(ws + WS_CS);
    bf16_t* DP = (bf16_t*)(ws + WS_DP); bf16_t* MIX = (bf16_t*)(ws + WS_MIX); bf16_t* X1G = (bf16_t*)(ws + WS_X1G); bf16_t* HID = (bf16_t*)(ws + WS_HID); float* PART = (float*)(ws + WS_PART);
    int* JLO = (int*)(ctl + CW_JLO); float* RSS = (float*)(ctl + CW_RSS);
    float* out = a.out;
    for (int u = wave * 64 + fresh_lane(); u < (LDS_BYTES - 131072) / 4; u += 512) ((LAS unsigned*)(lds + 131072))[u] = 0u;
    __syncthreads();
    XcdBarrier bar = xcd_barrier_post(ctl + CW_BAR, MISC + 8, wave == 0 && fresh_lane() == 0);
    const int gw = vcu * 8 + wave, NGW = G * 8;

    if constexpr (PHASES & 1) {
        const int lane = fresh_lane();
        LAS float* scr = (LAS float*)(lds + wave * 16384);
        constexpr int NB_I = (NPROJ + 31) / 32, I_I = (DM / 64) * NB_I, I_P = 4 * (PG / 64) * (PG / 32), I_O = (DM / 64) * (DM / 32), I_U = (DM / 64) * (DFF / 32), I_D = (DFF / 64) * (DM / 32);
        constexpr int NITEMS = I_I + I_P + I_O + I_U + I_D;
        for (int it = gw; it < NITEMS; it += NGW) {
            int r = it;
            if (r < I_I) { p0_transpose_item(a.w_in, DM, NPROJ, WI, scr, r / NB_I, r % NB_I, lane); continue; } r -= I_I;
            if (r < I_P) { const int g = r / ((PG / 64) * (PG / 32)), q = r % ((PG / 64) * (PG / 32)); p0_transpose_item(a.w_pool + (size_t)g * PG * PG, PG, PG, WP + (size_t)g * PG * PG, scr, q / (PG / 32), q % (PG / 32), lane); continue; } r -= I_P;
            if (r < I_O) { p0_transpose_item(a.w_out, DM, DM, WO, scr, r / (DM / 32), r % (DM / 32), lane); continue; } r -= I_O;
            if (r < I_U) { p0_transpose_item(a.w_up, DM, DFF, WU, scr, r / (DFF / 32), r % (DFF / 32), lane); continue; } r -= I_U;
            p0_transpose_item(a.w_down, DFF, DM, WD, scr, r / (DM / 32), r % (DM / 32), lane);
        }
        for (int m = gw; m < M; m += NGW) {
            const float* xrow = (m < MP) ? a.x_prompt + (size_t)m * DM : a.x_sample + (size_t)(m - MP) * DM;
            f32x4 v[16]; float s = 0.f;
#pragma unroll
            for (int j = 0; j < 16; ++j) { v[j] = *(const f32x4*)(xrow + 256 * j + 4 * lane); s += (v[j][0] * v[j][0] + v[j][1] * v[j][1]) + (v[j][2] * v[j][2] + v[j][3] * v[j][3]); }
            const float rstd = __builtin_amdgcn_rsqf(wave_sum(s) * (1.0f / DM) + EPS);
#pragma unroll
            for (int j = 0; j < 16; ++j) { const f32x4 gg = *(const f32x4*)(a.attn_norm_g + 256 * j + 4 * lane); const f32x4 y = v[j] * rstd * gg;
                u32x2 o; o.x = cvt_pk_bf16(y[0], y[1]); o.y = cvt_pk_bf16(y[2], y[3]); *(u32x2*)(XN + (size_t)m * DM + 256 * j + 4 * lane) = o; }
        }
    }
    xcd_barrier(bar, wave == 0 && fresh_lane() == 0);

    if constexpr (PHASES & 2) {
        {
            const int lane = fresh_lane(), fr = lane & 15, fq = lane >> 4;
            for (int t = gw; t < (M / 16) * 4; t += NGW) {
                const int rg = t >> 2, kq = t & 3;
                const bf16_t* xa = XN + (size_t)(rg * 16 + fr) * DM + kq * 1024 + 8 * fq;
                const bf16_t* wb = WI + (size_t)(PW + 3 * AW + fr) * DM + kq * 1024 + 8 * fq;
                f32x4 acc = {0.f, 0.f, 0.f, 0.f};
#pragma unroll 8
                for (int k = 0; k < 32; ++k) { const bf16x8 xv = *(const bf16x8*)(xa + 32 * k), wv = *(const bf16x8*)(wb + 32 * k);
                    acc = __builtin_amdgcn_mfma_f32_16x16x32_bf16(wv, xv, acc, 0, 0, 0); }
                *(f32x4*)(FL + ((size_t)kq * M + rg * 16 + fr) * NH + 4 * fq) = acc;
            }
        }
        pg8::Gemm g{XN, WI, M, PP, DM, DM, 1 << 30}; pg8::SplitOrder S; S.init(M, PP, DM, G, bx, PART, ctl + CW_SPLIT + 0 * 8192);
        pg8::EpiProj E{PROJ};
        pg8::gemm_phase<pg8::EpiProj, pg8::SplitOrder>(lds, g, S, E, wave);
    }
    xcd_barrier(bar, wave == 0 && fresh_lane() == 0);

    if constexpr (PHASES & 4) {
        const int lane = fresh_lane(), tid = wave * 64 + lane;
#define FLS(i) ((FL[(i)] + FL[(size_t)M * NH + (i)]) + (FL[(size_t)2 * M * NH + (i)] + FL[(size_t)3 * M * NH + (i)]))
        if (vcu < 16) {
            const int h = vcu; LAS float* cl = (LAS float*)lds; LAS double* tot = (LAS double*)(lds + 65536);
            const float bf = a.b_f[h]; float lf[16]; double run = 0.0;
#pragma unroll
            for (int j = 0; j < 16; ++j) lf[j] = log_sigmoid(FLS((size_t)(tid * 16 + j) * NH + h) + bf);
#pragma unroll
            for (int j = 0; j < 16; ++j) { out[O_FP + (size_t)(tid * 16 + j) * NH + h] = lf[j]; run += (double)lf[j]; }
            tot[tid] = run; __syncthreads();
            if (tid == 0) { double s = 0.0; for (int i = 0; i < 512; ++i) { const double t = tot[i]; tot[i] = s; s += t; } }
            __syncthreads();
            double c = tot[tid];
#pragma unroll
            for (int j = 0; j < 16; ++j) { c += (double)lf[j]; cl[tid * 16 + j] = (float)c; CB[(size_t)h * SEQ + tid * 16 + j] = (float)(c * (double)LOG2E); }
            __syncthreads();
            if (tid < 64) {
                float gq = fmaxf(fabsf(a.q_norm_g[tid]), fabsf(a.q_norm_g[tid + 64])), gk = fmaxf(fabsf(a.k_norm_g[tid]), fabsf(a.k_norm_g[tid + 64]));
                gq = wave_max(gq); gk = wave_max(gk);
                const float U = 11.3137085f * gq * gk; const float thr = -(2.f * U + PRUNE_T);
                if (tid < 32) { const int qb = tid; const float cP = cl[qb * 256]; int j = 0; while (j < 4 * qb && (cP - cl[64 * j + 63]) < thr) ++j; JLO[h * 32 + qb] = j; }
            }
            __syncthreads();
        } else if (vcu < 32) {
            const int b = vcu - 16, h = tid & 15, seg = tid >> 4; LAS double* tot = (LAS double*)(lds + 65536);
            const float* lsrc = a.cache_logf + ((size_t)b * PAST + seg * 64) * NH + h;
            double run = 0.0;
#pragma unroll 16
            for (int j = 0; j < 64; ++j) run += (double)lsrc[(size_t)j * NH];
            tot[tid] = run; __syncthreads();
            double c = 0.0; for (int s = 0; s < seg; ++s) c += tot[s * 16 + h];
            double ctot = 0.0; for (int s = 0; s < 32; ++s) ctot += tot[s * 16 + h];
            const float bf = a.b_f[h];
            const float lf0 = log_sigmoid(FLS((size_t)(MP + b * DS) * NH + h) + bf);
            const double cref = ctot + (double)lf0;
            float* csd = CS + (size_t)(b * NH + h) * 2080;
#pragma unroll 16
            for (int j = 0; j < 64; ++j) { c += (double)lsrc[(size_t)j * NH]; csd[seg * 64 + j] = (float)((cref - c) * (double)LOG2E); }
            if (seg == 31) {
                double cn = ctot;
                for (int s = 0; s < DS; ++s) { const float l = log_sigmoid(FLS((size_t)(MP + b * DS + s) * NH + h) + bf); out[O_FS + (size_t)(b * DS + s) * NH + h] = l; cn += (double)l; csd[PAST + s] = (float)((cref - cn) * (double)LOG2E); }
            }
            __syncthreads();
        }
#undef FLS
        for (int m = gw; m < M; m += NGW) {
            bf16_t* pr = PROJ + (size_t)m * PP + 32 * lane;
            float* ko = ((m < MP) ? out + O_KP + (size_t)m * AW : out + O_KS + (size_t)(m - MP) * AW) + 32 * lane;
            float* vo = ((m < MP) ? out + O_VP + (size_t)m * AW : out + O_VS + (size_t)(m - MP) * AW) + 32 * lane;
            const int dofs = (32 * lane) & 127;
#pragma unroll
            for (int which = 0; which < 2; ++which) {
                bf16_t* p = pr + PW + which * AW; const float* gsrc = (which == 0 ? a.q_norm_g : a.k_norm_g) + dofs;
                u32x4 w4[4];
#pragma unroll
                for (int j = 0; j < 4; ++j) w4[j] = *(const u32x4*)(p + 8 * j);
                float v[32]; float ss = 0.f;
#pragma unroll
                for (int j = 0; j < 4; ++j)
#pragma unroll
                    for (int e = 0; e < 4; ++e) { v[8 * j + 2 * e] = bf_lo(w4[j][e]); v[8 * j + 2 * e + 1] = bf_hi(w4[j][e]); }
#pragma unroll
                for (int i = 0; i < 32; ++i) ss += v[i] * v[i];
                ss += swz_xor<1>(ss); ss += swz_xor<2>(ss);
                const float rs = __builtin_amdgcn_rsqf(ss * (1.0f / HD) + EPS) * (which == 0 ? QSCALE : 1.0f);
#pragma unroll
                for (int j = 0; j < 8; ++j) { const f32x4 gg = *(const f32x4*)(gsrc + 4 * j);
#pragma unroll
                    for (int e = 0; e < 4; ++e) v[4 * j + e] = v[4 * j + e] * rs * gg[e]; }
#pragma unroll
                for (int j = 0; j < 4; ++j) { u32x4 w; w.x = cvt_pk_bf16(v[8 * j], v[8 * j + 1]); w.y = cvt_pk_bf16(v[8 * j + 2], v[8 * j + 3]); w.z = cvt_pk_bf16(v[8 * j + 4], v[8 * j + 5]); w.w = cvt_pk_bf16(v[8 * j + 6], v[8 * j + 7]);
                    *(u32x4*)(p + 8 * j) = w; }
                if (which == 1) {
#pragma unroll
                    for (int j = 0; j < 8; ++j) *(f32x4*)(ko + 4 * j) = (f32x4){v[4 * j], v[4 * j + 1], v[4 * j + 2], v[4 * j + 3]};
                }
            }
            {
                u32x4 vw[4];
#pragma unroll
                for (int j = 0; j < 4; ++j) vw[j] = *(const u32x4*)(pr + PW + 2 * AW + 8 * j);
#pragma unroll
                for (int j = 0; j < 4; ++j) { *(f32x4*)(vo + 8 * j) = (f32x4){bf_lo(vw[j][0]), bf_hi(vw[j][0]), bf_lo(vw[j][1]), bf_hi(vw[j][1])};
                    *(f32x4*)(vo + 8 * j + 4) = (f32x4){bf_lo(vw[j][2]), bf_hi(vw[j][2]), bf_lo(vw[j][3]), bf_hi(vw[j][3])}; }
            }
        }
        for (int task = gw; task < (M / 32) * 4; task += NGW) {
            const int chunk = task >> 2, g = task & 3, w = 2 << g; const int col = g * PG + 8 * lane;
            const bool samp = chunk >= MP / 32; const int r0 = chunk * 32; const int b = chunk - MP / 32;
            const float inv_w = 1.0f / (float)w;
            auto ld8 = [&](int e, float (&v)[8]) {
                if (e >= 0 || (!samp && r0 + e >= 0)) { const u32x4 wv = *(const u32x4*)(PROJ + (size_t)(r0 + e) * PP + col);
#pragma unroll
                    for (int i = 0; i < 4; ++i) { v[2 * i] = bf_lo(wv[i]); v[2 * i + 1] = bf_hi(wv[i]); } }
                else if (samp) { const float* sp = a.state_pool + ((size_t)b * PH + (PH + e)) * PW + col; const f32x4 x0 = *(const f32x4*)sp, x1 = *(const f32x4*)(sp + 4);
                    v[0] = x0[0]; v[1] = x0[1]; v[2] = x0[2]; v[3] = x0[3]; v[4] = x1[0]; v[5] = x1[1]; v[6] = x1[2]; v[7] = x1[3]; }
                else {
#pragma unroll
                    for (int i = 0; i < 8; ++i) v[i] = 0.f; }
            };
            float Sx[8];
#pragma unroll
            for (int i = 0; i < 8; ++i) Sx[i] = 0.f;
            for (int e = -(w - 1); e < 0; ++e) { float t[8]; ld8(e, t);
#pragma unroll
                for (int i = 0; i < 8; ++i) Sx[i] += t[i]; }
            for (int e = 0; e < 32; ++e) {
                float cur[8], old[8]; ld8(e, cur); ld8(e - w + 1, old);
#pragma unroll
                for (int i = 0; i < 8; ++i) Sx[i] += cur[i];
                float ic = inv_w; if (!samp) { const int pos = r0 + e; if (pos + 1 < w) ic = 1.0f / (float)(pos + 1); }
                float d[8];
#pragma unroll
                for (int i = 0; i < 8; ++i) d[i] = Sx[i] * ic - cur[i];
                u32x4 o; o.x = cvt_pk_bf16(d[0], d[1]); o.y = cvt_pk_bf16(d[2], d[3]); o.z = cvt_pk_bf16(d[4], d[5]); o.w = cvt_pk_bf16(d[6], d[7]);
                *(u32x4*)(DP + (size_t)(r0 + e) * PW + col) = o;
#pragma unroll
                for (int i = 0; i < 8; ++i) Sx[i] -= old[i];
            }
        }
        for (int t = gw; t < PH * (1 + DB); t += NGW) {
            const int s = t / PH, j = t % PH;
            const int row = (s == 0) ? (MP - PH + j) : (MP + (s - 1) * DS + (DS - PH) + j);
            float* dst = (s == 0) ? out + O_HP + (size_t)j * PW : out + O_HS + ((size_t)(s - 1) * PH + j) * PW;
#pragma unroll
            for (int i = 0; i < 4; ++i) { const u32x4 wv = *(const u32x4*)(PROJ + (size_t)row * PP + 32 * lane + 8 * i);
                *(f32x4*)(dst + 32 * lane + 8 * i) = (f32x4){bf_lo(wv[0]), bf_hi(wv[0]), bf_lo(wv[1]), bf_hi(wv[1])};
                *(f32x4*)(dst + 32 * lane + 8 * i + 4) = (f32x4){bf_lo(wv[2]), bf_hi(wv[2]), bf_lo(wv[3]), bf_hi(wv[3])}; }
        }
    }
    xcd_barrier(bar, wave == 0 && fresh_lane() == 0);

    if constexpr (PHASES & 8) {
        if constexpr (PHASES & 128) {
            pg8::Gemm g{DP, WP, M, PW, PG, PW, 2}; pg8::SplitOrder S; S.init(M, PW, PG, G, bx, nullptr, nullptr);
            pg8::EpiPool E{MIX, a.pool_scale};
            pg8::gemm_phase<pg8::EpiPool, pg8::SplitOrder>(lds, g, S, E, wave);
        }
        if constexpr (PHASES & 256) {
            int nblk = 0; for (int it = vcu; it < 256; it += G) nblk += 2;
            auto ref = [&](int i) { const int item = vcu + (i >> 1) * G, h = item >> 4, x = item & 15, qb = (i & 1) ? 31 - x : x;
                att::Blk r; r.h = h; r.qb = qb; r.jlo = JLO[h * 32 + qb]; return r; };
            if (nblk > 0) {
                att::Seam S; att::Blk cur = ref(0);
                att::attn_prime(cur, PROJ, (att::lptr)lds, S, wave);
                for (int i = 0; i < nblk; ++i) { const att::Blk nxt = (i + 1 < nblk) ? ref(i + 1) : cur; att::attn_block(cur, nxt, PROJ, MIX, CB, (att::lptr)lds, S, wave); cur = nxt; }
            }
        }
        asm volatile("s_waitcnt vmcnt(0)" ::: "memory"); __syncthreads();
        if constexpr (PHASES & 512) for (int u = vcu; u < DB * NH; u += G) att::samp_unit(u >> 4, u & 15, PROJ, a.cache_k, a.cache_v, CS, MIX, (att::lptr)lds, wave);
    }
    xcd_barrier(bar, wave == 0 && fresh_lane() == 0);

    if constexpr (PHASES & 16) {
        pg8::Gemm g{MIX, WO, M, DM, DM, DM, 1 << 30}; pg8::SplitOrder S; S.init(M, DM, DM, G, bx, PART, ctl + CW_SPLIT + 1 * 8192);
        pg8::EpiOut E{a.x_prompt, a.x_sample, out, X1G, a.mlp_norm_g, RSS};
        pg8::gemm_phase<pg8::EpiOut, pg8::SplitOrder>(lds, g, S, E, wave);
    }
    xcd_barrier(bar, wave == 0 && fresh_lane() == 0);

    if constexpr (PHASES & 32) {
        pg8::Gemm g{X1G, WU, M, DFF, DM, DM, 1 << 30}; pg8::SplitOrder S; S.init(M, DFF, DM, G, bx, PART, ctl + CW_SPLIT + 2 * 8192);
        pg8::EpiUp E{HID, RSS};
        pg8::gemm_phase<pg8::EpiUp, pg8::SplitOrder>(lds, g, S, E, wave);
    }
    xcd_barrier(bar, wave == 0 && fresh_lane() == 0);

    if constexpr (PHASES & 64) {
        pg8::Gemm g{HID, WD, M, DM, DFF, DFF, 1 << 30}; pg8::SplitOrder S; S.init(M, DM, DFF, G, bx, PART, ctl + CW_SPLIT + 3 * 8192);
        pg8::EpiDown E{out};
        pg8::gemm_phase<pg8::EpiDown, pg8::SplitOrder>(lds, g, S, E, wave);
    }
}

extern "C" void kernel_launch(void* const* d_in, const int* in_sizes, int n_in, void* d_out, int out_size, void* d_ws, size_t ws_size, hipStream_t stream) {
    static int grid = 0;
    if (grid == 0) {
        if (n_in != 17 || in_sizes[0] != MP * DM || (size_t)out_size != O_END || ws_size < WS_END) {
            fprintf(stderr, "kernel_launch: shape mismatch (n_in %d, in0 %d, out %d, ws %zu; need 17, %d, %zu, >= %zu)\n", n_in, n_in > 0 ? in_sizes[0] : -1, out_size, ws_size, MP * DM, (size_t)O_END, (size_t)WS_END);
            grid = -1; return; }
        int dev = 0, cus = 0, per_cu = 0;
        if (hipGetDevice(&dev) != hipSuccess || hipDeviceGetAttribute(&cus, hipDeviceAttributeMultiprocessorCount, dev) != hipSuccess) { grid = -1; return; }
        if (hipFuncSetAttribute((const void*)hymba_fwd, hipFuncAttributeMaxDynamicSharedMemorySize, LDS_BYTES) != hipSuccess) { fprintf(stderr, "kernel_launch: hipFuncSetAttribute failed\n"); grid = -1; return; }
        if (hipOccupancyMaxActiveBlocksPerMultiprocessor(&per_cu, (const void*)hymba_fwd, 512, LDS_BYTES) != hipSuccess || per_cu < 1) { fprintf(stderr, "kernel_launch: occupancy query says %d\n", per_cu); }
        (void)hipGetLastError();
        grid = cus;
    }
    if (grid < 0) return;
    if (hipMemsetAsync((char*)d_ws + WS_CTL, 0, CTL_ZERO_BYTES, stream) != hipSuccess) { fprintf(stderr, "kernel_launch: memset failed\n"); return; }
    Args a{};
    a.x_prompt = (const float*)d_in[0]; a.x_sample = (const float*)d_in[1]; a.cache_k = (const float*)d_in[2]; a.cache_v = (const float*)d_in[3]; a.cache_logf = (const float*)d_in[4];
    a.state_pool = (const float*)d_in[5]; a.attn_norm_g = (const float*)d_in[6]; a.w_in = (const float*)d_in[7]; a.b_f = (const float*)d_in[8]; a.q_norm_g = (const float*)d_in[9];
    a.k_norm_g = (const float*)d_in[10]; a.w_pool = (const float*)d_in[11]; a.pool_scale = (const float*)d_in[12]; a.w_out = (const float*)d_in[13]; a.mlp_norm_g = (const float*)d_in[14];
    a.w_up = (const float*)d_in[15]; a.w_down = (const float*)d_in[16];
    a.out = (float*)d_out; a.ws = (unsigned char*)d_ws;
    hipLaunchKernelGGL(hymba_fwd, dim3(grid), dim3(512), LDS_BYTES, stream, a);
    const hipError_t le = hipPeekAtLastError();
    if (le != hipSuccess) fprintf(stderr, "kernel_launch: launch failed: %s\n", hipGetErrorName(le));
}
```

```cpp
#include <hip/hip_runtime.h>
#include <cstdio>
#include <cstdint>

#define LAS __attribute__((address_space(3)))
#define GAS __attribute__((address_space(1)))
typedef unsigned short bf16_t;
typedef short bf16x8 __attribute__((ext_vector_type(8)));
typedef short s16x4 __attribute__((ext_vector_type(4)));
typedef float f32x2 __attribute__((ext_vector_type(2)));
typedef float f32x4 __attribute__((ext_vector_type(4)));
typedef float f32x16 __attribute__((ext_vector_type(16)));
typedef unsigned u32x2 __attribute__((ext_vector_type(2)));
typedef unsigned u32x4 __attribute__((ext_vector_type(4)));

constexpr int DM = 4096, SEQ = 8192, DB = 16, DS = 32, PAST = 2048;
constexpr int MP = SEQ, MS = DB * DS, M = MP + MS;
constexpr int PW = 2048, AW = 2048, NH = 16, HD = 128, PH = 15, PG = 512;
constexpr int NPROJ = PW + 3 * AW + NH;
constexpr int NPROJ_PAD = 8448;
constexpr int PP = 8192;
constexpr int DFF = 16384;
constexpr float EPS = 1e-6f;
constexpr float QSCALE = 0.08838834764831845f * 1.4426950408889634f;
constexpr float LOG2E = 1.4426950408889634f;
constexpr float PRUNE_T = 40.0f;
constexpr size_t O_YP = 0, O_YS = (size_t)MP * DM, O_KP = O_YS + (size_t)MS * DM, O_VP = O_KP + (size_t)MP * AW, O_FP = O_VP + (size_t)MP * AW,
                 O_HP = O_FP + (size_t)MP * NH, O_KS = O_HP + (size_t)PH * PW, O_VS = O_KS + (size_t)MS * AW, O_FS = O_VS + (size_t)MS * AW,
                 O_HS = O_FS + (size_t)MS * NH, O_END = O_HS + (size_t)DB * PH * PW;
static_assert(O_END == 71964672, "output size");
constexpr size_t MiB = 1u << 20;
constexpr size_t WS_CTL = 0, CTL_ZERO_BYTES = 1 * MiB;
constexpr size_t WS_WI = 2 * MiB, WS_WP = 68 * MiB, WS_WO = 70 * MiB, WS_WU = 102 * MiB, WS_WD = 230 * MiB, WS_XN = 358 * MiB, WS_PROJ = 426 * MiB,
                 WS_FL = 562 * MiB, WS_CB = 565 * MiB, WS_CS = 566 * MiB, WS_DP = 569 * MiB, WS_MIX = 603 * MiB, WS_X1G = 671 * MiB, WS_HID = 739 * MiB, WS_PART = 1011 * MiB, WS_END = 1075 * MiB;
static_assert(WS_WI + (size_t)NPROJ_PAD * DM * 2 <= WS_WP && WS_XN + (size_t)M * DM * 2 <= WS_PROJ && WS_PROJ + (size_t)M * PP * 2 <= WS_FL && WS_FL + (size_t)4 * M * NH * 4 <= WS_CB && WS_CS + (size_t)DB * NH * 2080 * 4 <= WS_DP &&
              WS_DP + (size_t)M * PW * 2 <= WS_MIX && WS_HID + (size_t)M * DFF * 2 <= WS_PART && WS_PART + (size_t)256 * 65536 * 4 <= WS_END, "ws map");
constexpr int CW_BAR = 4096;
constexpr int CW_JLO = 16384;
constexpr int CW_RSS = 32768;
constexpr int CW_SPLIT = 65536;
static_assert((CW_RSS + 16384 + M) <= CW_SPLIT && (CW_SPLIT + 8 * 8192) * 4 <= (int)CTL_ZERO_BYTES, "ctl");
constexpr int LDS_BYTES = 147456;
constexpr int MISC_OFF = 131072 + 320;

__device__ __forceinline__ int fresh_lane() { int l; asm volatile("v_mbcnt_lo_u32_b32 %0, -1, 0\n\tv_mbcnt_hi_u32_b32 %0, -1, %0" : "=v"(l)); return l; }
template <int X> __device__ __forceinline__ float swz_xor(float v) { return __int_as_float(__builtin_amdgcn_ds_swizzle(__float_as_int(v), (X << 10) | 0x1f)); }
__device__ __forceinline__ float half_sum(float v) { auto rr = __builtin_amdgcn_permlane32_swap(__float_as_uint(v), __float_as_uint(v), false, false); return __uint_as_float(rr[0]) + __uint_as_float(rr[1]); }
__device__ __forceinline__ float half_max(float v) { auto rr = __builtin_amdgcn_permlane32_swap(__float_as_uint(v), __float_as_uint(v), false, false); return fmaxf(__uint_as_float(rr[0]), __uint_as_float(rr[1])); }
__device__ __forceinline__ unsigned cvt_pk_bf16(float lo, float hi) { unsigned r; asm volatile("v_cvt_pk_bf16_f32 %0, %1, %2" : "=v"(r) : "v"(lo), "v"(hi)); return r; }
__device__ __forceinline__ float bf_lo(unsigned w) { return __uint_as_float(w << 16); }
__device__ __forceinline__ float bf_hi(unsigned w) { return __uint_as_float(w & 0xffff0000u); }
__device__ __forceinline__ bf16x8 pack8(f32x4 a, f32x4 b) { u32x4 w = {cvt_pk_bf16(a[0], a[1]), cvt_pk_bf16(a[2], a[3]), cvt_pk_bf16(b[0], b[1]), cvt_pk_bf16(b[2], b[3])}; return __builtin_bit_cast(bf16x8, w); }

namespace pg8 {
constexpr int BM = 256, BK = 64, HALF = 128, HTB = HALF * BK * 2, STAGE_BYTES = 8 * HTB, NXCD = 8, WGM = 8;
__host__ __device__ __forceinline__ int lds_byte(int r, int c) { const int st = (r >> 4) * 2 + (c >> 5), rr = r & 15, cc = c & 31, ob = rr * 64 + cc * 2; return st * 1024 + (ob ^ (((ob >> 9) & 1) << 5)); }
__host__ __device__ __forceinline__ void stage_rc(int b, int& R, int& C) { const int st = b / 1024, sb = b % 1024, swz = sb ^ (((sb >> 9) & 1) << 5); R = (st >> 1) * 16 + swz / 64; C = (st & 1) * 32 + (swz % 64) / 2; }
__host__ __device__ __forceinline__ int perm32(int rho) { const int n = rho >> 4, i = rho & 15; return 8 * (i >> 2) + 4 * n + (i & 3); }
struct Unit { int pm, pn, kt0, nt, part; };
struct Gemm { const bf16_t* A; const bf16_t* Bt; int M, N, K, lda, adiv; };
struct SplitOrder {
    int nM, nN, nwg, G, c, R, r, s, ntK, nfull; float* part; unsigned* cnt;
    __device__ __forceinline__ void init(int M_, int N_, int K_, int G_, int c_, float* part_, unsigned* cnt_) {
        nM = M_ / BM; nN = N_ / BM; nwg = nM * nN; G = G_; c = c_; ntK = K_ / BK; part = part_; cnt = cnt_;
        r = 0; s = 1; nfull = nwg;
        if (G == 256 && part_ != nullptr) { const int rem = nwg % 256; if (rem != 0 && 256 % rem == 0) { const int ss = 256 / rem; if (ntK % ss == 0 && ((ntK / ss) & 1) == 0 && ntK / ss >= 4) { r = rem; s = ss; nfull = nwg - rem; } } }
    }
    __device__ __forceinline__ void map(int wgid, Unit& u) const {
        { const int q = nwg / NXCD, rr = nwg % NXCD, xcd = wgid % NXCD, off = wgid / NXCD; wgid = (xcd < rr ? xcd * (q + 1) : rr * (q + 1) + (xcd - rr) * q) + off; }
        const int nig = WGM * nN, gid = wgid / nig, fm = gid * WGM, gsz = (nM - fm) < WGM ? (nM - fm) : WGM;
        u.pm = fm + ((wgid % nig) % gsz); u.pn = (wgid % nig) / gsz;
    }
    __device__ __forceinline__ bool next(int i, Unit& u) const {
        int wg, kt0 = 0, nt = ntK, part = -1; bool ok;
        if (r) {
            if (i == 0) { wg = nfull + c / s; nt = ntK / s; kt0 = (c % s) * nt; part = c; ok = true; }
            else { const long L = (long)(i - 1) * G + c; ok = L < nfull; wg = ok ? (int)L : 0; }
        } else { const long L = (long)i * G + c; ok = L < nwg; wg = ok ? (int)L : 0; }
        Unit t; map(wg, t); t.kt0 = kt0; t.nt = nt; t.part = part; u = t; return ok;
    }
};
__device__ __forceinline__ void store16_sc1(float* p, f32x4 v) { asm volatile("global_store_dwordx4 %0, %1, off sc1\n\ts_nop 1" :: "v"(p), "v"(v) : "memory"); }
template <class Epi, class Sched>
__device__ __forceinline__ void gemm_phase(LAS unsigned char* lds, const Gemm g, const Sched& S, const Epi& E, const int wid) {
    const int lane = fresh_lane(), tid = wid * 64 + lane, wr = wid >> 2, wc = wid & 3, fr = lane & 15, fq = lane >> 4;
    const int K = g.K;
    unsigned voffA[2], voffB[2];
#pragma unroll
    for (int i = 0; i < 2; ++i) { int R, C; stage_rc(tid * 16 + i * 8192, R, C); const int Rb = (R & ~31) + perm32(R & 31);
        voffA[i] = (unsigned)(R * g.lda + C) * 2u; voffB[i] = (unsigned)(Rb * K + C) * 2u; }
    const size_t kstep = (size_t)(BK * 2);
    const size_t hstepA = (size_t)HALF * g.lda * 2, hstepB = (size_t)HALF * K * 2;
    const size_t tstepA = 2 * hstepA, tstepB = 2 * hstepB;
    const unsigned ldsw = (unsigned)wid * 1024u;
    const int aoff = lds_byte(wr * 64 + fr, fq * 8), boff = lds_byte(wc * 32 + fr, fq * 8);
#define PG8_SA(b, h) (((b) * 2 + (h)) * HTB)
#define PG8_SB(b, h) ((4 + (b) * 2 + (h)) * HTB)
#define PG8_STAGE(bufoff, gbase, voff) do { _Pragma("unroll") for (int _i = 0; _i < 2; ++_i) \
        __builtin_amdgcn_global_load_lds((const unsigned*)((const char*)(gbase) + (voff)[_i]), (LAS unsigned*)(lds + (bufoff) + ldsw + _i * 8192), 16, 0, 0); } while (0)
#define PG8_LDA(dst, b, h) do { _Pragma("unroll") for (int m = 0; m < 4; ++m) _Pragma("unroll") for (int k = 0; k < 2; ++k) dst[m][k] = *(const LAS bf16x8*)(lds + PG8_SA(b, h) + aoff + m * 2048 + k * 1024); } while (0)
#define PG8_LDB(dst, b, h) do { _Pragma("unroll") for (int n = 0; n < 2; ++n) _Pragma("unroll") for (int k = 0; k < 2; ++k) dst[n][k] = *(const LAS bf16x8*)(lds + PG8_SB(b, h) + boff + n * 2048 + k * 1024); } while (0)
#define PG8_MMA(ai, bj, At, Bt) do { __builtin_amdgcn_s_setprio(1); _Pragma("unroll") for (int m = 0; m < 4; ++m) _Pragma("unroll") for (int n = 0; n < 2; ++n) _Pragma("unroll") for (int k = 0; k < 2; ++k) \
        acc[ai][bj][m][n] = __builtin_amdgcn_mfma_f32_16x16x32_bf16(Bt[n][k], At[m][k], acc[ai][bj][m][n], 0, 0, 0); __builtin_amdgcn_s_setprio(0); } while (0)
#define PG8_WAIT_V(n) asm volatile("s_waitcnt vmcnt(" #n ")" ::: "memory")
#define PG8_WAIT_L(n) asm volatile("s_waitcnt lgkmcnt(" #n ")" ::: "memory")
#define PG8_BAR __builtin_amdgcn_s_barrier()
#define PG8_SCHED __builtin_amdgcn_sched_barrier(0)
    Unit cur, nxt; int ui = 0;
    if (!S.next(0, cur)) return;
    f32x4 acc[2][2][4][2];
#pragma unroll
    for (int a = 0; a < 2; ++a)
#pragma unroll
        for (int b = 0; b < 2; ++b)
#pragma unroll
            for (int m = 0; m < 4; ++m)
#pragma unroll
                for (int n = 0; n < 2; ++n) acc[a][b][m][n] = (f32x4){0.f, 0.f, 0.f, 0.f};
    bf16x8 At[4][2], B0[2][2], B1[2][2];
    const char* cA = (const char*)g.A + (size_t)cur.pm * tstepA + (size_t)(cur.pn / g.adiv) * K * 2 + (size_t)cur.kt0 * kstep; const char* cB = (const char*)g.Bt + (size_t)cur.pn * tstepB + (size_t)cur.kt0 * kstep;
    PG8_STAGE(PG8_SB(0, 0), cB, voffB); PG8_STAGE(PG8_SB(0, 1), cB + hstepB, voffB); PG8_STAGE(PG8_SA(0, 0), cA, voffA); PG8_STAGE(PG8_SA(0, 1), cA + hstepA, voffA);
    if (wr == 1) PG8_BAR;
    PG8_WAIT_V(2); PG8_BAR;
    PG8_STAGE(PG8_SB(1, 0), cB + kstep, voffB); PG8_STAGE(PG8_SA(1, 0), cA + kstep, voffA); PG8_STAGE(PG8_SB(1, 1), cB + hstepB + kstep, voffB);
    PG8_WAIT_V(6); PG8_BAR;
    for (;;) {
        const bool has_next = S.next(ui + 1, nxt);
        const char* nA = has_next ? (const char*)g.A + (size_t)nxt.pm * tstepA + (size_t)(nxt.pn / g.adiv) * K * 2 + (size_t)nxt.kt0 * kstep : cA; const char* nB = has_next ? (const char*)g.Bt + (size_t)nxt.pn * tstepB + (size_t)nxt.kt0 * kstep : cB;
        const int nt = cur.nt;
        for (int t = 0; t < nt; t += 2) {
            const bool last = (t == nt - 2);
            const char* a1 = cA + (size_t)(t + 1) * kstep;
            const char* a2 = last ? nA : cA + (size_t)(t + 2) * kstep; const char* b2 = last ? nB : cB + (size_t)(t + 2) * kstep;
            const char* a3 = a2 + kstep; const char* b3 = b2 + kstep;
            PG8_LDB(B0, 0, 0); PG8_LDB(B1, 0, 1); PG8_SCHED; PG8_LDA(At, 0, 0); PG8_STAGE(PG8_SA(1, 1), a1 + hstepA, voffA);
            PG8_WAIT_V(8); PG8_WAIT_L(0); PG8_BAR; PG8_MMA(0, 0, At, B0); PG8_MMA(0, 1, At, B1); PG8_BAR; PG8_SCHED;
            PG8_LDA(At, 0, 1); PG8_STAGE(PG8_SB(0, 0), b2, voffB); PG8_STAGE(PG8_SB(0, 1), b2 + hstepB, voffB); PG8_STAGE(PG8_SA(0, 0), a2, voffA);
            PG8_WAIT_V(8); PG8_WAIT_L(0); PG8_BAR; PG8_MMA(1, 0, At, B0); PG8_MMA(1, 1, At, B1); PG8_BAR; PG8_SCHED;
            PG8_LDB(B0, 1, 0); PG8_LDB(B1, 1, 1); PG8_SCHED; PG8_LDA(At, 1, 0); PG8_STAGE(PG8_SA(0, 1), a2 + hstepA, voffA);
            PG8_WAIT_V(8); PG8_WAIT_L(0); PG8_BAR; PG8_MMA(0, 0, At, B0); PG8_MMA(0, 1, At, B1); PG8_BAR; PG8_SCHED;
            PG8_LDA(At, 1, 1); PG8_STAGE(PG8_SB(1, 0), b3, voffB); PG8_STAGE(PG8_SB(1, 1), b3 + hstepB, voffB); PG8_STAGE(PG8_SA(1, 0), a3, voffA);
            PG8_WAIT_V(8); PG8_WAIT_L(0); PG8_BAR; PG8_MMA(1, 0, At, B0); PG8_MMA(1, 1, At, B1); PG8_BAR; PG8_SCHED;
        }
        if (wr == 0) PG8_BAR;
        if (cur.part >= 0) {
            float* pb = S.part + (size_t)cur.part * 65536 + (size_t)(wr * 64 + fr) * 256 + wc * 32 + 8 * fq;
#pragma unroll
            for (int ai = 0; ai < 2; ++ai)
#pragma unroll
                for (int m = 0; m < 4; ++m)
#pragma unroll
                    for (int bj = 0; bj < 2; ++bj)
#pragma unroll
                        for (int n = 0; n < 2; ++n) store16_sc1(pb + (size_t)(ai * HALF + m * 16) * 256 + bj * HALF + 4 * n, acc[ai][bj][m][n]);
            asm volatile("s_waitcnt vmcnt(0)" ::: "memory");
            if (lane == 0) __hip_atomic_fetch_add(S.cnt + 64 * (cur.part / S.s), 1u, __ATOMIC_RELAXED, __HIP_MEMORY_SCOPE_AGENT);
        } else E(acc, cur, wr, wc, fr, fq);
        if (!has_next) break;
#pragma unroll
        for (int a = 0; a < 2; ++a)
#pragma unroll
            for (int b = 0; b < 2; ++b)
#pragma unroll
                for (int m = 0; m < 4; ++m)
#pragma unroll
                    for (int n = 0; n < 2; ++n) acc[a][b][m][n] = (f32x4){0.f, 0.f, 0.f, 0.f};
        cur = nxt; cA = nA; cB = nB; ++ui;
        if (wr == 1) PG8_BAR;
    }
    PG8_WAIT_V(0);
    PG8_BAR;
    if (S.r) {
        const int su = S.c / S.s, j = S.c % S.s, rows = BM / S.s; Unit fu; S.map(S.nfull + su, fu);
        if (wid == 0) { unsigned* cw = S.cnt + 64 * su; unsigned sp = 0;
            while ((unsigned)__builtin_amdgcn_readfirstlane(__hip_atomic_load(cw, __ATOMIC_RELAXED, __HIP_MEMORY_SCOPE_AGENT)) < 8u * (unsigned)S.s) { __builtin_amdgcn_s_sleep(2); if (++sp > (1u << 22)) break; }
            __builtin_amdgcn_fence(__ATOMIC_ACQUIRE, "agent"); asm volatile("s_waitcnt vmcnt(0)" ::: "memory"); }
        __syncthreads();
        const float* pbase = S.part + (size_t)(su * S.s) * 65536;
        for (int rr = wid; rr < rows; rr += 8) { const int row = j * rows + rr; f32x4 v = {0.f, 0.f, 0.f, 0.f};
            for (int q = 0; q < S.s; ++q) v += *(const f32x4*)(pbase + (size_t)q * 65536 + row * 256 + lane * 4);
            E.fix(v, fu.pm * BM + row, fu.pn * BM + lane * 4, lane); }
    }
#undef PG8_SA
#undef PG8_SB
#undef PG8_STAGE
#undef PG8_LDA
#undef PG8_LDB
#undef PG8_MMA
#undef PG8_WAIT_V
#undef PG8_WAIT_L
#undef PG8_BAR
#undef PG8_SCHED
}

struct EpiProj {
    bf16_t* O;
    __device__ __forceinline__ void fix(f32x4 v, int row, int col, int) const { u32x2 w; w.x = cvt_pk_bf16(v[0], v[1]); w.y = cvt_pk_bf16(v[2], v[3]); *(u32x2*)(O + (size_t)row * PP + col) = w; }
    __device__ __forceinline__ void operator()(const f32x4 (&acc)[2][2][4][2], const Unit& u, int wr, int wc, int fr, int fq) const {
        const int row0 = u.pm * BM + wr * 64 + fr;
        const int col0 = u.pn * BM + wc * 32 + 8 * fq;
#pragma unroll
        for (int ai = 0; ai < 2; ++ai)
#pragma unroll
            for (int m = 0; m < 4; ++m) { bf16_t* rowp = O + (size_t)(row0 + ai * HALF + m * 16) * PP + col0;
#pragma unroll
                for (int bj = 0; bj < 2; ++bj) { const f32x4 v0 = acc[ai][bj][m][0], v1 = acc[ai][bj][m][1];
                    u32x4 w; w.x = cvt_pk_bf16(v0[0], v0[1]); w.y = cvt_pk_bf16(v0[2], v0[3]); w.z = cvt_pk_bf16(v1[0], v1[1]); w.w = cvt_pk_bf16(v1[2], v1[3]);
                    *(u32x4*)(rowp + bj * HALF) = w; } }
    }
};
struct EpiPool {
    bf16_t* O; const float* scale;
    __device__ __forceinline__ void fix(f32x4, int, int, int) const {}
    __device__ __forceinline__ void operator()(const f32x4 (&acc)[2][2][4][2], const Unit& u, int wr, int wc, int fr, int fq) const {
        const int row0 = u.pm * BM + wr * 64 + fr, col0 = u.pn * BM + wc * 32 + 8 * fq;
        f32x4 sv[2][2];
#pragma unroll
        for (int bj = 0; bj < 2; ++bj)
#pragma unroll
            for (int n = 0; n < 2; ++n) sv[bj][n] = *(const f32x4*)(scale + col0 + bj * HALF + 4 * n);
#pragma unroll
        for (int ai = 0; ai < 2; ++ai)
#pragma unroll
            for (int m = 0; m < 4; ++m) { bf16_t* rowp = O + (size_t)(row0 + ai * HALF + m * 16) * DM + col0;
#pragma unroll
                for (int bj = 0; bj < 2; ++bj) { const f32x4 v0 = acc[ai][bj][m][0] * sv[bj][0], v1 = acc[ai][bj][m][1] * sv[bj][1];
                    u32x4 w; w.x = cvt_pk_bf16(v0[0], v0[1]); w.y = cvt_pk_bf16(v0[2], v0[3]); w.z = cvt_pk_bf16(v1[0], v1[1]); w.w = cvt_pk_bf16(v1[2], v1[3]);
                    *(u32x4*)(rowp + bj * HALF) = w; } }
    }
};
struct EpiOut {
    const float* xp; const float* xs; float* Y; bf16_t* X1G; const float* g2; float* rowss;
    __device__ __forceinline__ void fix(f32x4 v, int row, int col, int lane) const {
        const float* xin = (row < MP) ? xp + (size_t)row * DM : xs + (size_t)(row - MP) * DM;
        const f32x4 x1 = *(const f32x4*)(xin + col) + v; *(f32x4*)(Y + (size_t)row * DM + col) = x1;
        const f32x4 w = x1 * *(const f32x4*)(g2 + col); u32x2 o; o.x = cvt_pk_bf16(w[0], w[1]); o.y = cvt_pk_bf16(w[2], w[3]); *(u32x2*)(X1G + (size_t)row * DM + col) = o;
        float ss = (x1[0] * x1[0] + x1[1] * x1[1]) + (x1[2] * x1[2] + x1[3] * x1[3]);
        ss += swz_xor<1>(ss); ss += swz_xor<2>(ss); ss += swz_xor<4>(ss); ss += swz_xor<8>(ss); ss += swz_xor<16>(ss); ss = half_sum(ss);
        if (lane == 0) __hip_atomic_fetch_add(rowss + row, ss, __ATOMIC_RELAXED, __HIP_MEMORY_SCOPE_AGENT);
    }
    __device__ __forceinline__ void operator()(const f32x4 (&acc)[2][2][4][2], const Unit& u, int wr, int wc, int fr, int fq) const {
        const int row0 = u.pm * BM + wr * 64 + fr, col0 = u.pn * BM + wc * 32 + 8 * fq;
        const float* xin = (u.pm < MP / BM) ? xp : xs - (size_t)MP * DM;
        f32x4 gv[2][2];
#pragma unroll
        for (int bj = 0; bj < 2; ++bj)
#pragma unroll
            for (int n = 0; n < 2; ++n) gv[bj][n] = *(const f32x4*)(g2 + col0 + bj * HALF + 4 * n);
#pragma unroll
        for (int ai = 0; ai < 2; ++ai) {
            f32x4 xv[4][2][2];
#pragma unroll
            for (int m = 0; m < 4; ++m)
#pragma unroll
                for (int bj = 0; bj < 2; ++bj)
#pragma unroll
                    for (int n = 0; n < 2; ++n) xv[m][bj][n] = *(const f32x4*)(xin + (size_t)(row0 + ai * HALF + m * 16) * DM + col0 + bj * HALF + 4 * n);
#pragma unroll
            for (int m = 0; m < 4; ++m) { const int row = row0 + ai * HALF + m * 16; const size_t off = (size_t)row * DM + col0; float ss = 0.f;
#pragma unroll
                for (int bj = 0; bj < 2; ++bj) {
                    const f32x4 v0 = xv[m][bj][0] + acc[ai][bj][m][0], v1 = xv[m][bj][1] + acc[ai][bj][m][1];
                    *(f32x4*)(Y + off + bj * HALF) = v0; *(f32x4*)(Y + off + bj * HALF + 4) = v1;
                    ss += (v0[0] * v0[0] + v0[1] * v0[1]) + (v0[2] * v0[2] + v0[3] * v0[3]) + (v1[0] * v1[0] + v1[1] * v1[1]) + (v1[2] * v1[2] + v1[3] * v1[3]);
                    const f32x4 w0 = v0 * gv[bj][0], w1 = v1 * gv[bj][1];
                    u32x4 w; w.x = cvt_pk_bf16(w0[0], w0[1]); w.y = cvt_pk_bf16(w0[2], w0[3]); w.z = cvt_pk_bf16(w1[0], w1[1]); w.w = cvt_pk_bf16(w1[2], w1[3]);
                    *(u32x4*)(X1G + off + bj * HALF) = w; }
                ss += swz_xor<16>(ss); ss = half_sum(ss);
                if (fq == 0) __hip_atomic_fetch_add(rowss + row, ss, __ATOMIC_RELAXED, __HIP_MEMORY_SCOPE_AGENT); }
            asm volatile("" ::: "memory"); }
    }
};
struct EpiUp {
    bf16_t* O; const float* rowss;
    __device__ __forceinline__ void fix(f32x4 v, int row, int col, int) const {
        const float rs = __builtin_amdgcn_rsqf(rowss[row] * (1.0f / DM) + EPS); v = v * rs;
#pragma unroll
        for (int j = 0; j < 4; ++j) v[j] = fmaxf(v[j], 0.f);
        v = v * v; u32x2 o; o.x = cvt_pk_bf16(v[0], v[1]); o.y = cvt_pk_bf16(v[2], v[3]); *(u32x2*)(O + (size_t)row * DFF + col) = o;
    }
    __device__ __forceinline__ void operator()(const f32x4 (&acc)[2][2][4][2], const Unit& u, int wr, int wc, int fr, int fq) const {
        const int row0 = u.pm * BM + wr * 64 + fr, col0 = u.pn * BM + wc * 32 + 8 * fq;
#pragma unroll
        for (int ai = 0; ai < 2; ++ai)
#pragma unroll
            for (int m = 0; m < 4; ++m) { const int row = row0 + ai * HALF + m * 16; bf16_t* rowp = O + (size_t)row * DFF + col0;
                const float rs = __builtin_amdgcn_rsqf(rowss[row] * (1.0f / DM) + EPS);
#pragma unroll
                for (int bj = 0; bj < 2; ++bj) { f32x4 v0 = acc[ai][bj][m][0] * rs, v1 = acc[ai][bj][m][1] * rs;
#pragma unroll
                    for (int j = 0; j < 4; ++j) { v0[j] = fmaxf(v0[j], 0.f); v1[j] = fmaxf(v1[j], 0.f); }
                    v0 = v0 * v0; v1 = v1 * v1;
                    u32x4 w; w.x = cvt_pk_bf16(v0[0], v0[1]); w.y = cvt_pk_bf16(v0[2], v0[3]); w.z = cvt_pk_bf16(v1[0], v1[1]); w.w = cvt_pk_bf16(v1[2], v1[3]);
                    *(u32x4*)(rowp + bj * HALF) = w; } }
    }
};
struct EpiDown {
    float* Y;
    __device__ __forceinline__ void fix(f32x4 v, int row, int col, int) const { float* p = Y + (size_t)row * DM + col; *(f32x4*)p = *(const f32x4*)p + v; }
    __device__ __forceinline__ void operator()(const f32x4 (&acc)[2][2][4][2], const Unit& u, int wr, int wc, int fr, int fq) const {
        const int row0 = u.pm * BM + wr * 64 + fr, col0 = u.pn * BM + wc * 32 + 8 * fq;
#pragma unroll
        for (int ai = 0; ai < 2; ++ai) {
            f32x4 yv[4][2][2];
#pragma unroll
            for (int m = 0; m < 4; ++m)
#pragma unroll
                for (int bj = 0; bj < 2; ++bj)
#pragma unroll
                    for (int n = 0; n < 2; ++n) yv[m][bj][n] = *(const f32x4*)(Y + (size_t)(row0 + ai * HALF + m * 16) * DM + col0 + bj * HALF + 4 * n);
#pragma unroll
            for (int m = 0; m < 4; ++m)
#pragma unroll
                for (int bj = 0; bj < 2; ++bj)
#pragma unroll
                    for (int n = 0; n < 2; ++n) *(f32x4*)(Y + (size_t)(row0 + ai * HALF + m * 16) * DM + col0 + bj * HALF + 4 * n) = yv[m][bj][n] + acc[ai][bj][m][n];
            asm volatile("" ::: "memory"); }
    }
};
}

namespace att {
constexpr int D = 128, NW = 8, QBLK = 32, KVBLK = 64, QB = NW * QBLK;
constexpr int SHM_V = KVBLK * D * 2, SHM_K = KVBLK * D * 2;
constexpr int OFF_K = 2 * SHM_V, OFF_WS = 2 * SHM_V + 2 * SHM_K, OFF_CB = OFF_WS + NW * 64 * 4, LDS_NEED = OFF_CB + 8192 * 4;
constexpr int PO = DM;
constexpr float THR2 = 8.f * LOG2E;
typedef LAS char* lptr;
#define KSWZ(row, colB) ((row) * 256 + ((colB) ^ (((row) & 7) << 4)))
#define SBAR() __builtin_amdgcn_sched_barrier(0)
__device__ __forceinline__ int v_st(int k, int c) { const int kk = (k & ~0xC) | ((k & 4) << 1) | ((k & 8) >> 1); return ((kk >> 3) * 4 + (c >> 5)) * 512 + ((kk & 7) * 32 + (c & 31)) * 2; }
__device__ __forceinline__ int v_rd_base(int lane) { return ((lane & 3) << 3) | (((lane >> 2) & 3) << 6) | (((lane >> 4) & 1) << 5) | (((lane >> 5) & 1) << 8); }
constexpr int v_rd_off(int d0, int ks, int half) { return d0 * 512 + ks * 4096 + half * 2048; }
__device__ __forceinline__ int crow(int r, int hi) { return (r & 3) + 8 * (r >> 2) + 4 * hi; }
__device__ __forceinline__ bf16x8 load8(const bf16_t* p) { return *reinterpret_cast<const bf16x8*>(p); }
__device__ __forceinline__ void mask_tile(f32x16& p0, f32x16& p1, int dq) {
    const float NEG = -__builtin_inff();
#pragma unroll
    for (int r = 0; r < 16; ++r) { const int c = (r & 3) + 8 * (r >> 2);
        if (dq - c < 0) p0[r] = NEG;
        if (dq - c - 32 < 0) p1[r] = NEG; }
}
__device__ __forceinline__ void partialSM(f32x16& p0, f32x16& p1, float& m_reg, float& mn, float& alpha) {
    float pmax = p0[0];
#pragma unroll
    for (int r = 1; r < 16; ++r) pmax = fmaxf(pmax, p0[r]);
#pragma unroll
    for (int r = 0; r < 16; ++r) pmax = fmaxf(pmax, p1[r]);
    { auto rr = __builtin_amdgcn_permlane32_swap(__float_as_uint(pmax), __float_as_uint(pmax), false, false);
      pmax = fmaxf(__uint_as_float(rr[0]), __uint_as_float(rr[1])); }
    if (__builtin_expect(__all((pmax - m_reg) <= THR2), 1)) { mn = m_reg; alpha = 1.f; }
    else { mn = fmaxf(m_reg, pmax); alpha = __builtin_amdgcn_exp2f(m_reg - mn); m_reg = mn; }
#pragma unroll
    for (int r = 0; r < 16; ++r) p0[r] = p0[r] - mn;
#pragma unroll
    for (int r = 0; r < 16; ++r) p1[r] = p1[r] - mn;
#pragma unroll
    for (int r = 0; r < 16; ++r) p0[r] = __builtin_amdgcn_exp2f(p0[r]);
}
__device__ __forceinline__ void finishSM(f32x16& p0, f32x16& p1, float alpha, float& l_reg, bf16x8& pa0, bf16x8& pa1, bf16x8& pa2, bf16x8& pa3) {
#pragma unroll
    for (int r = 0; r < 16; ++r) p1[r] = __builtin_amdgcn_exp2f(p1[r]);
    float ps = 0;
#pragma unroll
    for (int r = 0; r < 16; ++r) ps += p0[r];
#pragma unroll
    for (int r = 0; r < 16; ++r) ps += p1[r];
    { auto rr = __builtin_amdgcn_permlane32_swap(__float_as_uint(ps), __float_as_uint(ps), false, false);
      ps = __uint_as_float(rr[0]) + __uint_as_float(rr[1]); }
    l_reg = l_reg * alpha + ps;
#define PK4(P, B_, OUT) do { unsigned a0 = cvt_pk_bf16(P[B_+0], P[B_+1]), a1 = cvt_pk_bf16(P[B_+2], P[B_+3]);                          \
        unsigned b0 = cvt_pk_bf16(P[B_+4], P[B_+5]), b1 = cvt_pk_bf16(P[B_+6], P[B_+7]);                                             \
        auto r0 = __builtin_amdgcn_permlane32_swap(a0, b0, false, false); auto r1 = __builtin_amdgcn_permlane32_swap(a1, b1, false, false); \
        u32x4 w = {r0[0], r1[0], r0[1], r1[1]}; OUT = __builtin_bit_cast(bf16x8, w); } while (0)
    PK4(p0, 0, pa0); PK4(p0, 8, pa1); PK4(p1, 0, pa2); PK4(p1, 8, pa3);
}
template <int KB>
__device__ __forceinline__ void qkt(f32x16& p0, f32x16& p1, lptr K_lds, const LAS float* cbt, int r32, int hi, const bf16x8* qr) {
#pragma unroll
    for (int i = 0; i < 4; ++i) { const f32x4 b0 = *(const LAS f32x4*)(cbt + 8 * i), b1 = *(const LAS f32x4*)(cbt + 32 + 8 * i);
        p0[4 * i] = b0[0]; p0[4 * i + 1] = b0[1]; p0[4 * i + 2] = b0[2]; p0[4 * i + 3] = b0[3];
        p1[4 * i] = b1[0]; p1[4 * i + 1] = b1[1]; p1[4 * i + 2] = b1[2]; p1[4 * i + 3] = b1[3]; }
    lptr kb[4];
#pragma unroll
    for (int dd = 0; dd < 4; ++dd) kb[dd] = K_lds + KB * SHM_K + KSWZ(r32, (dd * 16 + hi * 8) * 2);
#pragma unroll
    for (int d0 = 0; d0 < 8; ++d0) { lptr a = kb[d0 & 3] + (d0 >> 2) * 128;
        bf16x8 b0 = *reinterpret_cast<const LAS bf16x8*>(a);
        bf16x8 b1 = *reinterpret_cast<const LAS bf16x8*>(a + 32 * 256);
        p0 = __builtin_amdgcn_mfma_f32_32x32x16_bf16(b0, qr[d0], p0, 0, 0, 0);
        p1 = __builtin_amdgcn_mfma_f32_32x32x16_bf16(b1, qr[d0], p1, 0, 0, 0); }
}
template <int VB>
__device__ __forceinline__ void pv_tile(f32x16* o, int vb0, bf16x8 pa0, bf16x8 pa1, bf16x8 pa2, bf16x8 pa3) {
#define TRRD(dst, off) asm volatile("ds_read_b64_tr_b16 %0, %1 offset:%2" : "=&v"(dst) : "v"(vb0), "i"(off) : "memory")
#define PV_D0(d0) do { s16x4 l0, l1, l2, l3, h0, h1, h2, h3; constexpr int b_ = VB * SHM_V + v_rd_off(d0, 0, 0);   \
        TRRD(l0, b_); TRRD(h0, b_ + 2048); TRRD(l1, b_ + 4096); TRRD(h1, b_ + 6144); TRRD(l2, b_ + 8192); TRRD(h2, b_ + 10240); TRRD(l3, b_ + 12288); TRRD(h3, b_ + 14336); \
        asm volatile("s_waitcnt lgkmcnt(0)" ::: "memory"); SBAR();   \
        o[d0] = __builtin_amdgcn_mfma_f32_32x32x16_bf16(pa0, (bf16x8){l0[0], l0[1], l0[2], l0[3], h0[0], h0[1], h0[2], h0[3]}, o[d0], 0, 0, 0);   \
        o[d0] = __builtin_amdgcn_mfma_f32_32x32x16_bf16(pa1, (bf16x8){l1[0], l1[1], l1[2], l1[3], h1[0], h1[1], h1[2], h1[3]}, o[d0], 0, 0, 0);   \
        o[d0] = __builtin_amdgcn_mfma_f32_32x32x16_bf16(pa2, (bf16x8){l2[0], l2[1], l2[2], l2[3], h2[0], h2[1], h2[2], h2[3]}, o[d0], 0, 0, 0);   \
        o[d0] = __builtin_amdgcn_mfma_f32_32x32x16_bf16(pa3, (bf16x8){l3[0], l3[1], l3[2], l3[3], h3[0], h3[1], h3[2], h3[3]}, o[d0], 0, 0, 0); } while (0)
    PV_D0(0); PV_D0(1); PV_D0(2); PV_D0(3);
#undef PV_D0
#undef TRRD
}
struct Blk { int h, qb, jlo; };
struct Seam { bf16x8 qr[8]; bf16x8 st_v0, st_v1, st_k0, st_k1; };
#define VMW() asm volatile("s_waitcnt vmcnt(0)" ::: "memory")
#define VMWN(n) asm volatile("s_waitcnt vmcnt(%0)" :: "i"(n) : "memory")
#define SLOAD_H(hh, k0) do { const bf16_t* kt_ = PROJ + (size_t)(k0) * PP + (PW + AW) + (hh) * HD;                                         \
                         S.st_v0 = load8(kt_ + AW + toff); S.st_v1 = load8(kt_ + AW + 32 * PP + toff);                                      \
                         S.st_k0 = load8(kt_ + toff); S.st_k1 = load8(kt_ + 32 * PP + toff); } while (0)
#define QLOAD(hh, qq) do { const bf16_t* qt_ = PROJ + (size_t)((qq) * QB + wid * QBLK) * PP + PW + (hh) * HD;                                \
                         _Pragma("unroll") for (int d0 = 0; d0 < 8; ++d0) S.qr[d0] = load8(qt_ + qoff + d0 * 16); } while (0)
#define SWRITE_HK(bf) do { *(LAS bf16x8*)(K_lds + (bf) * SHM_K + kws) = S.st_k0; *(LAS bf16x8*)(K_lds + (bf) * SHM_K + kws + 32 * 256) = S.st_k1; } while (0)
#define SWRITE_HV(bf) do { *(LAS bf16x8*)(V_lds + (bf) * SHM_V + vst0) = S.st_v0; *(LAS bf16x8*)(V_lds + (bf) * SHM_V + vst1) = S.st_v1; } while (0)
#define SWRITE_H(bf) do { SWRITE_HV(bf); SWRITE_HK(bf); } while (0)
__device__ __forceinline__ void attn_prime(const Blk cur, const bf16_t* PROJ, lptr lds, Seam& S, const int wid) {
    const int lane = fresh_lane(), tid = wid * 64 + lane, r32 = lane & 31, hi = lane >> 5;
    const int sr = tid >> 4, sc = (tid & 15) * 8, kws = KSWZ(sr, sc * 2); lptr K_lds = lds + OFF_K;
    const unsigned toff = (unsigned)(sr * PP + sc), qoff = (unsigned)(r32 * PP + hi * 8);
    QLOAD(cur.h, cur.qb);
    SLOAD_H(cur.h, cur.jlo * KVBLK); VMW(); SWRITE_HK(0);
    __syncthreads();
}
__device__ __forceinline__ void attn_block(const Blk cur, const Blk nxt, const bf16_t* PROJ, bf16_t* MIX, const float* CB, lptr lds, Seam& S, const int wid) {
    const int lane = fresh_lane(), tid = wid * 64 + lane, r32 = lane & 31, hi = lane >> 5;
    const int P0 = cur.qb * QB, j_lo = cur.jlo, j_hi = (P0 + QB - 1) / KVBLK + 1;
    const int NT = j_hi - j_lo;
    const int qlo = P0 + wid * QBLK, qm = qlo + r32 - 4 * hi;
    lptr V_lds = lds; lptr K_lds = lds + OFF_K;
    LAS float* ws = (LAS float*)(lds + OFF_WS) + wid * 64; LAS float* li_l = ws; LAS float* al_l = ws + 32;
    LAS float* cb = (LAS float*)(lds + OFF_CB);
    float m_reg = -1e30f, l_reg = 0; f32x16 o[4] = {};
    const int sr = tid >> 4, sc = (tid & 15) * 8, vst0 = v_st(sr, sc), vst1 = v_st(32 + sr, sc), kws = KSWZ(sr, sc * 2);
    const unsigned toff = (unsigned)(sr * PP + sc);
    const int vb0 = (int)(unsigned)(size_t)V_lds + v_rd_base(lane);
    const int hh = cur.h;
    { const float* c2 = CB + (size_t)hh * SEQ; const float cref = c2[P0]; const float* csrc = c2 + j_lo * KVBLK;
      for (int i = tid * 4; i < NT * KVBLK; i += 2048) { const f32x4 c = *(const f32x4*)(csrc + i); *(LAS f32x4*)(cb + i) = cref - c; }
      __syncthreads(); }
    const LAS float* cbl = cb + 4 * hi;
#define RESC(a) do { if (__any((a) < 1.f)) { if (hi == 0) al_l[r32] = (a); asm volatile("s_waitcnt lgkmcnt(0)" ::: "memory");              \
                     _Pragma("unroll") for (int d_ = 0; d_ < 4; ++d_) _Pragma("unroll") for (int r = 0; r < 16; ++r) o[d_][r] *= al_l[crow(r, hi)]; } } while (0)
#define KBASE(t) ((j_lo + (t)) * KVBLK)
#define MASKT(P0_, P1_, t) do { const int kb_ = KBASE(t); if (kb_ + KVBLK - 1 > qlo) mask_tile(P0_, P1_, qm - kb_); } while (0)
#define SEAM_K0() do { VMWN(8); SWRITE_HK(0); SBAR(); } while (0)
    f32x16 pA0, pA1, pB0, pB1; float mnA, mnB, alA, alB; bf16x8 pa0, pa1, pa2, pa3;
    SWRITE_HV(0); SBAR();
    if (NT > 1) { SLOAD_H(hh, KBASE(1)); }
    SBAR(); qkt<0>(pA0, pA1, K_lds, cbl, r32, hi, S.qr);
    MASKT(pA0, pA1, 0); partialSM(pA0, pA1, m_reg, mnA, alA);
    if (NT > 1) { VMW(); SWRITE_H(1); }
    __syncthreads();
#define HALF_STEP(PX0, PX1, mnX, alX, PY0, PY1, alY, t, KB, VB, SB) do {                                                      \
        SBAR(); qkt<KB>(PX0, PX1, K_lds, cbl + (t) * KVBLK, r32, hi, S.qr);                                                   \
        finishSM(PY0, PY1, alY, l_reg, pa0, pa1, pa2, pa3); SBAR();                                                           \
        if ((t) + 1 < NT) { SLOAD_H(hh, KBASE((t) + 1)); SBAR(); }                                                            \
        pv_tile<VB>(o, vb0, pa0, pa1, pa2, pa3); MASKT(PX0, PX1, (t)); partialSM(PX0, PX1, m_reg, mnX, alX);                   \
        __syncthreads();                                                                                                      \
        if ((t) + 1 < NT) { VMW(); SWRITE_H(SB); }                                                                            \
        RESC(alX); __syncthreads(); } while (0)
    for (int t = 1; t + 1 < NT; t += 2) {
        HALF_STEP(pB0, pB1, mnB, alB, pA0, pA1, alA, t, 1, 0, 0);
        HALF_STEP(pA0, pA1, mnA, alA, pB0, pB1, alB, t + 1, 0, 1, 1);
    }
    const bool even = (NT & 1) == 0;
    const int l2_ = fresh_lane(), r32b_ = l2_ & 31, hib_ = l2_ >> 5, qmb_ = qlo + r32b_ - 4 * hib_;
    { const int r32 = r32b_, hi = hib_, qm = qmb_;
    if (even) { SBAR(); qkt<1>(pB0, pB1, K_lds, cbl + (NT - 1) * KVBLK, r32, hi, S.qr); SBAR(); }
    SLOAD_H(nxt.h, nxt.jlo * KVBLK); SBAR();
    { const unsigned qoff = (unsigned)(r32 * PP + hi * 8); QLOAD(nxt.h, nxt.qb); }
    SBAR();
    finishSM(pA0, pA1, alA, l_reg, pa0, pa1, pa2, pa3); SBAR();
    pv_tile<0>(o, vb0, pa0, pa1, pa2, pa3);
    if (even) { MASKT(pB0, pB1, NT - 1); partialSM(pB0, pB1, m_reg, mnB, alB); __syncthreads(); RESC(alB);
        finishSM(pB0, pB1, alB, l_reg, pa0, pa1, pa2, pa3); SBAR(); pv_tile<1>(o, vb0, pa0, pa1, pa2, pa3); }
    SBAR(); SEAM_K0();
    if (hi == 0) li_l[r32] = l_reg; asm volatile("s_waitcnt lgkmcnt(0)" ::: "memory");
    bf16_t* Ow = MIX + (size_t)(P0 + wid * QBLK) * PO + PW + hh * HD;
    const unsigned ooff = (unsigned)(4 * hi * PO + r32);
#pragma unroll
    for (int r = 0; r < 16; ++r) { const float rl = __builtin_amdgcn_rcpf(li_l[crow(r, hi)]);
#pragma unroll
        for (int d0 = 0; d0 < 4; ++d0) { const float v = o[d0][r] * rl;
            const float vn = swz_xor<1>(v);
            if ((r32 & 1) == 0) *(unsigned*)(Ow + ooff + (unsigned)(((r & 3) + 8 * (r >> 2)) * PO + d0 * 32)) = cvt_pk_bf16(v, vn); } }
    }
    __syncthreads();
#undef RESC
#undef KBASE
#undef MASKT
#undef SEAM_K0
#undef HALF_STEP
}
#undef QLOAD
#undef SLOAD_H
#undef SWRITE_HK
#undef SWRITE_HV
#undef SWRITE_H

constexpr int SOFF_ML = 0, SOFF_OT = 2048, SLDS_NEED = 2048 + 8 * 64 * 32 * 4;
template <bool NEWK>
__device__ __forceinline__ void samp_chunk(const float* Kc, const float* Vc, const bf16_t* Kn, const bf16_t* Vn, const float* bias, const bf16x8* qr,
                                           float& m_reg, float& l_reg, f32x16* oT, int r32, int hi) {
    f32x16 s;
#pragma unroll
    for (int i = 0; i < 4; ++i) { const f32x4 b = *(const f32x4*)(bias + 8 * i + 4 * hi); s[4 * i] = b[0]; s[4 * i + 1] = b[1]; s[4 * i + 2] = b[2]; s[4 * i + 3] = b[3]; }
    bf16x8 kf[8];
    if constexpr (NEWK) {
#pragma unroll
        for (int d0 = 0; d0 < 8; ++d0) kf[d0] = load8(Kn + (size_t)r32 * PP + d0 * 16 + hi * 8);
    } else {
        const float* kp = Kc + (size_t)r32 * (NH * HD) + hi * 8;
#pragma unroll
        for (int d0 = 0; d0 < 8; ++d0) kf[d0] = pack8(*(const f32x4*)(kp + d0 * 16), *(const f32x4*)(kp + d0 * 16 + 4));
    }
#pragma unroll
    for (int d0 = 0; d0 < 8; ++d0) s = __builtin_amdgcn_mfma_f32_32x32x16_bf16(kf[d0], qr[d0], s, 0, 0, 0);
    if constexpr (NEWK) {
        const float NEG = -__builtin_inff();
#pragma unroll
        for (int r = 0; r < 16; ++r) if (crow(r, hi) > r32) s[r] = NEG;
    }
    float pmax = s[0];
#pragma unroll
    for (int r = 1; r < 16; ++r) pmax = fmaxf(pmax, s[r]);
    { auto rr = __builtin_amdgcn_permlane32_swap(__float_as_uint(pmax), __float_as_uint(pmax), false, false); pmax = fmaxf(__uint_as_float(rr[0]), __uint_as_float(rr[1])); }
    const float mn = fmaxf(m_reg, pmax), alpha = __builtin_amdgcn_exp2f(m_reg - mn); m_reg = mn;
    float ps = 0.f;
#pragma unroll
    for (int r = 0; r < 16; ++r) { s[r] = __builtin_amdgcn_exp2f(s[r] - mn); ps += s[r]; }
    { auto rr = __builtin_amdgcn_permlane32_swap(__float_as_uint(ps), __float_as_uint(ps), false, false); ps = __uint_as_float(rr[0]) + __uint_as_float(rr[1]); }
    l_reg = l_reg * alpha + ps;
    if (__any(alpha < 1.f)) {
#pragma unroll
        for (int d0 = 0; d0 < 4; ++d0) oT[d0] = oT[d0] * alpha;
    }
    bf16x8 pa0, pa1; PK4(s, 0, pa0); PK4(s, 8, pa1);
#pragma unroll
    for (int ks = 0; ks < 2; ++ks) {
#pragma unroll
        for (int d0 = 0; d0 < 4; ++d0) {
            bf16x8 vf;
            if constexpr (NEWK) {
                const bf16_t* vp = Vn + (size_t)(16 * ks + 8 * hi) * PP + 32 * d0 + r32;
                short e[8];
#pragma unroll
                for (int j = 0; j < 8; ++j) e[j] = (short)vp[(size_t)j * PP];
                vf = (bf16x8){e[0], e[1], e[2], e[3], e[4], e[5], e[6], e[7]};
            } else {
                const float* vp = Vc + (size_t)(16 * ks + 8 * hi) * (NH * HD) + 32 * d0 + r32;
                float e[8];
#pragma unroll
                for (int j = 0; j < 8; ++j) e[j] = vp[(size_t)j * (NH * HD)];
                vf = pack8((f32x4){e[0], e[1], e[2], e[3]}, (f32x4){e[4], e[5], e[6], e[7]});
            }
            oT[d0] = __builtin_amdgcn_mfma_f32_32x32x16_bf16(vf, ks == 0 ? pa0 : pa1, oT[d0], 0, 0, 0);
        }
    }
}
#undef PK4
__device__ __forceinline__ void samp_unit(int b, int h, const bf16_t* PROJ, const float* cache_k, const float* cache_v, const float* CS, bf16_t* MIX, lptr lds, const int wid) {
    const int lane = fresh_lane(), tid = wid * 64 + lane, r32 = lane & 31, hi = lane >> 5;
    const bf16_t* Qp = PROJ + (size_t)(MP + b * DS) * PP + PW + h * HD;
    const bf16_t* Kn = PROJ + (size_t)(MP + b * DS) * PP + PW + AW + h * HD;
    const bf16_t* Vn = PROJ + (size_t)(MP + b * DS) * PP + PW + 2 * AW + h * HD;
    const float* bias = CS + (size_t)(b * NH + h) * 2080;
    bf16x8 qr[8];
#pragma unroll
    for (int d0 = 0; d0 < 8; ++d0) qr[d0] = load8(Qp + (size_t)r32 * PP + d0 * 16 + hi * 8);
    float m_reg = -1e30f, l_reg = 0.f; f32x16 oT[4] = {};
    const float* Kc = cache_k + ((size_t)(b * PAST + wid * 256) * NH + h) * HD;
    const float* Vc = cache_v + ((size_t)(b * PAST + wid * 256) * NH + h) * HD;
    for (int c = 0; c < 8; ++c)
        samp_chunk<false>(Kc + (size_t)c * 32 * NH * HD, Vc + (size_t)c * 32 * NH * HD, nullptr, nullptr, bias + wid * 256 + c * 32, qr, m_reg, l_reg, oT, r32, hi);
    if (wid == 7) samp_chunk<true>(nullptr, nullptr, Kn, Vn, bias + PAST, qr, m_reg, l_reg, oT, r32, hi);
    LAS float* ML = (LAS float*)(lds + SOFF_ML); LAS float* OT = (LAS float*)(lds + SOFF_OT);
    if (hi == 0) { ML[(wid * 32 + r32) * 2] = m_reg; ML[(wid * 32 + r32) * 2 + 1] = l_reg; }
    __syncthreads();
    float Mx = -1e30f;
#pragma unroll
    for (int w = 0; w < 8; ++w) Mx = fmaxf(Mx, ML[(w * 32 + r32) * 2]);
    float L = 0.f;
#pragma unroll
    for (int w = 0; w < 8; ++w) L += ML[(w * 32 + r32) * 2 + 1] * __builtin_amdgcn_exp2f(ML[(w * 32 + r32) * 2] - Mx);
    const float f = __builtin_amdgcn_exp2f(m_reg - Mx) / L;
#pragma unroll
    for (int half = 0; half < 2; ++half) {
#pragma unroll
        for (int dd = 0; dd < 2; ++dd)
#pragma unroll
            for (int r = 0; r < 16; ++r) OT[(wid * 64 + dd * 32 + crow(r, hi)) * 32 + r32] = oT[half * 2 + dd][r] * f;
        __syncthreads();
        float acc4[4] = {0.f, 0.f, 0.f, 0.f};
#pragma unroll
        for (int w = 0; w < 8; ++w)
#pragma unroll
            for (int j = 0; j < 4; ++j) acc4[j] += OT[(w * 64 + 8 * wid + 4 * hi + j) * 32 + r32];
        u32x2 o2; o2.x = cvt_pk_bf16(acc4[0], acc4[1]); o2.y = cvt_pk_bf16(acc4[2], acc4[3]);
        *(u32x2*)(MIX + (size_t)(MP + b * DS + r32) * DM + PW + h * HD + half * 64 + 8 * wid + 4 * hi) = o2;
        __syncthreads();
    }
}
}

#define XB_TMO      128
#define XB_XCNT(j)  (256  + 64 * (j))
#define XB_XSUB(j)  (1280 + 64 * (j))
#define XB_XGEN(j)  (2304 + 64 * (j))
#define XB_TOP      3328
#define XB_TOPGEN   3392
#define XCD_BAR_WORDS 3456
#define XB_SPIN_CAP (1u << 22)
__device__ __forceinline__ unsigned xb_ld(unsigned* p)              { return __hip_atomic_load(p, __ATOMIC_RELAXED, __HIP_MEMORY_SCOPE_AGENT); }
__device__ __forceinline__ unsigned xb_add(unsigned* p, unsigned v) { return __hip_atomic_fetch_add(p, v, __ATOMIC_RELAXED, __HIP_MEMORY_SCOPE_AGENT); }
__device__ __forceinline__ unsigned xb_xcc_id() { return (unsigned)__builtin_amdgcn_s_getreg((3 << 11) | 20) & 0xFu; }
#define XB_SPIN(cond, bar) do { unsigned _sp = 0; while (cond) { __builtin_amdgcn_s_sleep(1); \
    if ((++_sp & 255u) == 0u) { if (xb_ld(&(bar)[XB_TMO])) break; if (_sp > XB_SPIN_CAP) { atomicAdd(&(bar)[XB_TMO], 1u); break; } } } } while (0)
struct XcdBarrier { unsigned* bar; unsigned x; volatile LAS unsigned* st; };
__device__ __forceinline__ XcdBarrier xcd_barrier_post(unsigned* bar, volatile LAS unsigned* st, bool leader) {
    XcdBarrier b; b.bar = bar; b.x = xb_xcc_id(); b.st = st;
    if (leader) (void)xb_add(&bar[XB_XCNT(b.x)], 1u);
    return b;
}
__device__ __forceinline__ void xcd_barrier_complete(unsigned* bar, unsigned x, unsigned& nloc, unsigned& nx) {
    const unsigned G = gridDim.x * gridDim.y * gridDim.z;
    unsigned sum, cnt, mine, sp = 0u;
    for (;;) {
        sum = 0u; cnt = 0u; mine = 0u;
#pragma unroll
        for (unsigned j = 0; j < 16; ++j) { const unsigned c = xb_ld(&bar[XB_XCNT(j)]); sum += c; cnt += (c > 0u) ? 1u : 0u; mine = (j == x) ? c : mine; }
        if (sum == G) break;
        __builtin_amdgcn_s_sleep(1);
        if ((++sp & 255u) == 0u) { if (xb_ld(&bar[XB_TMO])) break; if (sp > XB_SPIN_CAP) { atomicAdd(&bar[XB_TMO], 1u); break; } }
    }
    nloc = mine > 0u ? mine : 1u; nx = cnt > 0u ? cnt : 1u;
}
__device__ __forceinline__ void xcd_barrier(const XcdBarrier& b, bool leader) {
    asm volatile("s_waitcnt vmcnt(0)" ::: "memory");
    __syncthreads();
    if (leader) {
        unsigned* bar = b.bar;
        __builtin_amdgcn_s_waitcnt(0);
        unsigned nloc = b.st[0], nx = b.st[1];
        if (nloc == 0u) { xcd_barrier_complete(bar, b.x, nloc, nx); b.st[0] = nloc; b.st[1] = nx; }
        const unsigned old = xb_add(&bar[XB_XSUB(b.x)], 1u);
        const unsigned gen = old / nloc;
        if (old + 1u == (gen + 1u) * nloc) {
            __builtin_amdgcn_fence(__ATOMIC_RELEASE, "agent");
            asm volatile("s_waitcnt vmcnt(0)" ::: "memory");
            const unsigned og = xb_add(&bar[XB_TOP], 1u);
            const unsigned tg = og / nx;
            if (og + 1u == (tg + 1u) * nx) xb_add(&bar[XB_TOPGEN], 1u);
            else XB_SPIN(xb_ld(&bar[XB_TOPGEN]) == tg, bar);
            __builtin_amdgcn_fence(__ATOMIC_ACQUIRE, "agent");
            xb_add(&bar[XB_XGEN(b.x)], 1u);
            asm volatile("s_waitcnt vmcnt(0)" ::: "memory");
        } else {
            XB_SPIN(xb_ld(&bar[XB_XGEN(b.x)]) == gen, bar);
            __builtin_amdgcn_fence(__ATOMIC_ACQUIRE, "agent");
            asm volatile("s_waitcnt vmcnt(0)" ::: "memory");
        }
    }
    __syncthreads();
}

#ifndef PHASES
#define PHASES 0xfff
#endif
#ifndef PROBE
#define PROBE 0
#endif
#define REPS(id) for (int rep_ = 0; rep_ < ((PROBE == (id)) ? 2 : 1); ++rep_)
struct Args {
    const float *x_prompt, *x_sample, *cache_k, *cache_v, *cache_logf, *state_pool, *attn_norm_g, *w_in, *b_f, *q_norm_g, *k_norm_g, *w_pool, *pool_scale, *w_out, *mlp_norm_g, *w_up, *w_down;
    float* out; unsigned char* ws;
};
__device__ __forceinline__ float wave_sum(float v) { v += swz_xor<1>(v); v += swz_xor<2>(v); v += swz_xor<4>(v); v += swz_xor<8>(v); v += swz_xor<16>(v); return half_sum(v); }
__device__ __forceinline__ float wave_max(float v) { v = fmaxf(v, swz_xor<1>(v)); v = fmaxf(v, swz_xor<2>(v)); v = fmaxf(v, swz_xor<4>(v)); v = fmaxf(v, swz_xor<8>(v)); v = fmaxf(v, swz_xor<16>(v)); return half_max(v); }
__device__ __forceinline__ void p0_transpose_item(const float* W, int K, int N, bf16_t* WT, LAS float* scr, int kb, int nb, int lane) {
    const int k0 = 64 * kb, n0 = 32 * nb; const int nn = n0 + (lane & 31);
#pragma unroll 8
    for (int i = 0; i < 32; ++i) { const int kk = 2 * i + (lane >> 5); scr[kk * 33 + (lane & 31)] = nn < N ? W[(size_t)(k0 + kk) * N + nn] : 0.f; }
    asm volatile("s_waitcnt lgkmcnt(0)" ::: "memory");
    const int c = lane & 7;
#pragma unroll
    for (int j = 0; j < 4; ++j) { const int n = (lane >> 3) + 8 * j; const LAS float* s = scr + (8 * c) * 33 + n;
        u32x4 o; o.x = cvt_pk_bf16(s[0 * 33], s[1 * 33]); o.y = cvt_pk_bf16(s[2 * 33], s[3 * 33]); o.z = cvt_pk_bf16(s[4 * 33], s[5 * 33]); o.w = cvt_pk_bf16(s[6 * 33], s[7 * 33]);
        *(u32x4*)(WT + (size_t)(n0 + n) * K + k0 + 8 * c) = o; }
    asm volatile("s_waitcnt lgkmcnt(0)" ::: "memory");
}
__device__ __forceinline__ float log_sigmoid(float x) { return fminf(x, 0.f) - log1pf(__expf(-fabsf(x))); }

__global__ void __launch_bounds__(512, 2) hymba_fwd(Args a) {
    extern __shared__ __attribute__((aligned(16))) unsigned char lds_raw[];
    LAS unsigned char* lds = (LAS unsigned char*)lds_raw;
    volatile LAS unsigned* MISC = (volatile LAS unsigned*)(lds + MISC_OFF);
    const int wave = __builtin_amdgcn_readfirstlane((int)threadIdx.x >> 6);
    const int G = gridDim.x; const int bx = blockIdx.x; const int vcu = (G % 8 == 0) ? (bx % 8) * (G / 8) + bx / 8 : bx;
    unsigned char* ws = a.ws;
    unsigned* ctl = (unsigned*)(ws + WS_CTL);
    bf16_t* WI = (bf16_t*)(ws + WS_WI); bf16_t* WP = (bf16_t*)(ws + WS_WP); bf16_t* WO = (bf16_t*)(ws + WS_WO); bf16_t* WU = (bf16_t*)(ws + WS_WU); bf16_t* WD = (bf16_t*)(ws + WS_WD);
    bf16_t* XN = (bf16_t*)(ws + WS_XN); bf16_t* PROJ = (bf16_t*)(ws + WS_PROJ); float* FL = (float*)(ws + WS_FL); float* CB = (float*)(ws + WS_CB); float* CS = (float*)(ws + WS_CS);
    bf16_t* DP = (bf16_t*)(ws + WS_DP); bf16_t* MIX = (bf16_t*)(ws + WS_MIX); bf16_t* X1G = (bf16_t*)(ws + WS_X1G); bf16_t* HID = (bf16_t*)(ws + WS_HID); float* PART = (float*)(ws + WS_PART);
    int* JLO = (int*)(ctl + CW_JLO); float* RSS = (float*)(ctl + CW_RSS);
    float* out = a.out;
    for (int u = wave * 64 + fresh_lane(); u < (LDS_BYTES - 131072) / 4; u += 512) ((LAS unsigned*)(lds + 131072))[u] = 0u;
    __syncthreads();
    XcdBarrier bar = xcd_barrier_post(ctl + CW_BAR, MISC + 8, wave == 0 && fresh_lane() == 0);
    const int gw = vcu * 8 + wave, NGW = G * 8;

    REPS(1) {
        const int lane = fresh_lane();
        LAS float* scr = (LAS float*)(lds + wave * 16384);
        constexpr int NB_I = (NPROJ + 31) / 32, I_I = (DM / 64) * NB_I, I_P = 4 * (PG / 64) * (PG / 32), I_O = (DM / 64) * (DM / 32), I_U = (DM / 64) * (DFF / 32), I_D = (DFF / 64) * (DM / 32);
        constexpr int NITEMS = I_I + I_P + I_O + I_U + I_D;
        for (int it = gw; it < NITEMS; it += NGW) {
            int r = it;
            if (r < I_I) { p0_transpose_item(a.w_in, DM, NPROJ, WI, scr, r / NB_I, r % NB_I, lane); continue; } r -= I_I;
            if (r < I_P) { const int g = r / ((PG / 64) * (PG / 32)), q = r % ((PG / 64) * (PG / 32)); p0_transpose_item(a.w_pool + (size_t)g * PG * PG, PG, PG, WP + (size_t)g * PG * PG, scr, q / (PG / 32), q % (PG / 32), lane); continue; } r -= I_P;
            if (r < I_O) { p0_transpose_item(a.w_out, DM, DM, WO, scr, r / (DM / 32), r % (DM / 32), lane); continue; } r -= I_O;
            if (r < I_U) { p0_transpose_item(a.w_up, DM, DFF, WU, scr, r / (DFF / 32), r % (DFF / 32), lane); continue; } r -= I_U;
            p0_transpose_item(a.w_down, DFF, DM, WD, scr, r / (DM / 32), r % (DM / 32), lane);
        }
        for (int m = gw; m < M; m += NGW) {
            const float* xrow = (m < MP) ? a.x_prompt + (size_t)m * DM : a.x_sample + (size_t)(m - MP) * DM;
            f32x4 v[16]; float s = 0.f;
#pragma unroll
            for (int j = 0; j < 16; ++j) { v[j] = *(const f32x4*)(xrow + 256 * j + 4 * lane); s += (v[j][0] * v[j][0] + v[j][1] * v[j][1]) + (v[j][2] * v[j][2] + v[j][3] * v[j][3]); }
            const float rstd = __builtin_amdgcn_rsqf(wave_sum(s) * (1.0f / DM) + EPS);
#pragma unroll
            for (int j = 0; j < 16; ++j) { const f32x4 gg = *(const f32x4*)(a.attn_norm_g + 256 * j + 4 * lane); const f32x4 y = v[j] * rstd * gg;
                u32x2 o; o.x = cvt_pk_bf16(y[0], y[1]); o.y = cvt_pk_bf16(y[2], y[3]); *(u32x2*)(XN + (size_t)m * DM + 256 * j + 4 * lane) = o; }
        }
    }
    xcd_barrier(bar, wave == 0 && fresh_lane() == 0);

    REPS(2) {
        {
            const int lane = fresh_lane(), fr = lane & 15, fq = lane >> 4;
            for (int t = gw; t < (M / 16) * 4; t += NGW) {
                const int rg = t >> 2, kq = t & 3;
                const bf16_t* xa = XN + (size_t)(rg * 16 + fr) * DM + kq * 1024 + 8 * fq;
                const bf16_t* wb = WI + (size_t)(PW + 3 * AW + fr) * DM + kq * 1024 + 8 * fq;
                f32x4 acc = {0.f, 0.f, 0.f, 0.f};
#pragma unroll 8
                for (int k = 0; k < 32; ++k) { const bf16x8 xv = *(const bf16x8*)(xa + 32 * k), wv = *(const bf16x8*)(wb + 32 * k);
                    acc = __builtin_amdgcn_mfma_f32_16x16x32_bf16(wv, xv, acc, 0, 0, 0); }
                *(f32x4*)(FL + ((size_t)kq * M + rg * 16 + fr) * NH + 4 * fq) = acc;
            }
        }
        pg8::Gemm g{XN, WI, M, PP, DM, DM, 1 << 30}; pg8::SplitOrder S; S.init(M, PP, DM, G, bx, PART, ctl + CW_SPLIT + (0 + 4 * rep_) * 8192);
        pg8::EpiProj E{PROJ};
        pg8::gemm_phase<pg8::EpiProj, pg8::SplitOrder>(lds, g, S, E, wave);
    }
    xcd_barrier(bar, wave == 0 && fresh_lane() == 0);

    {
        const int lane = fresh_lane(), tid = wave * 64 + lane;
#define FLS(i) ((FL[(i)] + FL[(size_t)M * NH + (i)]) + (FL[(size_t)2 * M * NH + (i)] + FL[(size_t)3 * M * NH + (i)]))
        if (vcu < 16) {
            const int h = vcu; LAS float* cl = (LAS float*)lds; LAS double* tot = (LAS double*)(lds + 65536);
            const float bf = a.b_f[h]; float lf[16]; double run = 0.0;
#pragma unroll
            for (int j = 0; j < 16; ++j) lf[j] = log_sigmoid(FLS((size_t)(tid * 16 + j) * NH + h) + bf);
#pragma unroll
            for (int j = 0; j < 16; ++j) { out[O_FP + (size_t)(tid * 16 + j) * NH + h] = lf[j]; run += (double)lf[j]; }
            tot[tid] = run; __syncthreads();
            if (tid == 0) { double s = 0.0; for (int i = 0; i < 512; ++i) { const double t = tot[i]; tot[i] = s; s += t; } }
            __syncthreads();
            double c = tot[tid];
#pragma unroll
            for (int j = 0; j < 16; ++j) { c += (double)lf[j]; cl[tid * 16 + j] = (float)c; CB[(size_t)h * SEQ + tid * 16 + j] = (float)(c * (double)LOG2E); }
            __syncthreads();
            if (tid < 64) {
                float gq = fmaxf(fabsf(a.q_norm_g[tid]), fabsf(a.q_norm_g[tid + 64])), gk = fmaxf(fabsf(a.k_norm_g[tid]), fabsf(a.k_norm_g[tid + 64]));
                gq = wave_max(gq); gk = wave_max(gk);
                const float U = 11.3137085f * gq * gk; const float thr = -(2.f * U + PRUNE_T);
                if (tid < 32) { const int qb = tid; const float cP = cl[qb * 256]; int j = 0; while (j < 4 * qb && (cP - cl[64 * j + 63]) < thr) ++j; JLO[h * 32 + qb] = j; }
            }
            __syncthreads();
        } else if (vcu < 32) {
            const int b = vcu - 16, h = tid & 15, seg = tid >> 4; LAS double* tot = (LAS double*)(lds + 65536);
            const float* lsrc = a.cache_logf + ((size_t)b * PAST + seg * 64) * NH + h;
            double run = 0.0;
#pragma unroll 16
            for (int j = 0; j < 64; ++j) run += (double)lsrc[(size_t)j * NH];
            tot[tid] = run; __syncthreads();
            double c = 0.0; for (int s = 0; s < seg; ++s) c += tot[s * 16 + h];
            double ctot = 0.0; for (int s = 0; s < 32; ++s) ctot += tot[s * 16 + h];
            const float bf = a.b_f[h];
            const float lf0 = log_sigmoid(FLS((size_t)(MP + b * DS) * NH + h) + bf);
            const double cref = ctot + (double)lf0;
            float* csd = CS + (size_t)(b * NH + h) * 2080;
#pragma unroll 16
            for (int j = 0; j < 64; ++j) { c += (double)lsrc[(size_t)j * NH]; csd[seg * 64 + j] = (float)((cref - c) * (double)LOG2E); }
            if (seg == 31) {
                double cn = ctot;
                for (int s = 0; s < DS; ++s) { const float l = log_sigmoid(FLS((size_t)(MP + b * DS + s) * NH + h) + bf); out[O_FS + (size_t)(b * DS + s) * NH + h] = l; cn += (double)l; csd[PAST + s] = (float)((cref - cn) * (double)LOG2E); }
            }
            __syncthreads();
        }
#undef FLS
        for (int m = gw; m < M; m += NGW) {
            bf16_t* pr = PROJ + (size_t)m * PP + 32 * lane;
            float* ko = ((m < MP) ? out + O_KP + (size_t)m * AW : out + O_KS + (size_t)(m - MP) * AW) + 32 * lane;
            float* vo = ((m < MP) ? out + O_VP + (size_t)m * AW : out + O_VS + (size_t)(m - MP) * AW) + 32 * lane;
            const int dofs = (32 * lane) & 127;
#pragma unroll
            for (int which = 0; which < 2; ++which) {
                bf16_t* p = pr + PW + which * AW; const float* gsrc = (which == 0 ? a.q_norm_g : a.k_norm_g) + dofs;
                u32x4 w4[4];
#pragma unroll
                for (int j = 0; j < 4; ++j) w4[j] = *(const u32x4*)(p + 8 * j);
                float v[32]; float ss = 0.f;
#pragma unroll
                for (int j = 0; j < 4; ++j)
#pragma unroll
                    for (int e = 0; e < 4; ++e) { v[8 * j + 2 * e] = bf_lo(w4[j][e]); v[8 * j + 2 * e + 1] = bf_hi(w4[j][e]); }
#pragma unroll
                for (int i = 0; i < 32; ++i) ss += v[i] * v[i];
                ss += swz_xor<1>(ss); ss += swz_xor<2>(ss);
                const float rs = __builtin_amdgcn_rsqf(ss * (1.0f / HD) + EPS) * (which == 0 ? QSCALE : 1.0f);
#pragma unroll
                for (int j = 0; j < 8; ++j) { const f32x4 gg = *(const f32x4*)(gsrc + 4 * j);
#pragma unroll
                    for (int e = 0; e < 4; ++e) v[4 * j + e] = v[4 * j + e] * rs * gg[e]; }
#pragma unroll
                for (int j = 0; j < 4; ++j) { u32x4 w; w.x = cvt_pk_bf16(v[8 * j], v[8 * j + 1]); w.y = cvt_pk_bf16(v[8 * j + 2], v[8 * j + 3]); w.z = cvt_pk_bf16(v[8 * j + 4], v[8 * j + 5]); w.w = cvt_pk_bf16(v[8 * j + 6], v[8 * j + 7]);
                    *(u32x4*)(p + 8 * j) = w; }
                if (which == 1) {
#pragma unroll
                    for (int j = 0; j < 8; ++j) *(f32x4*)(ko + 4 * j) = (f32x4){v[4 * j], v[4 * j + 1], v[4 * j + 2], v[4 * j + 3]};
                }
            }
            {
                u32x4 vw[4];
#pragma unroll
                for (int j = 0; j < 4; ++j) vw[j] = *(const u32x4*)(pr + PW + 2 * AW + 8 * j);
#pragma unroll
                for (int j = 0; j < 4; ++j) { *(f32x4*)(vo + 8 * j) = (f32x4){bf_lo(vw[j][0]), bf_hi(vw[j][0]), bf_lo(vw[j][1]), bf_hi(vw[j][1])};
                    *(f32x4*)(vo + 8 * j + 4) = (f32x4){bf_lo(vw[j][2]), bf_hi(vw[j][2]), bf_lo(vw[j][3]), bf_hi(vw[j][3])}; }
            }
        }
        for (int task = gw; task < (M / 32) * 4; task += NGW) {
            const int chunk = task >> 2, g = task & 3, w = 2 << g; const int col = g * PG + 8 * lane;
            const bool samp = chunk >= MP / 32; const int r0 = chunk * 32; const int b = chunk - MP / 32;
            const float inv_w = 1.0f / (float)w;
            auto ld8 = [&](int e, float (&v)[8]) {
                if (e >= 0 || (!samp && r0 + e >= 0)) { const u32x4 wv = *(const u32x4*)(PROJ + (size_t)(r0 + e) * PP + col);
#pragma unroll
                    for (int i = 0; i < 4; ++i) { v[2 * i] = bf_lo(wv[i]); v[2 * i + 1] = bf_hi(wv[i]); } }
                else if (samp) { const float* sp = a.state_pool + ((size_t)b * PH + (PH + e)) * PW + col; const f32x4 x0 = *(const f32x4*)sp, x1 = *(const f32x4*)(sp + 4);
                    v[0] = x0[0]; v[1] = x0[1]; v[2] = x0[2]; v[3] = x0[3]; v[4] = x1[0]; v[5] = x1[1]; v[6] = x1[2]; v[7] = x1[3]; }
                else {
#pragma unroll
                    for (int i = 0; i < 8; ++i) v[i] = 0.f; }
            };
            float Sx[8];
#pragma unroll
            for (int i = 0; i < 8; ++i) Sx[i] = 0.f;
            for (int e = -(w - 1); e < 0; ++e) { float t[8]; ld8(e, t);
#pragma unroll
                for (int i = 0; i < 8; ++i) Sx[i] += t[i]; }
            for (int e = 0; e < 32; ++e) {
                float cur[8], old[8]; ld8(e, cur); ld8(e - w + 1, old);
#pragma unroll
                for (int i = 0; i < 8; ++i) Sx[i] += cur[i];
                float ic = inv_w; if (!samp) { const int pos = r0 + e; if (pos + 1 < w) ic = 1.0f / (float)(pos + 1); }
                float d[8];
#pragma unroll
                for (int i = 0; i < 8; ++i) d[i] = Sx[i] * ic - cur[i];
                u32x4 o; o.x = cvt_pk_bf16(d[0], d[1]); o.y = cvt_pk_bf16(d[2], d[3]); o.z = cvt_pk_bf16(d[4], d[5]); o.w = cvt_pk_bf16(d[6], d[7]);
                *(u32x4*)(DP + (size_t)(r0 + e) * PW + col) = o;
#pragma unroll
                for (int i = 0; i < 8; ++i) Sx[i] -= old[i];
            }
        }
        for (int t = gw; t < PH * (1 + DB); t += NGW) {
            const int s = t / PH, j = t % PH;
            const int row = (s == 0) ? (MP - PH + j) : (MP + (s - 1) * DS + (DS - PH) + j);
            float* dst = (s == 0) ? out + O_HP + (size_t)j * PW : out + O_HS + ((size_t)(s - 1) * PH + j) * PW;
#pragma unroll
            for (int i = 0; i < 4; ++i) { const u32x4 wv = *(const u32x4*)(PROJ + (size_t)row * PP + 32 * lane + 8 * i);
                *(f32x4*)(dst + 32 * lane + 8 * i) = (f32x4){bf_lo(wv[0]), bf_hi(wv[0]), bf_lo(wv[1]), bf_hi(wv[1])};
                *(f32x4*)(dst + 32 * lane + 8 * i + 4) = (f32x4){bf_lo(wv[2]), bf_hi(wv[2]), bf_lo(wv[3]), bf_hi(wv[3])}; }
        }
    }
    xcd_barrier(bar, wave == 0 && fresh_lane() == 0);

    {
        REPS(3) {
            pg8::Gemm g{DP, WP, M, PW, PG, PW, 2}; pg8::SplitOrder S; S.init(M, PW, PG, G, bx, nullptr, nullptr);
            pg8::EpiPool E{MIX, a.pool_scale};
            pg8::gemm_phase<pg8::EpiPool, pg8::SplitOrder>(lds, g, S, E, wave);
        }
        REPS(4) {
            int nblk = 0; for (int it = vcu; it < 256; it += G) nblk += 2;
            auto ref = [&](int i) { const int item = vcu + (i >> 1) * G, h = item >> 4, x = item & 15, qb = (i & 1) ? 31 - x : x;
                att::Blk r; r.h = h; r.qb = qb; r.jlo = JLO[h * 32 + qb]; return r; };
            if (nblk > 0) {
                att::Seam S; att::Blk cur = ref(0);
                att::attn_prime(cur, PROJ, (att::lptr)lds, S, wave);
                for (int i = 0; i < nblk; ++i) { const att::Blk nxt = (i + 1 < nblk) ? ref(i + 1) : cur; att::attn_block(cur, nxt, PROJ, MIX, CB, (att::lptr)lds, S, wave); cur = nxt; }
            }
        }
        asm volatile("s_waitcnt vmcnt(0)" ::: "memory"); __syncthreads();
        REPS(5) for (int u = vcu; u < DB * NH; u += G) att::samp_unit(u >> 4, u & 15, PROJ, a.cache_k, a.cache_v, CS, MIX, (att::lptr)lds, wave);
    }
    xcd_barrier(bar, wave == 0 && fresh_lane() == 0);

    REPS(6) {
        pg8::Gemm g{MIX, WO, M, DM, DM, DM, 1 << 30}; pg8::SplitOrder S; S.init(M, DM, DM, G, bx, PART, ctl + CW_SPLIT + (1 + 4 * rep_) * 8192);
        pg8::EpiOut E{a.x_prompt, a.x_sample, out, X1G, a.mlp_norm_g, rep_ ? RSS + 16384 : RSS};
        pg8::gemm_phase<pg8::EpiOut, pg8::SplitOrder>(lds, g, S, E, wave);
    }
    xcd_barrier(bar, wave == 0 && fresh_lane() == 0);

    REPS(7) {
        pg8::Gemm g{X1G, WU, M, DFF, DM, DM, 1 << 30}; pg8::SplitOrder S; S.init(M, DFF, DM, G, bx, PART, ctl + CW_SPLIT + (2 + 4 * rep_) * 8192);
        pg8::EpiUp E{HID, RSS};
        pg8::gemm_phase<pg8::EpiUp, pg8::SplitOrder>(lds, g, S, E, wave);
    }
    xcd_barrier(bar, wave == 0 && fresh_lane() == 0);

    REPS(8) {
        pg8::Gemm g{HID, WD, M, DM, DFF, DFF, 1 << 30}; pg8::SplitOrder S; S.init(M, DM, DFF, G, bx, PART, ctl + CW_SPLIT + (3 + 4 * rep_) * 8192);
        pg8::EpiDown E{rep_ ? (float*)(ws + WS_END) : out};
        pg8::gemm_phase<pg8::EpiDown, pg8::SplitOrder>(lds, g, S, E, wave);
    }
}

extern "C" void kernel_launch(void* const* d_in, const int* in_sizes, int n_in, void* d_out, int out_size, void* d_ws, size_t ws_size, hipStream_t stream) {
    static int grid = 0;
    if (grid == 0) {
        if (n_in != 17 || in_sizes[0] != MP * DM || (size_t)out_size != O_END || ws_size < WS_END + (PROBE == 8 ? (size_t)M * DM * 4 : 0)) {
            fprintf(stderr, "kernel_launch: shape mismatch (n_in %d, in0 %d, out %d, ws %zu; need 17, %d, %zu, >= %zu)\n", n_in, n_in > 0 ? in_sizes[0] : -1, out_size, ws_size, MP * DM, (size_t)O_END, (size_t)WS_END);
            grid = -1; return; }
        int dev = 0, cus = 0, per_cu = 0;
        if (hipGetDevice(&dev) != hipSuccess || hipDeviceGetAttribute(&cus, hipDeviceAttributeMultiprocessorCount, dev) != hipSuccess) { grid = -1; return; }
        if (hipFuncSetAttribute((const void*)hymba_fwd, hipFuncAttributeMaxDynamicSharedMemorySize, LDS_BYTES) != hipSuccess) { fprintf(stderr, "kernel_launch: hipFuncSetAttribute failed\n"); grid = -1; return; }
        if (hipOccupancyMaxActiveBlocksPerMultiprocessor(&per_cu, (const void*)hymba_fwd, 512, LDS_BYTES) != hipSuccess || per_cu < 1) { fprintf(stderr, "kernel_launch: occupancy query says %d\n", per_cu); }
        (void)hipGetLastError();
        grid = cus;
    }
    if (grid < 0) return;
    if (hipMemsetAsync((char*)d_ws + WS_CTL, 0, CTL_ZERO_BYTES, stream) != hipSuccess) { fprintf(stderr, "kernel_launch: memset failed\n"); return; }
    Args a{};
    a.x_prompt = (const float*)d_in[0]; a.x_sample = (const float*)d_in[1]; a.cache_k = (const float*)d_in[2]; a.cache_v = (const float*)d_in[3]; a.cache_logf = (const float*)d_in[4];
    a.state_pool = (const float*)d_in[5]; a.attn_norm_g = (const float*)d_in[6]; a.w_in = (const float*)d_in[7]; a.b_f = (const float*)d_in[8]; a.q_norm_g = (const float*)d_in[9];
    a.k_norm_g = (const float*)d_in[10]; a.w_pool = (const float*)d_in[11]; a.pool_scale = (const float*)d_in[12]; a.w_out = (const float*)d_in[13]; a.mlp_norm_g = (const float*)d_in[14];
    a.w_up = (const float*)d_in[15]; a.w_down = (const float*)d_in[16];
    a.out = (float*)d_out; a.ws = (unsigned char*)d_ws;
    hipLaunchKernelGGL(hymba_fwd, dim3(grid), dim3(512), LDS_BYTES, stream, a);
    const hipError_t le = hipPeekAtLastError();
    if (le != hipSuccess) fprintf(stderr, "kernel_launch: launch failed: %s\n", hipGetErrorName(le));
}
```

```cpp
#include <hip/hip_runtime.h>
#include <cstdio>
#include <cstdint>

#define LAS __attribute__((address_space(3)))
#define GAS __attribute__((address_space(1)))
typedef unsigned short bf16_t;
typedef short bf16x8 __attribute__((ext_vector_type(8)));
typedef short s16x4 __attribute__((ext_vector_type(4)));
typedef float f32x2 __attribute__((ext_vector_type(2)));
typedef float f32x4 __attribute__((ext_vector_type(4)));
typedef float f32x16 __attribute__((ext_vector_type(16)));
typedef unsigned u32x2 __attribute__((ext_vector_type(2)));
typedef unsigned u32x4 __attribute__((ext_vector_type(4)));

constexpr int DM = 4096, SEQ = 8192, DB = 16, DS = 32, PAST = 2048;
constexpr int MP = SEQ, MS = DB * DS, M = MP + MS;
constexpr int PW = 2048, AW = 2048, NH = 16, HD = 128, PH = 15, PG = 512;
constexpr int NPROJ = PW + 3 * AW + NH;
constexpr int NPROJ_PAD = 8448;
constexpr int PP = 8192;
constexpr int DFF = 16384;
constexpr float EPS = 1e-6f;
constexpr float QSCALE = 0.08838834764831845f * 1.4426950408889634f;
constexpr float LOG2E = 1.4426950408889634f;
constexpr float PRUNE_T = 40.0f;
constexpr size_t O_YP = 0, O_YS = (size_t)MP * DM, O_KP = O_YS + (size_t)MS * DM, O_VP = O_KP + (size_t)MP * AW, O_FP = O_VP + (size_t)MP * AW,
                 O_HP = O_FP + (size_t)MP * NH, O_KS = O_HP + (size_t)PH * PW, O_VS = O_KS + (size_t)MS * AW, O_FS = O_VS + (size_t)MS * AW,
                 O_HS = O_FS + (size_t)MS * NH, O_END = O_HS + (size_t)DB * PH * PW;
static_assert(O_END == 71964672, "output size");
constexpr size_t MiB = 1u << 20;
constexpr size_t WS_CTL = 0, CTL_ZERO_BYTES = 1 * MiB;
constexpr size_t WS_WI = 2 * MiB, WS_WP = 68 * MiB, WS_WO = 70 * MiB, WS_WU = 102 * MiB, WS_WD = 230 * MiB, WS_XN = 358 * MiB, WS_PROJ = 426 * MiB,
                 WS_FL = 562 * MiB, WS_CB = 565 * MiB, WS_CS = 566 * MiB, WS_DP = 569 * MiB, WS_MIX = 603 * MiB, WS_X1G = 671 * MiB, WS_HID = 739 * MiB, WS_PART = 1011 * MiB, WS_END = 1075 * MiB;
static_assert(WS_WI + (size_t)NPROJ_PAD * DM * 2 <= WS_WP && WS_XN + (size_t)M * DM * 2 <= WS_PROJ && WS_PROJ + (size_t)M * PP * 2 <= WS_FL && WS_FL + (size_t)4 * M * NH * 4 <= WS_CB && WS_CS + (size_t)DB * NH * 2080 * 4 <= WS_DP &&
              WS_DP + (size_t)M * PW * 2 <= WS_MIX && WS_HID + (size_t)M * DFF * 2 <= WS_PART && WS_PART + (size_t)256 * 65536 * 4 <= WS_END, "ws map");
constexpr int CW_BAR = 4096;
constexpr int CW_JLO = 16384;
constexpr int CW_RSS = 32768;
constexpr int CW_SPLIT = 65536;
static_assert((CW_RSS + 16384 + M) <= CW_SPLIT && (CW_SPLIT + 8 * 8192) * 4 <= (int)CTL_ZERO_BYTES, "ctl");
constexpr int LDS_BYTES = 147456;
constexpr int MISC_OFF = 131072 + 320;

__device__ __forceinline__ int fresh_lane() { int l; asm volatile("v_mbcnt_lo_u32_b32 %0, -1, 0\n\tv_mbcnt_hi_u32_b32 %0, -1, %0" : "=v"(l)); return l; }
template <int X> __device__ __forceinline__ float swz_xor(float v) { return __int_as_float(__builtin_amdgcn_ds_swizzle(__float_as_int(v), (X << 10) | 0x1f)); }
__device__ __forceinline__ float half_sum(float v) { auto rr = __builtin_amdgcn_permlane32_swap(__float_as_uint(v), __float_as_uint(v), false, false); return __uint_as_float(rr[0]) + __uint_as_float(rr[1]); }
__device__ __forceinline__ float half_max(float v) { auto rr = __builtin_amdgcn_permlane32_swap(__float_as_uint(v), __float_as_uint(v), false, false); return fmaxf(__uint_as_float(rr[0]), __uint_as_float(rr[1])); }
__device__ __forceinline__ unsigned cvt_pk_bf16(float lo, float hi) { unsigned r; asm volatile("v_cvt_pk_bf16_f32 %0, %1, %2" : "=v"(r) : "v"(lo), "v"(hi)); return r; }
__device__ __forceinline__ float bf_lo(unsigned w) { return __uint_as_float(w << 16); }
__device__ __forceinline__ float bf_hi(unsigned w) { return __uint_as_float(w & 0xffff0000u); }
__device__ __forceinline__ bf16x8 pack8(f32x4 a, f32x4 b) { u32x4 w = {cvt_pk_bf16(a[0], a[1]), cvt_pk_bf16(a[2], a[3]), cvt_pk_bf16(b[0], b[1]), cvt_pk_bf16(b[2], b[3])}; return __builtin_bit_cast(bf16x8, w); }

namespace pg8 {
constexpr int BM = 256, BK = 64, HALF = 128, HTB = HALF * BK * 2, STAGE_BYTES = 8 * HTB, NXCD = 8, WGM = 8;
__host__ __device__ __forceinline__ int lds_byte(int r, int c) { const int st = (r >> 4) * 2 + (c >> 5), rr = r & 15, cc = c & 31, ob = rr * 64 + cc * 2; return st * 1024 + (ob ^ (((ob >> 9) & 1) << 5)); }
__host__ __device__ __forceinline__ void stage_rc(int b, int& R, int& C) { const int st = b / 1024, sb = b % 1024, swz = sb ^ (((sb >> 9) & 1) << 5); R = (st >> 1) * 16 + swz / 64; C = (st & 1) * 32 + (swz % 64) / 2; }
__host__ __device__ __forceinline__ int perm32(int rho) { const int n = rho >> 4, i = rho & 15; return 8 * (i >> 2) + 4 * n + (i & 3); }
struct Unit { int pm, pn, kt0, nt, part; };
struct Gemm { const bf16_t* A; const bf16_t* Bt; int M, N, K, lda, adiv; };
struct SplitOrder {
    int nM, nN, nwg, G, c, R, r, s, ntK, nfull, ibeg, iend; float* part; unsigned* cnt;
    __device__ __forceinline__ void init(int M_, int N_, int K_, int G_, int c_, float* part_, unsigned* cnt_) {
        nM = M_ / BM; nN = N_ / BM; nwg = nM * nN; G = G_; c = c_; ntK = K_ / BK; part = part_; cnt = cnt_;
        r = 0; s = 1; nfull = nwg; ibeg = 0; iend = 1 << 30;
        if (G == 256 && part_ != nullptr) { const int rem = nwg % 256; if (rem != 0 && 256 % rem == 0) { const int ss = 256 / rem; if (ntK % ss == 0 && ((ntK / ss) & 1) == 0 && ntK / ss >= 4) { r = rem; s = ss; nfull = nwg - rem; } } }
    }
    __device__ __forceinline__ void map(int wgid, Unit& u) const {
        { const int q = nwg / NXCD, rr = nwg % NXCD, xcd = wgid % NXCD, off = wgid / NXCD; wgid = (xcd < rr ? xcd * (q + 1) : rr * (q + 1) + (xcd - rr) * q) + off; }
        const int nig = WGM * nN, gid = wgid / nig, fm = gid * WGM, gsz = (nM - fm) < WGM ? (nM - fm) : WGM;
        u.pm = fm + ((wgid % nig) % gsz); u.pn = (wgid % nig) / gsz;
    }
    __device__ __forceinline__ bool next(int i0, Unit& u) const {
        const int i = i0 + ibeg; int wg, kt0 = 0, nt = ntK, part = -1; bool ok;
        if (r) {
            if (i == 0) { wg = nfull + c / s; nt = ntK / s; kt0 = (c % s) * nt; part = c; ok = true; }
            else { const long L = (long)(i - 1) * G + c; ok = L < nfull; wg = ok ? (int)L : 0; }
        } else { const long L = (long)i * G + c; ok = L < nwg; wg = ok ? (int)L : 0; }
        Unit t; map(wg, t); t.kt0 = kt0; t.nt = nt; t.part = part; u = t; return ok && i < iend;
    }
};
__device__ __forceinline__ void store16_sc1(float* p, f32x4 v) { asm volatile("global_store_dwordx4 %0, %1, off sc1\n\ts_nop 1" :: "v"(p), "v"(v) : "memory"); }
template <class Epi, class Sched>
__device__ __forceinline__ void gemm_phase(LAS unsigned char* lds, const Gemm g, const Sched& S, const Epi& E, const int wid, const bool do_fix = true) {
    const int lane = fresh_lane(), tid = wid * 64 + lane, wr = wid >> 2, wc = wid & 3, fr = lane & 15, fq = lane >> 4;
    const int K = g.K;
    unsigned voffA[2], voffB[2];
#pragma unroll
    for (int i = 0; i < 2; ++i) { int R, C; stage_rc(tid * 16 + i * 8192, R, C); const int Rb = (R & ~31) + perm32(R & 31);
        voffA[i] = (unsigned)(R * g.lda + C) * 2u; voffB[i] = (unsigned)(Rb * K + C) * 2u; }
    const size_t kstep = (size_t)(BK * 2);
    const size_t hstepA = (size_t)HALF * g.lda * 2, hstepB = (size_t)HALF * K * 2;
    const size_t tstepA = 2 * hstepA, tstepB = 2 * hstepB;
    const unsigned ldsw = (unsigned)wid * 1024u;
    const int aoff = lds_byte(wr * 64 + fr, fq * 8), boff = lds_byte(wc * 32 + fr, fq * 8);
#define PG8_SA(b, h) (((b) * 2 + (h)) * HTB)
#define PG8_SB(b, h) ((4 + (b) * 2 + (h)) * HTB)
#define PG8_STAGE(bufoff, gbase, voff) do { _Pragma("unroll") for (int _i = 0; _i < 2; ++_i) \
        __builtin_amdgcn_global_load_lds((const unsigned*)((const char*)(gbase) + (voff)[_i]), (LAS unsigned*)(lds + (bufoff) + ldsw + _i * 8192), 16, 0, 0); } while (0)
#define PG8_LDA(dst, b, h) do { _Pragma("unroll") for (int m = 0; m < 4; ++m) _Pragma("unroll") for (int k = 0; k < 2; ++k) dst[m][k] = *(const LAS bf16x8*)(lds + PG8_SA(b, h) + aoff + m * 2048 + k * 1024); } while (0)
#define PG8_LDB(dst, b, h) do { _Pragma("unroll") for (int n = 0; n < 2; ++n) _Pragma("unroll") for (int k = 0; k < 2; ++k) dst[n][k] = *(const LAS bf16x8*)(lds + PG8_SB(b, h) + boff + n * 2048 + k * 1024); } while (0)
#define PG8_MMA(ai, bj, At, Bt) do { __builtin_amdgcn_s_setprio(1); _Pragma("unroll") for (int m = 0; m < 4; ++m) _Pragma("unroll") for (int n = 0; n < 2; ++n) _Pragma("unroll") for (int k = 0; k < 2; ++k) \
        acc[ai][bj][m][n] = __builtin_amdgcn_mfma_f32_16x16x32_bf16(Bt[n][k], At[m][k], acc[ai][bj][m][n], 0, 0, 0); __builtin_amdgcn_s_setprio(0); } while (0)
#define PG8_WAIT_V(n) asm volatile("s_waitcnt vmcnt(" #n ")" ::: "memory")
#define PG8_WAIT_L(n) asm volatile("s_waitcnt lgkmcnt(" #n ")" ::: "memory")
#define PG8_BAR __builtin_amdgcn_s_barrier()
#define PG8_SCHED __builtin_amdgcn_sched_barrier(0)
    Unit cur, nxt; int ui = 0;
    if (S.next(0, cur)) {
    f32x4 acc[2][2][4][2];
#pragma unroll
    for (int a = 0; a < 2; ++a)
#pragma unroll
        for (int b = 0; b < 2; ++b)
#pragma unroll
            for (int m = 0; m < 4; ++m)
#pragma unroll
                for (int n = 0; n < 2; ++n) acc[a][b][m][n] = (f32x4){0.f, 0.f, 0.f, 0.f};
    bf16x8 At[4][2], B0[2][2], B1[2][2];
    const char* cA = (const char*)g.A + (size_t)cur.pm * tstepA + (size_t)(cur.pn / g.adiv) * K * 2 + (size_t)cur.kt0 * kstep; const char* cB = (const char*)g.Bt + (size_t)cur.pn * tstepB + (size_t)cur.kt0 * kstep;
    PG8_STAGE(PG8_SB(0, 0), cB, voffB); PG8_STAGE(PG8_SB(0, 1), cB + hstepB, voffB); PG8_STAGE(PG8_SA(0, 0), cA, voffA); PG8_STAGE(PG8_SA(0, 1), cA + hstepA, voffA);
    if (wr == 1) PG8_BAR;
    PG8_WAIT_V(2); PG8_BAR;
    PG8_STAGE(PG8_SB(1, 0), cB + kstep, voffB); PG8_STAGE(PG8_SA(1, 0), cA + kstep, voffA); PG8_STAGE(PG8_SB(1, 1), cB + hstepB + kstep, voffB);
    PG8_WAIT_V(6); PG8_BAR;
    for (;;) {
        const bool has_next = S.next(ui + 1, nxt);
        const char* nA = has_next ? (const char*)g.A + (size_t)nxt.pm * tstepA + (size_t)(nxt.pn / g.adiv) * K * 2 + (size_t)nxt.kt0 * kstep : cA; const char* nB = has_next ? (const char*)g.Bt + (size_t)nxt.pn * tstepB + (size_t)nxt.kt0 * kstep : cB;
        const int nt = cur.nt;
        for (int t = 0; t < nt; t += 2) {
            const bool last = (t == nt - 2);
            const char* a1 = cA + (size_t)(t + 1) * kstep;
            const char* a2 = last ? nA : cA + (size_t)(t + 2) * kstep; const char* b2 = last ? nB : cB + (size_t)(t + 2) * kstep;
            const char* a3 = a2 + kstep; const char* b3 = b2 + kstep;
            PG8_LDB(B0, 0, 0); PG8_LDB(B1, 0, 1); PG8_SCHED; PG8_LDA(At, 0, 0); PG8_STAGE(PG8_SA(1, 1), a1 + hstepA, voffA);
            PG8_WAIT_V(8); PG8_WAIT_L(0); PG8_BAR; PG8_MMA(0, 0, At, B0); PG8_MMA(0, 1, At, B1); PG8_BAR; PG8_SCHED;
            PG8_LDA(At, 0, 1); PG8_STAGE(PG8_SB(0, 0), b2, voffB); PG8_STAGE(PG8_SB(0, 1), b2 + hstepB, voffB); PG8_STAGE(PG8_SA(0, 0), a2, voffA);
            PG8_WAIT_V(8); PG8_WAIT_L(0); PG8_BAR; PG8_MMA(1, 0, At, B0); PG8_MMA(1, 1, At, B1); PG8_BAR; PG8_SCHED;
            PG8_LDB(B0, 1, 0); PG8_LDB(B1, 1, 1); PG8_SCHED; PG8_LDA(At, 1, 0); PG8_STAGE(PG8_SA(0, 1), a2 + hstepA, voffA);
            PG8_WAIT_V(8); PG8_WAIT_L(0); PG8_BAR; PG8_MMA(0, 0, At, B0); PG8_MMA(0, 1, At, B1); PG8_BAR; PG8_SCHED;
            PG8_LDA(At, 1, 1); PG8_STAGE(PG8_SB(1, 0), b3, voffB); PG8_STAGE(PG8_SB(1, 1), b3 + hstepB, voffB); PG8_STAGE(PG8_SA(1, 0), a3, voffA);
            PG8_WAIT_V(8); PG8_WAIT_L(0); PG8_BAR; PG8_MMA(1, 0, At, B0); PG8_MMA(1, 1, At, B1); PG8_BAR; PG8_SCHED;
        }
        if (wr == 0) PG8_BAR;
        if (cur.part >= 0) {
            float* pb = S.part + (size_t)cur.part * 65536 + (size_t)(wr * 64 + fr) * 256 + wc * 32 + 8 * fq;
#pragma unroll
            for (int ai = 0; ai < 2; ++ai)
#pragma unroll
                for (int m = 0; m < 4; ++m)
#pragma unroll
                    for (int bj = 0; bj < 2; ++bj)
#pragma unroll
                        for (int n = 0; n < 2; ++n) store16_sc1(pb + (size_t)(ai * HALF + m * 16) * 256 + bj * HALF + 4 * n, acc[ai][bj][m][n]);
            asm volatile("s_waitcnt vmcnt(0)" ::: "memory");
            if (lane == 0) __hip_atomic_fetch_add(S.cnt + 64 * (cur.part / S.s), 1u, __ATOMIC_RELAXED, __HIP_MEMORY_SCOPE_AGENT);
        } else E(acc, cur, wr, wc, fr, fq);
        if (!has_next) break;
#pragma unroll
        for (int a = 0; a < 2; ++a)
#pragma unroll
            for (int b = 0; b < 2; ++b)
#pragma unroll
                for (int m = 0; m < 4; ++m)
#pragma unroll
                    for (int n = 0; n < 2; ++n) acc[a][b][m][n] = (f32x4){0.f, 0.f, 0.f, 0.f};
        cur = nxt; cA = nA; cB = nB; ++ui;
        if (wr == 1) PG8_BAR;
    }
    PG8_WAIT_V(0);
    PG8_BAR;
    }
    if (S.r && do_fix) {
        const int su = S.c / S.s, j = S.c % S.s, rows = BM / S.s; Unit fu; S.map(S.nfull + su, fu);
        if (wid == 0) { unsigned* cw = S.cnt + 64 * su; unsigned sp = 0;
            while ((unsigned)__builtin_amdgcn_readfirstlane(__hip_atomic_load(cw, __ATOMIC_RELAXED, __HIP_MEMORY_SCOPE_AGENT)) < 8u * (unsigned)S.s) { __builtin_amdgcn_s_sleep(2); if (++sp > (1u << 22)) break; }
            __builtin_amdgcn_fence(__ATOMIC_ACQUIRE, "agent"); asm volatile("s_waitcnt vmcnt(0)" ::: "memory"); }
        __syncthreads();
        const float* pbase = S.part + (size_t)(su * S.s) * 65536;
        for (int rr = wid; rr < rows; rr += 8) { const int row = j * rows + rr; f32x4 v = {0.f, 0.f, 0.f, 0.f};
            for (int q = 0; q < S.s; ++q) v += *(const f32x4*)(pbase + (size_t)q * 65536 + row * 256 + lane * 4);
            E.fix(v, fu.pm * BM + row, fu.pn * BM + lane * 4, lane); }
    }
#undef PG8_SA
#undef PG8_SB
#undef PG8_STAGE
#undef PG8_LDA
#undef PG8_LDB
#undef PG8_MMA
#undef PG8_WAIT_V
#undef PG8_WAIT_L
#undef PG8_BAR
#undef PG8_SCHED
}

struct EpiProj {
    bf16_t* O;
    __device__ __forceinline__ void fix(f32x4 v, int row, int col, int) const { u32x2 w; w.x = cvt_pk_bf16(v[0], v[1]); w.y = cvt_pk_bf16(v[2], v[3]); *(u32x2*)(O + (size_t)row * PP + col) = w; }
    __device__ __forceinline__ void operator()(const f32x4 (&acc)[2][2][4][2], const Unit& u, int wr, int wc, int fr, int fq) const {
        const int row0 = u.pm * BM + wr * 64 + fr;
        const int col0 = u.pn * BM + wc * 32 + 8 * fq;
#pragma unroll
        for (int ai = 0; ai < 2; ++ai)
#pragma unroll
            for (int m = 0; m < 4; ++m) { bf16_t* rowp = O + (size_t)(row0 + ai * HALF + m * 16) * PP + col0;
#pragma unroll
                for (int bj = 0; bj < 2; ++bj) { const f32x4 v0 = acc[ai][bj][m][0], v1 = acc[ai][bj][m][1];
                    u32x4 w; w.x = cvt_pk_bf16(v0[0], v0[1]); w.y = cvt_pk_bf16(v0[2], v0[3]); w.z = cvt_pk_bf16(v1[0], v1[1]); w.w = cvt_pk_bf16(v1[2], v1[3]);
                    *(u32x4*)(rowp + bj * HALF) = w; } }
    }
};
struct EpiPool {
    bf16_t* O; const float* scale;
    __device__ __forceinline__ void fix(f32x4, int, int, int) const {}
    __device__ __forceinline__ void operator()(const f32x4 (&acc)[2][2][4][2], const Unit& u, int wr, int wc, int fr, int fq) const {
        const int row0 = u.pm * BM + wr * 64 + fr, col0 = u.pn * BM + wc * 32 + 8 * fq;
        f32x4 sv[2][2];
#pragma unroll
        for (int bj = 0; bj < 2; ++bj)
#pragma unroll
            for (int n = 0; n < 2; ++n) sv[bj][n] = *(const f32x4*)(scale + col0 + bj * HALF + 4 * n);
#pragma unroll
        for (int ai = 0; ai < 2; ++ai)
#pragma unroll
            for (int m = 0; m < 4; ++m) { bf16_t* rowp = O + (size_t)(row0 + ai * HALF + m * 16) * DM + col0;
#pragma unroll
                for (int bj = 0; bj < 2; ++bj) { const f32x4 v0 = acc[ai][bj][m][0] * sv[bj][0], v1 = acc[ai][bj][m][1] * sv[bj][1];
                    u32x4 w; w.x = cvt_pk_bf16(v0[0], v0[1]); w.y = cvt_pk_bf16(v0[2], v0[3]); w.z = cvt_pk_bf16(v1[0], v1[1]); w.w = cvt_pk_bf16(v1[2], v1[3]);
                    *(u32x4*)(rowp + bj * HALF) = w; } }
    }
};
struct EpiOut {
    const float* xp; const float* xs; float* Y; bf16_t* X1G; const float* g2; float* rowss;
    __device__ __forceinline__ void fix(f32x4 v, int row, int col, int lane) const {
        const float* xin = (row < MP) ? xp + (size_t)row * DM : xs + (size_t)(row - MP) * DM;
        const f32x4 x1 = *(const f32x4*)(xin + col) + v; *(f32x4*)(Y + (size_t)row * DM + col) = x1;
        const f32x4 w = x1 * *(const f32x4*)(g2 + col); u32x2 o; o.x = cvt_pk_bf16(w[0], w[1]); o.y = cvt_pk_bf16(w[2], w[3]); *(u32x2*)(X1G + (size_t)row * DM + col) = o;
        float ss = (x1[0] * x1[0] + x1[1] * x1[1]) + (x1[2] * x1[2] + x1[3] * x1[3]);
        ss += swz_xor<1>(ss); ss += swz_xor<2>(ss); ss += swz_xor<4>(ss); ss += swz_xor<8>(ss); ss += swz_xor<16>(ss); ss = half_sum(ss);
        if (lane == 0) __hip_atomic_fetch_add(rowss + row, ss, __ATOMIC_RELAXED, __HIP_MEMORY_SCOPE_AGENT);
    }
    __device__ __forceinline__ void operator()(const f32x4 (&acc)[2][2][4][2], const Unit& u, int wr, int wc, int fr, int fq) const {
        const int row0 = u.pm * BM + wr * 64 + fr, col0 = u.pn * BM + wc * 32 + 8 * fq;
        const float* xin = (u.pm < MP / BM) ? xp : xs - (size_t)MP * DM;
        f32x4 gv[2][2];
#pragma unroll
        for (int bj = 0; bj < 2; ++bj)
#pragma unroll
            for (int n = 0; n < 2; ++n) gv[bj][n] = *(const f32x4*)(g2 + col0 + bj * HALF + 4 * n);
#pragma unroll
        for (int ai = 0; ai < 2; ++ai) {
            f32x4 xv[4][2][2];
#pragma unroll
            for (int m = 0; m < 4; ++m)
#pragma unroll
                for (int bj = 0; bj < 2; ++bj)
#pragma unroll
                    for (int n = 0; n < 2; ++n) xv[m][bj][n] = *(const f32x4*)(xin + (size_t)(row0 + ai * HALF + m * 16) * DM + col0 + bj * HALF + 4 * n);
#pragma unroll
            for (int m = 0; m < 4; ++m) { const int row = row0 + ai * HALF + m * 16; const size_t off = (size_t)row * DM + col0; float ss = 0.f;
#pragma unroll
                for (int bj = 0; bj < 2; ++bj) {
                    const f32x4 v0 = xv[m][bj][0] + acc[ai][bj][m][0], v1 = xv[m][bj][1] + acc[ai][bj][m][1];
                    *(f32x4*)(Y + off + bj * HALF) = v0; *(f32x4*)(Y + off + bj * HALF + 4) = v1;
                    ss += (v0[0] * v0[0] + v0[1] * v0[1]) + (v0[2] * v0[2] + v0[3] * v0[3]) + (v1[0] * v1[0] + v1[1] * v1[1]) + (v1[2] * v1[2] + v1[3] * v1[3]);
                    const f32x4 w0 = v0 * gv[bj][0], w1 = v1 * gv[bj][1];
                    u32x4 w; w.x = cvt_pk_bf16(w0[0], w0[1]); w.y = cvt_pk_bf16(w0[2], w0[3]); w.z = cvt_pk_bf16(w1[0], w1[1]); w.w = cvt_pk_bf16(w1[2], w1[3]);
                    *(u32x4*)(X1G + off + bj * HALF) = w; }
                ss += swz_xor<16>(ss); ss = half_sum(ss);
                if (fq == 0) __hip_atomic_fetch_add(rowss + row, ss, __ATOMIC_RELAXED, __HIP_MEMORY_SCOPE_AGENT); }
            asm volatile("" ::: "memory"); }
    }
};
struct EpiUp {
    bf16_t* O; const float* rowss;
    __device__ __forceinline__ void fix(f32x4 v, int row, int col, int) const {
        const float rs = __builtin_amdgcn_rsqf(rowss[row] * (1.0f / DM) + EPS); v = v * rs;
#pragma unroll
        for (int j = 0; j < 4; ++j) v[j] = fmaxf(v[j], 0.f);
        v = v * v; u32x2 o; o.x = cvt_pk_bf16(v[0], v[1]); o.y = cvt_pk_bf16(v[2], v[3]); *(u32x2*)(O + (size_t)row * DFF + col) = o;
    }
    __device__ __forceinline__ void operator()(const f32x4 (&acc)[2][2][4][2], const Unit& u, int wr, int wc, int fr, int fq) const {
        const int row0 = u.pm * BM + wr * 64 + fr, col0 = u.pn * BM + wc * 32 + 8 * fq;
#pragma unroll
        for (int ai = 0; ai < 2; ++ai)
#pragma unroll
            for (int m = 0; m < 4; ++m) { const int row = row0 + ai * HALF + m * 16; bf16_t* rowp = O + (size_t)row * DFF + col0;
                const float rs = __builtin_amdgcn_rsqf(rowss[row] * (1.0f / DM) + EPS);
#pragma unroll
                for (int bj = 0; bj < 2; ++bj) { f32x4 v0 = acc[ai][bj][m][0] * rs, v1 = acc[ai][bj][m][1] * rs;
#pragma unroll
                    for (int j = 0; j < 4; ++j) { v0[j] = fmaxf(v0[j], 0.f); v1[j] = fmaxf(v1[j], 0.f); }
                    v0 = v0 * v0; v1 = v1 * v1;
                    u32x4 w; w.x = cvt_pk_bf16(v0[0], v0[1]); w.y = cvt_pk_bf16(v0[2], v0[3]); w.z = cvt_pk_bf16(v1[0], v1[1]); w.w = cvt_pk_bf16(v1[2], v1[3]);
                    *(u32x4*)(rowp + bj * HALF) = w; } }
    }
};
struct EpiDown {
    float* Y;
    __device__ __forceinline__ void fix(f32x4 v, int row, int col, int) const { float* p = Y + (size_t)row * DM + col; *(f32x4*)p = *(const f32x4*)p + v; }
    __device__ __forceinline__ void operator()(const f32x4 (&acc)[2][2][4][2], const Unit& u, int wr, int wc, int fr, int fq) const {
        const int row0 = u.pm * BM + wr * 64 + fr, col0 = u.pn * BM + wc * 32 + 8 * fq;
#pragma unroll
        for (int ai = 0; ai < 2; ++ai) {
            f32x4 yv[4][2][2];
#pragma unroll
            for (int m = 0; m < 4; ++m)
#pragma unroll
                for (int bj = 0; bj < 2; ++bj)
#pragma unroll
                    for (int n = 0; n < 2; ++n) yv[m][bj][n] = *(const f32x4*)(Y + (size_t)(row0 + ai * HALF + m * 16) * DM + col0 + bj * HALF + 4 * n);
#pragma unroll
            for (int m = 0; m < 4; ++m)
#pragma unroll
                for (int bj = 0; bj < 2; ++bj)
#pragma unroll
                    for (int n = 0; n < 2; ++n) *(f32x4*)(Y + (size_t)(row0 + ai * HALF + m * 16) * DM + col0 + bj * HALF + 4 * n) = yv[m][bj][n] + acc[ai][bj][m][n];
            asm volatile("" ::: "memory"); }
    }
};
}

namespace att {
constexpr int D = 128, NW = 8, QBLK = 32, KVBLK = 64, QB = NW * QBLK;
constexpr int SHM_V = KVBLK * D * 2, SHM_K = KVBLK * D * 2;
constexpr int OFF_K = 2 * SHM_V, OFF_WS = 2 * SHM_V + 2 * SHM_K, OFF_CB = OFF_WS + NW * 64 * 4, LDS_NEED = OFF_CB + 8192 * 4;
constexpr int PO = DM;
constexpr float THR2 = 8.f * LOG2E;
typedef LAS char* lptr;
#define KSWZ(row, colB) ((row) * 256 + ((colB) ^ (((row) & 7) << 4)))
#define SBAR() __builtin_amdgcn_sched_barrier(0)
__device__ __forceinline__ int v_st(int k, int c) { const int kk = (k & ~0xC) | ((k & 4) << 1) | ((k & 8) >> 1); return ((kk >> 3) * 4 + (c >> 5)) * 512 + ((kk & 7) * 32 + (c & 31)) * 2; }
__device__ __forceinline__ int v_rd_base(int lane) { return ((lane & 3) << 3) | (((lane >> 2) & 3) << 6) | (((lane >> 4) & 1) << 5) | (((lane >> 5) & 1) << 8); }
constexpr int v_rd_off(int d0, int ks, int half) { return d0 * 512 + ks * 4096 + half * 2048; }
__device__ __forceinline__ int crow(int r, int hi) { return (r & 3) + 8 * (r >> 2) + 4 * hi; }
__device__ __forceinline__ bf16x8 load8(const bf16_t* p) { return *reinterpret_cast<const bf16x8*>(p); }
__device__ __forceinline__ void mask_tile(f32x16& p0, f32x16& p1, int dq) {
    const float NEG = -__builtin_inff();
#pragma unroll
    for (int r = 0; r < 16; ++r) { const int c = (r & 3) + 8 * (r >> 2);
        if (dq - c < 0) p0[r] = NEG;
        if (dq - c - 32 < 0) p1[r] = NEG; }
}
__device__ __forceinline__ void partialSM(f32x16& p0, f32x16& p1, float& m_reg, float& mn, float& alpha) {
    float pmax = p0[0];
#pragma unroll
    for (int r = 1; r < 16; ++r) pmax = fmaxf(pmax, p0[r]);
#pragma unroll
    for (int r = 0; r < 16; ++r) pmax = fmaxf(pmax, p1[r]);
    { auto rr = __builtin_amdgcn_permlane32_swap(__float_as_uint(pmax), __float_as_uint(pmax), false, false);
      pmax = fmaxf(__uint_as_float(rr[0]), __uint_as_float(rr[1])); }
    if (__builtin_expect(__all((pmax - m_reg) <= THR2), 1)) { mn = m_reg; alpha = 1.f; }
    else { mn = fmaxf(m_reg, pmax); alpha = __builtin_amdgcn_exp2f(m_reg - mn); m_reg = mn; }
#pragma unroll
    for (int r = 0; r < 16; ++r) p0[r] = p0[r] - mn;
#pragma unroll
    for (int r = 0; r < 16; ++r) p1[r] = p1[r] - mn;
#pragma unroll
    for (int r = 0; r < 16; ++r) p0[r] = __builtin_amdgcn_exp2f(p0[r]);
}
__device__ __forceinline__ void finishSM(f32x16& p0, f32x16& p1, float alpha, float& l_reg, bf16x8& pa0, bf16x8& pa1, bf16x8& pa2, bf16x8& pa3) {
#pragma unroll
    for (int r = 0; r < 16; ++r) p1[r] = __builtin_amdgcn_exp2f(p1[r]);
    float ps = 0;
#pragma unroll
    for (int r = 0; r < 16; ++r) ps += p0[r];
#pragma unroll
    for (int r = 0; r < 16; ++r) ps += p1[r];
    { auto rr = __builtin_amdgcn_permlane32_swap(__float_as_uint(ps), __float_as_uint(ps), false, false);
      ps = __uint_as_float(rr[0]) + __uint_as_float(rr[1]); }
    l_reg = l_reg * alpha + ps;
#define PK4(P, B_, OUT) do { unsigned a0 = cvt_pk_bf16(P[B_+0], P[B_+1]), a1 = cvt_pk_bf16(P[B_+2], P[B_+3]);                          \
        unsigned b0 = cvt_pk_bf16(P[B_+4], P[B_+5]), b1 = cvt_pk_bf16(P[B_+6], P[B_+7]);                                             \
        auto r0 = __builtin_amdgcn_permlane32_swap(a0, b0, false, false); auto r1 = __builtin_amdgcn_permlane32_swap(a1, b1, false, false); \
        u32x4 w = {r0[0], r1[0], r0[1], r1[1]}; OUT = __builtin_bit_cast(bf16x8, w); } while (0)
    PK4(p0, 0, pa0); PK4(p0, 8, pa1); PK4(p1, 0, pa2); PK4(p1, 8, pa3);
}
template <int KB>
__device__ __forceinline__ void qkt(f32x16& p0, f32x16& p1, lptr K_lds, const LAS float* cbt, int r32, int hi, const bf16x8* qr) {
#pragma unroll
    for (int i = 0; i < 4; ++i) { const f32x4 b0 = *(const LAS f32x4*)(cbt + 8 * i), b1 = *(const LAS f32x4*)(cbt + 32 + 8 * i);
        p0[4 * i] = b0[0]; p0[4 * i + 1] = b0[1]; p0[4 * i + 2] = b0[2]; p0[4 * i + 3] = b0[3];
        p1[4 * i] = b1[0]; p1[4 * i + 1] = b1[1]; p1[4 * i + 2] = b1[2]; p1[4 * i + 3] = b1[3]; }
    lptr kb[4];
#pragma unroll
    for (int dd = 0; dd < 4; ++dd) kb[dd] = K_lds + KB * SHM_K + KSWZ(r32, (dd * 16 + hi * 8) * 2);
#pragma unroll
    for (int d0 = 0; d0 < 8; ++d0) { lptr a = kb[d0 & 3] + (d0 >> 2) * 128;
        bf16x8 b0 = *reinterpret_cast<const LAS bf16x8*>(a);
        bf16x8 b1 = *reinterpret_cast<const LAS bf16x8*>(a + 32 * 256);
        p0 = __builtin_amdgcn_mfma_f32_32x32x16_bf16(b0, qr[d0], p0, 0, 0, 0);
        p1 = __builtin_amdgcn_mfma_f32_32x32x16_bf16(b1, qr[d0], p1, 0, 0, 0); }
}
template <int VB>
__device__ __forceinline__ void pv_tile(f32x16* o, int vb0, bf16x8 pa0, bf16x8 pa1, bf16x8 pa2, bf16x8 pa3) {
#define TRRD(dst, off) asm volatile("ds_read_b64_tr_b16 %0, %1 offset:%2" : "=&v"(dst) : "v"(vb0), "i"(off) : "memory")
#define PV_D0(d0) do { s16x4 l0, l1, l2, l3, h0, h1, h2, h3; constexpr int b_ = VB * SHM_V + v_rd_off(d0, 0, 0);   \
        TRRD(l0, b_); TRRD(h0, b_ + 2048); TRRD(l1, b_ + 4096); TRRD(h1, b_ + 6144); TRRD(l2, b_ + 8192); TRRD(h2, b_ + 10240); TRRD(l3, b_ + 12288); TRRD(h3, b_ + 14336); \
        asm volatile("s_waitcnt lgkmcnt(0)" ::: "memory"); SBAR();   \
        o[d0] = __builtin_amdgcn_mfma_f32_32x32x16_bf16(pa0, (bf16x8){l0[0], l0[1], l0[2], l0[3], h0[0], h0[1], h0[2], h0[3]}, o[d0], 0, 0, 0);   \
        o[d0] = __builtin_amdgcn_mfma_f32_32x32x16_bf16(pa1, (bf16x8){l1[0], l1[1], l1[2], l1[3], h1[0], h1[1], h1[2], h1[3]}, o[d0], 0, 0, 0);   \
        o[d0] = __builtin_amdgcn_mfma_f32_32x32x16_bf16(pa2, (bf16x8){l2[0], l2[1], l2[2], l2[3], h2[0], h2[1], h2[2], h2[3]}, o[d0], 0, 0, 0);   \
        o[d0] = __builtin_amdgcn_mfma_f32_32x32x16_bf16(pa3, (bf16x8){l3[0], l3[1], l3[2], l3[3], h3[0], h3[1], h3[2], h3[3]}, o[d0], 0, 0, 0); } while (0)
    PV_D0(0); PV_D0(1); PV_D0(2); PV_D0(3);
#undef PV_D0
#undef TRRD
}
struct Blk { int h, qb, jlo; };
struct Seam { bf16x8 qr[8]; bf16x8 st_v0, st_v1, st_k0, st_k1; };
#define VMW() asm volatile("s_waitcnt vmcnt(0)" ::: "memory")
#define VMWN(n) asm volatile("s_waitcnt vmcnt(%0)" :: "i"(n) : "memory")
#define SLOAD_H(hh, k0) do { const bf16_t* kt_ = PROJ + (size_t)(k0) * PP + (PW + AW) + (hh) * HD;                                         \
                         S.st_v0 = load8(kt_ + AW + toff); S.st_v1 = load8(kt_ + AW + 32 * PP + toff);                                      \
                         S.st_k0 = load8(kt_ + toff); S.st_k1 = load8(kt_ + 32 * PP + toff); } while (0)
#define QLOAD(hh, qq) do { const bf16_t* qt_ = PROJ + (size_t)((qq) * QB + wid * QBLK) * PP + PW + (hh) * HD;                                \
                         _Pragma("unroll") for (int d0 = 0; d0 < 8; ++d0) S.qr[d0] = load8(qt_ + qoff + d0 * 16); } while (0)
#define SWRITE_HK(bf) do { *(LAS bf16x8*)(K_lds + (bf) * SHM_K + kws) = S.st_k0; *(LAS bf16x8*)(K_lds + (bf) * SHM_K + kws + 32 * 256) = S.st_k1; } while (0)
#define SWRITE_HV(bf) do { *(LAS bf16x8*)(V_lds + (bf) * SHM_V + vst0) = S.st_v0; *(LAS bf16x8*)(V_lds + (bf) * SHM_V + vst1) = S.st_v1; } while (0)
#define SWRITE_H(bf) do { SWRITE_HV(bf); SWRITE_HK(bf); } while (0)
__device__ __forceinline__ void attn_prime(const Blk cur, const bf16_t* PROJ, lptr lds, Seam& S, const int wid) {
    const int lane = fresh_lane(), tid = wid * 64 + lane, r32 = lane & 31, hi = lane >> 5;
    const int sr = tid >> 4, sc = (tid & 15) * 8, kws = KSWZ(sr, sc * 2); lptr K_lds = lds + OFF_K;
    const unsigned toff = (unsigned)(sr * PP + sc), qoff = (unsigned)(r32 * PP + hi * 8);
    QLOAD(cur.h, cur.qb);
    SLOAD_H(cur.h, cur.jlo * KVBLK); VMW(); SWRITE_HK(0);
    __syncthreads();
}
__device__ __forceinline__ void attn_block(const Blk cur, const Blk nxt, const bf16_t* PROJ, bf16_t* MIX, const float* CB, lptr lds, Seam& S, const int wid) {
    const int lane = fresh_lane(), tid = wid * 64 + lane, r32 = lane & 31, hi = lane >> 5;
    const int P0 = cur.qb * QB, j_lo = cur.jlo, j_hi = (P0 + QB - 1) / KVBLK + 1;
    const int NT = j_hi - j_lo;
    const int qlo = P0 + wid * QBLK, qm = qlo + r32 - 4 * hi;
    lptr V_lds = lds; lptr K_lds = lds + OFF_K;
    LAS float* ws = (LAS float*)(lds + OFF_WS) + wid * 64; LAS float* li_l = ws; LAS float* al_l = ws + 32;
    LAS float* cb = (LAS float*)(lds + OFF_CB);
    float m_reg = -1e30f, l_reg = 0; f32x16 o[4] = {};
    const int sr = tid >> 4, sc = (tid & 15) * 8, vst0 = v_st(sr, sc), vst1 = v_st(32 + sr, sc), kws = KSWZ(sr, sc * 2);
    const unsigned toff = (unsigned)(sr * PP + sc);
    const int vb0 = (int)(unsigned)(size_t)V_lds + v_rd_base(lane);
    const int hh = cur.h;
    { const float* c2 = CB + (size_t)hh * SEQ; const float cref = c2[P0]; const float* csrc = c2 + j_lo * KVBLK;
      for (int i = tid * 4; i < NT * KVBLK; i += 2048) { const f32x4 c = *(const f32x4*)(csrc + i); *(LAS f32x4*)(cb + i) = cref - c; }
      __syncthreads(); }
    const LAS float* cbl = cb + 4 * hi;
#define RESC(a) do { if (__any((a) < 1.f)) { if (hi == 0) al_l[r32] = (a); asm volatile("s_waitcnt lgkmcnt(0)" ::: "memory");              \
                     _Pragma("unroll") for (int d_ = 0; d_ < 4; ++d_) _Pragma("unroll") for (int r = 0; r < 16; ++r) o[d_][r] *= al_l[crow(r, hi)]; } } while (0)
#define KBASE(t) ((j_lo + (t)) * KVBLK)
#define MASKT(P0_, P1_, t) do { const int kb_ = KBASE(t); if (kb_ + KVBLK - 1 > qlo) mask_tile(P0_, P1_, qm - kb_); } while (0)
#define SEAM_K0() do { VMWN(8); SWRITE_HK(0); SBAR(); } while (0)
    f32x16 pA0, pA1, pB0, pB1; float mnA, mnB, alA, alB; bf16x8 pa0, pa1, pa2, pa3;
    SWRITE_HV(0); SBAR();
    if (NT > 1) { SLOAD_H(hh, KBASE(1)); }
    SBAR(); qkt<0>(pA0, pA1, K_lds, cbl, r32, hi, S.qr);
    MASKT(pA0, pA1, 0); partialSM(pA0, pA1, m_reg, mnA, alA);
    if (NT > 1) { VMW(); SWRITE_H(1); }
    __syncthreads();
#define HALF_STEP(PX0, PX1, mnX, alX, PY0, PY1, alY, t, KB, VB, SB) do {                                                      \
        SBAR(); qkt<KB>(PX0, PX1, K_lds, cbl + (t) * KVBLK, r32, hi, S.qr);                                                   \
        finishSM(PY0, PY1, alY, l_reg, pa0, pa1, pa2, pa3); SBAR();                                                           \
        if ((t) + 1 < NT) { SLOAD_H(hh, KBASE((t) + 1)); SBAR(); }                                                            \
        pv_tile<VB>(o, vb0, pa0, pa1, pa2, pa3); MASKT(PX0, PX1, (t)); partialSM(PX0, PX1, m_reg, mnX, alX);                   \
        __syncthreads();                                                                                                      \
        if ((t) + 1 < NT) { VMW(); SWRITE_H(SB); }                                                                            \
        RESC(alX); __syncthreads(); } while (0)
    for (int t = 1; t + 1 < NT; t += 2) {
        HALF_STEP(pB0, pB1, mnB, alB, pA0, pA1, alA, t, 1, 0, 0);
        HALF_STEP(pA0, pA1, mnA, alA, pB0, pB1, alB, t + 1, 0, 1, 1);
    }
    const bool even = (NT & 1) == 0;
    const int l2_ = fresh_lane(), r32b_ = l2_ & 31, hib_ = l2_ >> 5, qmb_ = qlo + r32b_ - 4 * hib_;
    { const int r32 = r32b_, hi = hib_, qm = qmb_;
    if (even) { SBAR(); qkt<1>(pB0, pB1, K_lds, cbl + (NT - 1) * KVBLK, r32, hi, S.qr); SBAR(); }
    SLOAD_H(nxt.h, nxt.jlo * KVBLK); SBAR();
    { const unsigned qoff = (unsigned)(r32 * PP + hi * 8); QLOAD(nxt.h, nxt.qb); }
    SBAR();
    finishSM(pA0, pA1, alA, l_reg, pa0, pa1, pa2, pa3); SBAR();
    pv_tile<0>(o, vb0, pa0, pa1, pa2, pa3);
    if (even) { MASKT(pB0, pB1, NT - 1); partialSM(pB0, pB1, m_reg, mnB, alB); __syncthreads(); RESC(alB);
        finishSM(pB0, pB1, alB, l_reg, pa0, pa1, pa2, pa3); SBAR(); pv_tile<1>(o, vb0, pa0, pa1, pa2, pa3); }
    SBAR(); SEAM_K0();
    if (hi == 0) li_l[r32] = l_reg; asm volatile("s_waitcnt lgkmcnt(0)" ::: "memory");
    bf16_t* Ow = MIX + (size_t)(P0 + wid * QBLK) * PO + PW + hh * HD;
    const unsigned ooff = (unsigned)(4 * hi * PO + r32);
#pragma unroll
    for (int r = 0; r < 16; ++r) { const float rl = __builtin_amdgcn_rcpf(li_l[crow(r, hi)]);
#pragma unroll
        for (int d0 = 0; d0 < 4; ++d0) { const float v = o[d0][r] * rl;
            const float vn = swz_xor<1>(v);
            if ((r32 & 1) == 0) *(unsigned*)(Ow + ooff + (unsigned)(((r & 3) + 8 * (r >> 2)) * PO + d0 * 32)) = cvt_pk_bf16(v, vn); } }
    }
    __syncthreads();
#undef RESC
#undef KBASE
#undef MASKT
#undef SEAM_K0
#undef HALF_STEP
}
#undef QLOAD
#undef SLOAD_H
#undef SWRITE_HK
#undef SWRITE_HV
#undef SWRITE_H

constexpr int SOFF_ML = 0, SOFF_OT = 2048, SLDS_NEED = 2048 + 8 * 64 * 32 * 4;
template <bool NEWK>
__device__ __forceinline__ void samp_chunk(const float* Kc, const float* Vc, const bf16_t* Kn, const bf16_t* Vn, const float* bias, const bf16x8* qr,
                                           float& m_reg, float& l_reg, f32x16* oT, int r32, int hi) {
    f32x16 s;
#pragma unroll
    for (int i = 0; i < 4; ++i) { const f32x4 b = *(const f32x4*)(bias + 8 * i + 4 * hi); s[4 * i] = b[0]; s[4 * i + 1] = b[1]; s[4 * i + 2] = b[2]; s[4 * i + 3] = b[3]; }
    bf16x8 kf[8];
    if constexpr (NEWK) {
#pragma unroll
        for (int d0 = 0; d0 < 8; ++d0) kf[d0] = load8(Kn + (size_t)r32 * PP + d0 * 16 + hi * 8);
    } else {
        const float* kp = Kc + (size_t)r32 * (NH * HD) + hi * 8;
#pragma unroll
        for (int d0 = 0; d0 < 8; ++d0) kf[d0] = pack8(*(const f32x4*)(kp + d0 * 16), *(const f32x4*)(kp + d0 * 16 + 4));
    }
#pragma unroll
    for (int d0 = 0; d0 < 8; ++d0) s = __builtin_amdgcn_mfma_f32_32x32x16_bf16(kf[d0], qr[d0], s, 0, 0, 0);
    if constexpr (NEWK) {
        const float NEG = -__builtin_inff();
#pragma unroll
        for (int r = 0; r < 16; ++r) if (crow(r, hi) > r32) s[r] = NEG;
    }
    float pmax = s[0];
#pragma unroll
    for (int r = 1; r < 16; ++r) pmax = fmaxf(pmax, s[r]);
    { auto rr = __builtin_amdgcn_permlane32_swap(__float_as_uint(pmax), __float_as_uint(pmax), false, false); pmax = fmaxf(__uint_as_float(rr[0]), __uint_as_float(rr[1])); }
    const float mn = fmaxf(m_reg, pmax), alpha = __builtin_amdgcn_exp2f(m_reg - mn); m_reg = mn;
    float ps = 0.f;
#pragma unroll
    for (int r = 0; r < 16; ++r) { s[r] = __builtin_amdgcn_exp2f(s[r] - mn); ps += s[r]; }
    { auto rr = __builtin_amdgcn_permlane32_swap(__float_as_uint(ps), __float_as_uint(ps), false, false); ps = __uint_as_float(rr[0]) + __uint_as_float(rr[1]); }
    l_reg = l_reg * alpha + ps;
    if (__any(alpha < 1.f)) {
#pragma unroll
        for (int d0 = 0; d0 < 4; ++d0) oT[d0] = oT[d0] * alpha;
    }
    bf16x8 pa0, pa1; PK4(s, 0, pa0); PK4(s, 8, pa1);
#pragma unroll
    for (int ks = 0; ks < 2; ++ks) {
#pragma unroll
        for (int d0 = 0; d0 < 4; ++d0) {
            bf16x8 vf;
            if constexpr (NEWK) {
                const bf16_t* vp = Vn + (size_t)(16 * ks + 8 * hi) * PP + 32 * d0 + r32;
                short e[8];
#pragma unroll
                for (int j = 0; j < 8; ++j) e[j] = (short)vp[(size_t)j * PP];
                vf = (bf16x8){e[0], e[1], e[2], e[3], e[4], e[5], e[6], e[7]};
            } else {
                const float* vp = Vc + (size_t)(16 * ks + 8 * hi) * (NH * HD) + 32 * d0 + r32;
                float e[8];
#pragma unroll
                for (int j = 0; j < 8; ++j) e[j] = vp[(size_t)j * (NH * HD)];
                vf = pack8((f32x4){e[0], e[1], e[2], e[3]}, (f32x4){e[4], e[5], e[6], e[7]});
            }
            oT[d0] = __builtin_amdgcn_mfma_f32_32x32x16_bf16(vf, ks == 0 ? pa0 : pa1, oT[d0], 0, 0, 0);
        }
    }
}
#undef PK4
__device__ __forceinline__ void samp_unit(int b, int h, const bf16_t* PROJ, const float* cache_k, const float* cache_v, const float* CS, bf16_t* MIX, lptr lds, const int wid) {
    const int lane = fresh_lane(), tid = wid * 64 + lane, r32 = lane & 31, hi = lane >> 5;
    const bf16_t* Qp = PROJ + (size_t)(MP + b * DS) * PP + PW + h * HD;
    const bf16_t* Kn = PROJ + (size_t)(MP + b * DS) * PP + PW + AW + h * HD;
    const bf16_t* Vn = PROJ + (size_t)(MP + b * DS) * PP + PW + 2 * AW + h * HD;
    const float* bias = CS + (size_t)(b * NH + h) * 2080;
    bf16x8 qr[8];
#pragma unroll
    for (int d0 = 0; d0 < 8; ++d0) qr[d0] = load8(Qp + (size_t)r32 * PP + d0 * 16 + hi * 8);
    float m_reg = -1e30f, l_reg = 0.f; f32x16 oT[4] = {};
    const float* Kc = cache_k + ((size_t)(b * PAST + wid * 256) * NH + h) * HD;
    const float* Vc = cache_v + ((size_t)(b * PAST + wid * 256) * NH + h) * HD;
    for (int c = 0; c < 8; ++c)
        samp_chunk<false>(Kc + (size_t)c * 32 * NH * HD, Vc + (size_t)c * 32 * NH * HD, nullptr, nullptr, bias + wid * 256 + c * 32, qr, m_reg, l_reg, oT, r32, hi);
    if (wid == 7) samp_chunk<true>(nullptr, nullptr, Kn, Vn, bias + PAST, qr, m_reg, l_reg, oT, r32, hi);
    LAS float* ML = (LAS float*)(lds + SOFF_ML); LAS float* OT = (LAS float*)(lds + SOFF_OT);
    if (hi == 0) { ML[(wid * 32 + r32) * 2] = m_reg; ML[(wid * 32 + r32) * 2 + 1] = l_reg; }
    __syncthreads();
    float Mx = -1e30f;
#pragma unroll
    for (int w = 0; w < 8; ++w) Mx = fmaxf(Mx, ML[(w * 32 + r32) * 2]);
    float L = 0.f;
#pragma unroll
    for (int w = 0; w < 8; ++w) L += ML[(w * 32 + r32) * 2 + 1] * __builtin_amdgcn_exp2f(ML[(w * 32 + r32) * 2] - Mx);
    const float f = __builtin_amdgcn_exp2f(m_reg - Mx) / L;
#pragma unroll
    for (int half = 0; half < 2; ++half) {
#pragma unroll
        for (int dd = 0; dd < 2; ++dd)
#pragma unroll
            for (int r = 0; r < 16; ++r) OT[(wid * 64 + dd * 32 + crow(r, hi)) * 32 + r32] = oT[half * 2 + dd][r] * f;
        __syncthreads();
        float acc4[4] = {0.f, 0.f, 0.f, 0.f};
#pragma unroll
        for (int w = 0; w < 8; ++w)
#pragma unroll
            for (int j = 0; j < 4; ++j) acc4[j] += OT[(w * 64 + 8 * wid + 4 * hi + j) * 32 + r32];
        u32x2 o2; o2.x = cvt_pk_bf16(acc4[0], acc4[1]); o2.y = cvt_pk_bf16(acc4[2], acc4[3]);
        *(u32x2*)(MIX + (size_t)(MP + b * DS + r32) * DM + PW + h * HD + half * 64 + 8 * wid + 4 * hi) = o2;
        __syncthreads();
    }
}
}

#define XB_TMO      128
#define XB_XCNT(j)  (256  + 64 * (j))
#define XB_XSUB(j)  (1280 + 64 * (j))
#define XB_XGEN(j)  (2304 + 64 * (j))
#define XB_TOP      3328
#define XB_TOPGEN   3392
#define XCD_BAR_WORDS 3456
#define XB_SPIN_CAP (1u << 22)
__device__ __forceinline__ unsigned xb_ld(unsigned* p)              { return __hip_atomic_load(p, __ATOMIC_RELAXED, __HIP_MEMORY_SCOPE_AGENT); }
__device__ __forceinline__ unsigned xb_add(unsigned* p, unsigned v) { return __hip_atomic_fetch_add(p, v, __ATOMIC_RELAXED, __HIP_MEMORY_SCOPE_AGENT); }
__device__ __forceinline__ unsigned xb_xcc_id() { return (unsigned)__builtin_amdgcn_s_getreg((3 << 11) | 20) & 0xFu; }
#define XB_SPIN(cond, bar) do { unsigned _sp = 0; while (cond) { __builtin_amdgcn_s_sleep(1); \
    if ((++_sp & 255u) == 0u) { if (xb_ld(&(bar)[XB_TMO])) break; if (_sp > XB_SPIN_CAP) { atomicAdd(&(bar)[XB_TMO], 1u); break; } } } } while (0)
struct XcdBarrier { unsigned* bar; unsigned x; volatile LAS unsigned* st; };
__device__ __forceinline__ XcdBarrier xcd_barrier_post(unsigned* bar, volatile LAS unsigned* st, bool leader) {
    XcdBarrier b; b.bar = bar; b.x = xb_xcc_id(); b.st = st;
    if (leader) (void)xb_add(&bar[XB_XCNT(b.x)], 1u);
    return b;
}
__device__ __forceinline__ void xcd_barrier_complete(unsigned* bar, unsigned x, unsigned& nloc, unsigned& nx) {
    const unsigned G = gridDim.x * gridDim.y * gridDim.z;
    unsigned sum, cnt, mine, sp = 0u;
    for (;;) {
        sum = 0u; cnt = 0u; mine = 0u;
#pragma unroll
        for (unsigned j = 0; j < 16; ++j) { const unsigned c = xb_ld(&bar[XB_XCNT(j)]); sum += c; cnt += (c > 0u) ? 1u : 0u; mine = (j == x) ? c : mine; }
        if (sum == G) break;
        __builtin_amdgcn_s_sleep(1);
        if ((++sp & 255u) == 0u) { if (xb_ld(&bar[XB_TMO])) break; if (sp > XB_SPIN_CAP) { atomicAdd(&bar[XB_TMO], 1u); break; } }
    }
    nloc = mine > 0u ? mine : 1u; nx = cnt > 0u ? cnt : 1u;
}
__device__ __forceinline__ void xcd_barrier(const XcdBarrier& b, bool leader) {
    asm volatile("s_waitcnt vmcnt(0)" ::: "memory");
    __syncthreads();
    if (leader) {
        unsigned* bar = b.bar;
        __builtin_amdgcn_s_waitcnt(0);
        unsigned nloc = b.st[0], nx = b.st[1];
        if (nloc == 0u) { xcd_barrier_complete(bar, b.x, nloc, nx); b.st[0] = nloc; b.st[1] = nx; }
        const unsigned old = xb_add(&bar[XB_XSUB(b.x)], 1u);
        const unsigned gen = old / nloc;
        if (old + 1u == (gen + 1u) * nloc) {
            __builtin_amdgcn_fence(__ATOMIC_RELEASE, "agent");
            asm volatile("s_waitcnt vmcnt(0)" ::: "memory");
            const unsigned og = xb_add(&bar[XB_TOP], 1u);
            const unsigned tg = og / nx;
            if (og + 1u == (tg + 1u) * nx) xb_add(&bar[XB_TOPGEN], 1u);
            else XB_SPIN(xb_ld(&bar[XB_TOPGEN]) == tg, bar);
            __builtin_amdgcn_fence(__ATOMIC_ACQUIRE, "agent");
            xb_add(&bar[XB_XGEN(b.x)], 1u);
            asm volatile("s_waitcnt vmcnt(0)" ::: "memory");
        } else {
            XB_SPIN(xb_ld(&bar[XB_XGEN(b.x)]) == gen, bar);
            __builtin_amdgcn_fence(__ATOMIC_ACQUIRE, "agent");
            asm volatile("s_waitcnt vmcnt(0)" ::: "memory");
        }
    }
    __syncthreads();
}

#ifndef PHASES
#define PHASES 0xfff
#endif
#ifndef PROBE
#define PROBE 0
#endif
#define REPS(id) for (int rep_ = 0; rep_ < ((PROBE == (id)) ? 2 : 1); ++rep_)
struct Args {
    const float *x_prompt, *x_sample, *cache_k, *cache_v, *cache_logf, *state_pool, *attn_norm_g, *w_in, *b_f, *q_norm_g, *k_norm_g, *w_pool, *pool_scale, *w_out, *mlp_norm_g, *w_up, *w_down;
    float* out; unsigned char* ws;
};
__device__ __forceinline__ float wave_sum(float v) { v += swz_xor<1>(v); v += swz_xor<2>(v); v += swz_xor<4>(v); v += swz_xor<8>(v); v += swz_xor<16>(v); return half_sum(v); }
__device__ __forceinline__ float wave_max(float v) { v = fmaxf(v, swz_xor<1>(v)); v = fmaxf(v, swz_xor<2>(v)); v = fmaxf(v, swz_xor<4>(v)); v = fmaxf(v, swz_xor<8>(v)); v = fmaxf(v, swz_xor<16>(v)); return half_max(v); }
constexpr int TR_LDS = 64 * 33 * 4;
__device__ __forceinline__ void transpose_tile(const float* W, int K, int N, bf16_t* WT, LAS unsigned* scr, int kb, int nb, int lane) {
    const int k0 = 64 * kb, n0 = 64 * nb, kq = lane >> 4, n4 = lane & 15;
    const bool okc = n0 + 4 * n4 < N;
    f32x4 ra[8], rb[8];
    const float* src = W + (size_t)(k0 + 2 * kq) * N + n0 + 4 * n4;
#pragma unroll
    for (int j = 0; j < 8; ++j) {
        ra[j] = okc ? __builtin_nontemporal_load((const f32x4*)(src + (size_t)(8 * j) * N)) : (f32x4){0.f, 0.f, 0.f, 0.f};
        rb[j] = okc ? __builtin_nontemporal_load((const f32x4*)(src + (size_t)(8 * j + 1) * N)) : (f32x4){0.f, 0.f, 0.f, 0.f}; }
#pragma unroll
    for (int j = 0; j < 8; ++j)
#pragma unroll
        for (int e = 0; e < 4; ++e) scr[(4 * n4 + e) * 33 + 4 * j + kq] = cvt_pk_bf16(ra[j][e], rb[j][e]);
    asm volatile("s_waitcnt lgkmcnt(0)" ::: "memory");
    const int c = lane & 7;
#pragma unroll
    for (int i = 0; i < 8; ++i) { const int n = (lane >> 3) + 8 * i; const LAS unsigned* p = scr + n * 33 + 4 * c;
        u32x4 o; o.x = p[0]; o.y = p[1]; o.z = p[2]; o.w = p[3];
        if (n0 + n < N) __builtin_nontemporal_store(o, (u32x4*)(WT + (size_t)(n0 + n) * K + k0 + 8 * c)); }
    asm volatile("s_waitcnt lgkmcnt(0)" ::: "memory");
}
__device__ __forceinline__ float log_sigmoid(float x) { return fminf(x, 0.f) - log1pf(__expf(-fabsf(x))); }

__global__ void __launch_bounds__(512, 2) hymba_fwd(Args a) {
    extern __shared__ __attribute__((aligned(16))) unsigned char lds_raw[];
    LAS unsigned char* lds = (LAS unsigned char*)lds_raw;
    volatile LAS unsigned* MISC = (volatile LAS unsigned*)(lds + MISC_OFF);
    const int wave = __builtin_amdgcn_readfirstlane((int)threadIdx.x >> 6);
    const int G = gridDim.x; const int bx = blockIdx.x; const int vcu = (G % 8 == 0) ? (bx % 8) * (G / 8) + bx / 8 : bx;
    unsigned char* ws = a.ws;
    unsigned* ctl = (unsigned*)(ws + WS_CTL);
    bf16_t* WI = (bf16_t*)(ws + WS_WI); bf16_t* WP = (bf16_t*)(ws + WS_WP); bf16_t* WO = (bf16_t*)(ws + WS_WO); bf16_t* WU = (bf16_t*)(ws + WS_WU); bf16_t* WD = (bf16_t*)(ws + WS_WD);
    bf16_t* XN = (bf16_t*)(ws + WS_XN); bf16_t* PROJ = (bf16_t*)(ws + WS_PROJ); float* FL = (float*)(ws + WS_FL); float* CB = (float*)(ws + WS_CB); float* CS = (float*)(ws + WS_CS);
    bf16_t* DP = (bf16_t*)(ws + WS_DP); bf16_t* MIX = (bf16_t*)(ws + WS_MIX); bf16_t* X1G = (bf16_t*)(ws + WS_X1G); bf16_t* HID = (bf16_t*)(ws + WS_HID); float* PART = (float*)(ws + WS_PART);
    int* JLO = (int*)(ctl + CW_JLO); float* RSS = (float*)(ctl + CW_RSS);
    float* out = a.out;
    for (int u = wave * 64 + fresh_lane(); u < (LDS_BYTES - 131072) / 4; u += 512) ((LAS unsigned*)(lds + 131072))[u] = 0u;
    __syncthreads();
    XcdBarrier bar = xcd_barrier_post(ctl + CW_BAR, MISC + 8, wave == 0 && fresh_lane() == 0);
    const int gw = vcu * 8 + wave, NGW = G * 8;

    REPS(1) {
        const int lane = fresh_lane();
        LAS unsigned* scr = (LAS unsigned*)(lds + wave * TR_LDS);
        constexpr int NB_I = (NPROJ + 63) / 64, I_I = (DM / 64) * NB_I, I_P = 4 * (PG / 64) * (PG / 64), I_O = (DM / 64) * (DM / 64);
        constexpr int NITEMS = I_I + I_P + I_O;
        for (int it = gw; it < NITEMS; it += NGW) {
            int r = it;
            if (r < I_I) { transpose_tile(a.w_in, DM, NPROJ, WI, scr, r / NB_I, r % NB_I, lane); continue; } r -= I_I;
            if (r < I_P) { const int g = r / ((PG / 64) * (PG / 64)), q = r % ((PG / 64) * (PG / 64)); transpose_tile(a.w_pool + (size_t)g * PG * PG, PG, PG, WP + (size_t)g * PG * PG, scr, q / (PG / 64), q % (PG / 64), lane); continue; } r -= I_P;
            transpose_tile(a.w_out, DM, DM, WO, scr, r / (DM / 64), r % (DM / 64), lane);
        }
        for (int m = gw; m < M; m += NGW) {
            const float* xrow = (m < MP) ? a.x_prompt + (size_t)m * DM : a.x_sample + (size_t)(m - MP) * DM;
            f32x4 v[16]; float s = 0.f;
#pragma unroll
            for (int j = 0; j < 16; ++j) { v[j] = *(const f32x4*)(xrow + 256 * j + 4 * lane); s += (v[j][0] * v[j][0] + v[j][1] * v[j][1]) + (v[j][2] * v[j][2] + v[j][3] * v[j][3]); }
            const float rstd = __builtin_amdgcn_rsqf(wave_sum(s) * (1.0f / DM) + EPS);
#pragma unroll
            for (int j = 0; j < 16; ++j) { const f32x4 gg = *(const f32x4*)(a.attn_norm_g + 256 * j + 4 * lane); const f32x4 y = v[j] * rstd * gg;
                u32x2 o; o.x = cvt_pk_bf16(y[0], y[1]); o.y = cvt_pk_bf16(y[2], y[3]); *(u32x2*)(XN + (size_t)m * DM + 256 * j + 4 * lane) = o; }
        }
    }
    xcd_barrier(bar, wave == 0 && fresh_lane() == 0);

    REPS(2) {
        {
            const int lane = fresh_lane(), fr = lane & 15, fq = lane >> 4;
            for (int t = gw; t < (M / 16) * 4; t += NGW) {
                const int rg = t >> 2, kq = t & 3;
                const bf16_t* xa = XN + (size_t)(rg * 16 + fr) * DM + kq * 1024 + 8 * fq;
                const bf16_t* wb = WI + (size_t)(PW + 3 * AW + fr) * DM + kq * 1024 + 8 * fq;
                f32x4 acc = {0.f, 0.f, 0.f, 0.f};
#pragma unroll 8
                for (int k = 0; k < 32; ++k) { const bf16x8 xv = *(const bf16x8*)(xa + 32 * k), wv = *(const bf16x8*)(wb + 32 * k);
                    acc = __builtin_amdgcn_mfma_f32_16x16x32_bf16(wv, xv, acc, 0, 0, 0); }
                *(f32x4*)(FL + ((size_t)kq * M + rg * 16 + fr) * NH + 4 * fq) = acc;
            }
        }
        pg8::Gemm g{XN, WI, M, PP, DM, DM, 1 << 30}; pg8::SplitOrder S; S.init(M, PP, DM, G, bx, PART, ctl + CW_SPLIT + (0 + 4 * rep_) * 8192);
        pg8::EpiProj E{PROJ};
        const int ncls = (S.r && G == 256) ? S.nfull / G + 1 : 1, cls = (bx >> 3) % ncls;
#pragma unroll 1
        for (int seg = 0; seg < 2; ++seg) {
            S.ibeg = seg == 0 ? 0 : cls; S.iend = seg == 0 ? cls : (1 << 30);
            pg8::gemm_phase<pg8::EpiProj, pg8::SplitOrder>(lds, g, S, E, wave, seg == 1);
            if (seg == 0) {
                const int lane = fresh_lane(); LAS unsigned* scr = (LAS unsigned*)(lds + wave * TR_LDS);
                constexpr int I_U = (DM / 64) * (DFF / 64), I_D = (DFF / 64) * (DM / 64);
                for (int it = gw; it < I_U + I_D; it += NGW) {
                    if (it < I_U) transpose_tile(a.w_up, DM, DFF, WU, scr, it / (DFF / 64), it % (DFF / 64), lane);
                    else { const int r = it - I_U; transpose_tile(a.w_down, DFF, DM, WD, scr, r / (DM / 64), r % (DM / 64), lane); }
                }
                asm volatile("s_waitcnt vmcnt(0) lgkmcnt(0)" ::: "memory"); __syncthreads();
            }
        }
    }
    xcd_barrier(bar, wave == 0 && fresh_lane() == 0);

    {
        const int lane = fresh_lane(), tid = wave * 64 + lane;
#define FLS(i) ((FL[(i)] + FL[(size_t)M * NH + (i)]) + (FL[(size_t)2 * M * NH + (i)] + FL[(size_t)3 * M * NH + (i)]))
        if (vcu < 16) {
            const int h = vcu; LAS float* cl = (LAS float*)lds; LAS double* tot = (LAS double*)(lds + 65536);
            const float bf = a.b_f[h]; float lf[16]; double run = 0.0;
#pragma unroll
            for (int j = 0; j < 16; ++j) lf[j] = log_sigmoid(FLS((size_t)(tid * 16 + j) * NH + h) + bf);
#pragma unroll
            for (int j = 0; j < 16; ++j) { out[O_FP + (size_t)(tid * 16 + j) * NH + h] = lf[j]; run += (double)lf[j]; }
            tot[tid] = run; __syncthreads();
            if (tid == 0) { double s = 0.0; for (int i = 0; i < 512; ++i) { const double t = tot[i]; tot[i] = s; s += t; } }
            __syncthreads();
            double c = tot[tid];
#pragma unroll
            for (int j = 0; j < 16; ++j) { c += (double)lf[j]; cl[tid * 16 + j] = (float)c; CB[(size_t)h * SEQ + tid * 16 + j] = (float)(c * (double)LOG2E); }
            __syncthreads();
            if (tid < 64) {
                float gq = fmaxf(fabsf(a.q_norm_g[tid]), fabsf(a.q_norm_g[tid + 64])), gk = fmaxf(fabsf(a.k_norm_g[tid]), fabsf(a.k_norm_g[tid + 64]));
                gq = wave_max(gq); gk = wave_max(gk);
                const float U = 11.3137085f * gq * gk; const float thr = -(2.f * U + PRUNE_T);
                if (tid < 32) { const int qb = tid; const float cP = cl[qb * 256]; int j = 0; while (j < 4 * qb && (cP - cl[64 * j + 63]) < thr) ++j; JLO[h * 32 + qb] = j; }
            }
            __syncthreads();
        } else if (vcu < 32) {
            const int b = vcu - 16, h = tid & 15, seg = tid >> 4; LAS double* tot = (LAS double*)(lds + 65536);
            const float* lsrc = a.cache_logf + ((size_t)b * PAST + seg * 64) * NH + h;
            double run = 0.0;
#pragma unroll 16
            for (int j = 0; j < 64; ++j) run += (double)lsrc[(size_t)j * NH];
            tot[tid] = run; __syncthreads();
            double c = 0.0; for (int s = 0; s < seg; ++s) c += tot[s * 16 + h];
            double ctot = 0.0; for (int s = 0; s < 32; ++s) ctot += tot[s * 16 + h];
            const float bf = a.b_f[h];
            const float lf0 = log_sigmoid(FLS((size_t)(MP + b * DS) * NH + h) + bf);
            const double cref = ctot + (double)lf0;
            float* csd = CS + (size_t)(b * NH + h) * 2080;
#pragma unroll 16
            for (int j = 0; j < 64; ++j) { c += (double)lsrc[(size_t)j * NH]; csd[seg * 64 + j] = (float)((cref - c) * (double)LOG2E); }
            if (seg == 31) {
                double cn = ctot;
                for (int s = 0; s < DS; ++s) { const float l = log_sigmoid(FLS((size_t)(MP + b * DS + s) * NH + h) + bf); out[O_FS + (size_t)(b * DS + s) * NH + h] = l; cn += (double)l; csd[PAST + s] = (float)((cref - cn) * (double)LOG2E); }
            }
            __syncthreads();
        }
#undef FLS
        for (int m = gw; m < M; m += NGW) {
            bf16_t* pr = PROJ + (size_t)m * PP + 32 * lane;
            float* ko = ((m < MP) ? out + O_KP + (size_t)m * AW : out + O_KS + (size_t)(m - MP) * AW) + 32 * lane;
            float* vo = ((m < MP) ? out + O_VP + (size_t)m * AW : out + O_VS + (size_t)(m - MP) * AW) + 32 * lane;
            const int dofs = (32 * lane) & 127;
#pragma unroll
            for (int which = 0; which < 2; ++which) {
                bf16_t* p = pr + PW + which * AW; const float* gsrc = (which == 0 ? a.q_norm_g : a.k_norm_g) + dofs;
                u32x4 w4[4];
#pragma unroll
                for (int j = 0; j < 4; ++j) w4[j] = *(const u32x4*)(p + 8 * j);
                float v[32]; float ss = 0.f;
#pragma unroll
                for (int j = 0; j < 4; ++j)
#pragma unroll
                    for (int e = 0; e < 4; ++e) { v[8 * j + 2 * e] = bf_lo(w4[j][e]); v[8 * j + 2 * e + 1] = bf_hi(w4[j][e]); }
#pragma unroll
                for (int i = 0; i < 32; ++i) ss += v[i] * v[i];
                ss += swz_xor<1>(ss); ss += swz_xor<2>(ss);
                const float rs = __builtin_amdgcn_rsqf(ss * (1.0f / HD) + EPS) * (which == 0 ? QSCALE : 1.0f);
#pragma unroll
                for (int j = 0; j < 8; ++j) { const f32x4 gg = *(const f32x4*)(gsrc + 4 * j);
#pragma unroll
                    for (int e = 0; e < 4; ++e) v[4 * j + e] = v[4 * j + e] * rs * gg[e]; }
#pragma unroll
                for (int j = 0; j < 4; ++j) { u32x4 w; w.x = cvt_pk_bf16(v[8 * j], v[8 * j + 1]); w.y = cvt_pk_bf16(v[8 * j + 2], v[8 * j + 3]); w.z = cvt_pk_bf16(v[8 * j + 4], v[8 * j + 5]); w.w = cvt_pk_bf16(v[8 * j + 6], v[8 * j + 7]);
                    *(u32x4*)(p + 8 * j) = w; }
                if (which == 1) {
#pragma unroll
                    for (int j = 0; j < 8; ++j) *(f32x4*)(ko + 4 * j) = (f32x4){v[4 * j], v[4 * j + 1], v[4 * j + 2], v[4 * j + 3]};
                }
            }
            {
                u32x4 vw[4];
#pragma unroll
                for (int j = 0; j < 4; ++j) vw[j] = *(const u32x4*)(pr + PW + 2 * AW + 8 * j);
#pragma unroll
                for (int j = 0; j < 4; ++j) { *(f32x4*)(vo + 8 * j) = (f32x4){bf_lo(vw[j][0]), bf_hi(vw[j][0]), bf_lo(vw[j][1]), bf_hi(vw[j][1])};
                    *(f32x4*)(vo + 8 * j + 4) = (f32x4){bf_lo(vw[j][2]), bf_hi(vw[j][2]), bf_lo(vw[j][3]), bf_hi(vw[j][3])}; }
            }
        }
        for (int task = gw; task < (M / 32) * 4; task += NGW) {
            const int chunk = task >> 2, g = task & 3, w = 2 << g; const int col = g * PG + 8 * lane;
            const bool samp = chunk >= MP / 32; const int r0 = chunk * 32; const int b = chunk - MP / 32;
            const float inv_w = 1.0f / (float)w;
            auto ld8 = [&](int e, float (&v)[8]) {
                if (e >= 0 || (!samp && r0 + e >= 0)) { const u32x4 wv = *(const u32x4*)(PROJ + (size_t)(r0 + e) * PP + col);
#pragma unroll
                    for (int i = 0; i < 4; ++i) { v[2 * i] = bf_lo(wv[i]); v[2 * i + 1] = bf_hi(wv[i]); } }
                else if (samp) { const float* sp = a.state_pool + ((size_t)b * PH + (PH + e)) * PW + col; const f32x4 x0 = *(const f32x4*)sp, x1 = *(const f32x4*)(sp + 4);
                    v[0] = x0[0]; v[1] = x0[1]; v[2] = x0[2]; v[3] = x0[3]; v[4] = x1[0]; v[5] = x1[1]; v[6] = x1[2]; v[7] = x1[3]; }
                else {
#pragma unroll
                    for (int i = 0; i < 8; ++i) v[i] = 0.f; }
            };
            float Sx[8];
#pragma unroll
            for (int i = 0; i < 8; ++i) Sx[i] = 0.f;
            for (int e = -(w - 1); e < 0; ++e) { float t[8]; ld8(e, t);
#pragma unroll
                for (int i = 0; i < 8; ++i) Sx[i] += t[i]; }
            for (int e = 0; e < 32; ++e) {
                float cur[8], old[8]; ld8(e, cur); ld8(e - w + 1, old);
#pragma unroll
                for (int i = 0; i < 8; ++i) Sx[i] += cur[i];
                float ic = inv_w; if (!samp) { const int pos = r0 + e; if (pos + 1 < w) ic = 1.0f / (float)(pos + 1); }
                float d[8];
#pragma unroll
                for (int i = 0; i < 8; ++i) d[i] = Sx[i] * ic - cur[i];
                u32x4 o; o.x = cvt_pk_bf16(d[0], d[1]); o.y = cvt_pk_bf16(d[2], d[3]); o.z = cvt_pk_bf16(d[4], d[5]); o.w = cvt_pk_bf16(d[6], d[7]);
                *(u32x4*)(DP + (size_t)(r0 + e) * PW + col) = o;
#pragma unroll
                for (int i = 0; i < 8; ++i) Sx[i] -= old[i];
            }
        }
        for (int t = gw; t < PH * (1 + DB); t += NGW) {
            const int s = t / PH, j = t % PH;
            const int row = (s == 0) ? (MP - PH + j) : (MP + (s - 1) * DS + (DS - PH) + j);
            float* dst = (s == 0) ? out + O_HP + (size_t)j * PW : out + O_HS + ((size_t)(s - 1) * PH + j) * PW;
#pragma unroll
            for (int i = 0; i < 4; ++i) { const u32x4 wv = *(const u32x4*)(PROJ + (size_t)row * PP + 32 * lane + 8 * i);
                *(f32x4*)(dst + 32 * lane + 8 * i) = (f32x4){bf_lo(wv[0]), bf_hi(wv[0]), bf_lo(wv[1]), bf_hi(wv[1])};
                *(f32x4*)(dst + 32 * lane + 8 * i + 4) = (f32x4){bf_lo(wv[2]), bf_hi(wv[2]), bf_lo(wv[3]), bf_hi(wv[3])}; }
        }
    }
    xcd_barrier(bar, wave == 0 && fresh_lane() == 0);

    {
        const int cls3 = (G == 256) ? (bx >> 3) % 3 : 2;
#define SAMP_JOB() do { for (int u = vcu; u < DB * NH; u += G) att::samp_unit(u >> 4, u & 15, PROJ, a.cache_k, a.cache_v, CS, MIX, (att::lptr)lds, wave); \
                        asm volatile("s_waitcnt vmcnt(0)" ::: "memory"); __syncthreads(); } while (0)
        if (cls3 == 0) SAMP_JOB();
        {
            pg8::Gemm g{DP, WP, M, PW, PG, PW, 2}; pg8::SplitOrder S; S.init(M, PW, PG, G, bx, nullptr, nullptr);
            pg8::EpiPool E{MIX, a.pool_scale};
            pg8::gemm_phase<pg8::EpiPool, pg8::SplitOrder>(lds, g, S, E, wave);
        }
        if (cls3 == 1) SAMP_JOB();
        {
            int nblk = 0; for (int it = vcu; it < 256; it += G) nblk += 2;
            auto ref = [&](int i) { const int item = vcu + (i >> 1) * G, h = item >> 4, x = item & 15, qb = (i & 1) ? 31 - x : x;
                att::Blk r; r.h = h; r.qb = qb; r.jlo = JLO[h * 32 + qb]; return r; };
            if (nblk > 0) {
                att::Seam S; att::Blk cur = ref(0);
                att::attn_prime(cur, PROJ, (att::lptr)lds, S, wave);
                for (int i = 0; i < nblk; ++i) { const att::Blk nxt = (i + 1 < nblk) ? ref(i + 1) : cur; att::attn_block(cur, nxt, PROJ, MIX, CB, (att::lptr)lds, S, wave); cur = nxt; }
            }
            asm volatile("s_waitcnt vmcnt(0)" ::: "memory"); __syncthreads();
        }
        if (cls3 == 2) SAMP_JOB();
#undef SAMP_JOB
    }
    xcd_barrier(bar, wave == 0 && fresh_lane() == 0);

    REPS(6) {
        pg8::Gemm g{MIX, WO, M, DM, DM, DM, 1 << 30}; pg8::SplitOrder S; S.init(M, DM, DM, G, bx, PART, ctl + CW_SPLIT + (1 + 4 * rep_) * 8192);
        pg8::EpiOut E{a.x_prompt, a.x_sample, out, X1G, a.mlp_norm_g, rep_ ? RSS + 16384 : RSS};
        pg8::gemm_phase<pg8::EpiOut, pg8::SplitOrder>(lds, g, S, E, wave);
    }
    xcd_barrier(bar, wave == 0 && fresh_lane() == 0);

    REPS(7) {
        pg8::Gemm g{X1G, WU, M, DFF, DM, DM, 1 << 30}; pg8::SplitOrder S; S.init(M, DFF, DM, G, bx, PART, ctl + CW_SPLIT + (2 + 4 * rep_) * 8192);
        pg8::EpiUp E{HID, RSS};
        pg8::gemm_phase<pg8::EpiUp, pg8::SplitOrder>(lds, g, S, E, wave);
    }
    xcd_barrier(bar, wave == 0 && fresh_lane() == 0);

    REPS(8) {
        pg8::Gemm g{HID, WD, M, DM, DFF, DFF, 1 << 30}; pg8::SplitOrder S; S.init(M, DM, DFF, G, bx, PART, ctl + CW_SPLIT + (3 + 4 * rep_) * 8192);
        pg8::EpiDown E{rep_ ? (float*)(ws + WS_END) : out};
        pg8::gemm_phase<pg8::EpiDown, pg8::SplitOrder>(lds, g, S, E, wave);
    }
}

extern "C" void kernel_launch(void* const* d_in, const int* in_sizes, int n_in, void* d_out, int out_size, void* d_ws, size_t ws_size, hipStream_t stream) {
    static int grid = 0;
    if (grid == 0) {
        if (n_in != 17 || in_sizes[0] != MP * DM || (size_t)out_size != O_END || ws_size < WS_END + (PROBE == 8 ? (size_t)M * DM * 4 : 0)) {
            fprintf(stderr, "kernel_launch: shape mismatch (n_in %d, in0 %d, out %d, ws %zu; need 17, %d, %zu, >= %zu)\n", n_in, n_in > 0 ? in_sizes[0] : -1, out_size, ws_size, MP * DM, (size_t)O_END, (size_t)WS_END);
            grid = -1; return; }
        int dev = 0, cus = 0, per_cu = 0;
        if (hipGetDevice(&dev) != hipSuccess || hipDeviceGetAttribute(&cus, hipDeviceAttributeMultiprocessorCount, dev) != hipSuccess) { grid = -1; return; }
        if (hipFuncSetAttribute((const void*)hymba_fwd, hipFuncAttributeMaxDynamicSharedMemorySize, LDS_BYTES) != hipSuccess) { fprintf(stderr, "kernel_launch: hipFuncSetAttribute failed\n"); grid = -1; return; }
        if (hipOccupancyMaxActiveBlocksPerMultiprocessor(&per_cu, (const void*)hymba_fwd, 512, LDS_BYTES) != hipSuccess || per_cu < 1) { fprintf(stderr, "kernel_launch: occupancy query says %d\n", per_cu); }
        (void)hipGetLastError();
        grid = cus;
    }
    if (grid < 0) return;
    if (hipMemsetAsync((char*)d_ws + WS_CTL, 0, CTL_ZERO_BYTES, stream) != hipSuccess) { fprintf(stderr, "kernel_launch: memset failed\n"); return; }
    Args a{};
    a.x_prompt = (const float*)d_in[0]; a.x_sample = (const float*)d_in[1]; a.cache_k = (const float*)d_in[2]; a.cache_v = (const float*)d_in[3]; a.cache_logf = (const float*)d_in[4];
    a.state_pool = (const float*)d_in[5]; a.attn_norm_g = (const float*)d_in[6]; a.w_in = (const float*)d_in[7]; a.b_f = (const float*)d_in[8]; a.q_norm_g = (const float*)d_in[9];
    a.k_norm_g = (const float*)d_in[10]; a.w_pool = (const float*)d_in[11]; a.pool_scale = (const float*)d_in[12]; a.w_out = (const float*)d_in[13]; a.mlp_norm_g = (const float*)d_in[14];
    a.w_up = (const float*)d_in[15]; a.w_down = (const float*)d_in[16];
    a.out = (float*)d_out; a.ws = (unsigned char*)d_ws;
    hipLaunchKernelGGL(hymba_fwd, dim3(grid), dim3(512), LDS_BYTES, stream, a);
    const hipError_t le = hipPeekAtLastError();
    if (le != hipSuccess) fprintf(stderr, "kernel_launch: launch failed: %s\n", hipGetErrorName(le));
}
```

```cpp
#include <hip/hip_runtime.h>
#include <cstdio>
#include <cstdint>

#define LAS __attribute__((address_space(3)))
#define GAS __attribute__((address_space(1)))
typedef unsigned short bf16_t;
typedef short bf16x8 __attribute__((ext_vector_type(8)));
typedef short s16x4 __attribute__((ext_vector_type(4)));
typedef float f32x2 __attribute__((ext_vector_type(2)));
typedef float f32x4 __attribute__((ext_vector_type(4)));
typedef float f32x16 __attribute__((ext_vector_type(16)));
typedef unsigned u32x2 __attribute__((ext_vector_type(2)));
typedef unsigned u32x4 __attribute__((ext_vector_type(4)));

constexpr int DM = 4096, SEQ = 8192, DB = 16, DS = 32, PAST = 2048;
constexpr int MP = SEQ, MS = DB * DS, M = MP + MS;
constexpr int PW = 2048, AW = 2048, NH = 16, HD = 128, PH = 15, PG = 512;
constexpr int NPROJ = PW + 3 * AW + NH;
constexpr int NPROJ_PAD = 8448;
constexpr int PP = 8192;
constexpr int DFF = 16384;
constexpr float EPS = 1e-6f;
constexpr float QSCALE = 0.08838834764831845f * 1.4426950408889634f;
constexpr float LOG2E = 1.4426950408889634f;
constexpr float PRUNE_T = 40.0f;
constexpr size_t O_YP = 0, O_YS = (size_t)MP * DM, O_KP = O_YS + (size_t)MS * DM, O_VP = O_KP + (size_t)MP * AW, O_FP = O_VP + (size_t)MP * AW,
                 O_HP = O_FP + (size_t)MP * NH, O_KS = O_HP + (size_t)PH * PW, O_VS = O_KS + (size_t)MS * AW, O_FS = O_VS + (size_t)MS * AW,
                 O_HS = O_FS + (size_t)MS * NH, O_END = O_HS + (size_t)DB * PH * PW;
static_assert(O_END == 71964672, "output size");
constexpr size_t MiB = 1u << 20;
constexpr size_t WS_CTL = 0, CTL_ZERO_BYTES = 1 * MiB;
constexpr size_t WS_WI = 2 * MiB, WS_WP = 68 * MiB, WS_WO = 70 * MiB, WS_WU = 102 * MiB, WS_WD = 230 * MiB, WS_XN = 358 * MiB, WS_PROJ = 426 * MiB,
                 WS_FL = 562 * MiB, WS_CB = 565 * MiB, WS_CS = 566 * MiB, WS_DP = 569 * MiB, WS_MIX = 603 * MiB, WS_X1G = 671 * MiB, WS_HID = 739 * MiB, WS_PART = 1011 * MiB, WS_END = 1075 * MiB;
static_assert(WS_WI + (size_t)NPROJ_PAD * DM * 2 <= WS_WP && WS_XN + (size_t)M * DM * 2 <= WS_PROJ && WS_PROJ + (size_t)M * PP * 2 <= WS_FL && WS_FL + (size_t)4 * M * NH * 4 <= WS_CB && WS_CS + (size_t)DB * NH * 2080 * 4 <= WS_DP &&
              WS_DP + (size_t)M * PW * 2 <= WS_MIX && WS_HID + (size_t)M * DFF * 2 <= WS_PART && WS_PART + (size_t)256 * 65536 * 4 <= WS_END, "ws map");
constexpr int CW_BAR = 4096;
constexpr int CW_JLO = 16384;
constexpr int CW_RSS = 32768;
constexpr int CW_SPLIT = 65536;
static_assert((CW_RSS + 16384 + M) <= CW_SPLIT && (CW_SPLIT + 8 * 8192) * 4 <= (int)CTL_ZERO_BYTES, "ctl");
constexpr int LDS_BYTES = 147456;
constexpr int MISC_OFF = LDS_BYTES - 128;

__device__ __forceinline__ int fresh_lane() { int l; asm volatile("v_mbcnt_lo_u32_b32 %0, -1, 0\n\tv_mbcnt_hi_u32_b32 %0, -1, %0" : "=v"(l)); return l; }
template <int X> __device__ __forceinline__ float swz_xor(float v) { return __int_as_float(__builtin_amdgcn_ds_swizzle(__float_as_int(v), (X << 10) | 0x1f)); }
__device__ __forceinline__ float half_sum(float v) { auto rr = __builtin_amdgcn_permlane32_swap(__float_as_uint(v), __float_as_uint(v), false, false); return __uint_as_float(rr[0]) + __uint_as_float(rr[1]); }
__device__ __forceinline__ float half_max(float v) { auto rr = __builtin_amdgcn_permlane32_swap(__float_as_uint(v), __float_as_uint(v), false, false); return fmaxf(__uint_as_float(rr[0]), __uint_as_float(rr[1])); }
__device__ __forceinline__ unsigned cvt_pk_bf16(float lo, float hi) { unsigned r; asm volatile("v_cvt_pk_bf16_f32 %0, %1, %2" : "=v"(r) : "v"(lo), "v"(hi)); return r; }
__device__ __forceinline__ float bf_lo(unsigned w) { return __uint_as_float(w << 16); }
__device__ __forceinline__ float bf_hi(unsigned w) { return __uint_as_float(w & 0xffff0000u); }
__device__ __forceinline__ bf16x8 pack8(f32x4 a, f32x4 b) { u32x4 w = {cvt_pk_bf16(a[0], a[1]), cvt_pk_bf16(a[2], a[3]), cvt_pk_bf16(b[0], b[1]), cvt_pk_bf16(b[2], b[3])}; return __builtin_bit_cast(bf16x8, w); }

namespace pg8 {
constexpr int BM = 256, BK = 64, HALF = 128, HTB = HALF * BK * 2, STAGE_BYTES = 8 * HTB, NXCD = 8, WGM = 8;
__host__ __device__ __forceinline__ int lds_byte(int r, int c) { const int st = (r >> 4) * 2 + (c >> 5), rr = r & 15, cc = c & 31, ob = rr * 64 + cc * 2; return st * 1024 + (ob ^ (((ob >> 9) & 1) << 5)); }
__host__ __device__ __forceinline__ void stage_rc(int b, int& R, int& C) { const int st = b / 1024, sb = b % 1024, swz = sb ^ (((sb >> 9) & 1) << 5); R = (st >> 1) * 16 + swz / 64; C = (st & 1) * 32 + (swz % 64) / 2; }
__host__ __device__ __forceinline__ int perm32(int rho) { const int n = rho >> 4, i = rho & 15; return 8 * (i >> 2) + 4 * n + (i & 3); }
struct Unit { int pm, pn, kt0, nt, part; };
struct Gemm { const bf16_t* A; const bf16_t* Bt; int M, N, K, lda, adiv; };
struct SplitOrder {
    int nM, nN, nwg, G, c, R, r, s, ntK, nfull, ibeg, iend; float* part; unsigned* cnt;
    __device__ __forceinline__ void init(int M_, int N_, int K_, int G_, int c_, float* part_, unsigned* cnt_) {
        nM = M_ / BM; nN = N_ / BM; nwg = nM * nN; G = G_; c = c_; ntK = K_ / BK; part = part_; cnt = cnt_;
        r = 0; s = 1; nfull = nwg; ibeg = 0; iend = 1 << 30;
        if (G == 256 && part_ != nullptr) { const int rem = nwg % 256; if (rem != 0 && 256 % rem == 0) { const int ss = 256 / rem; if (ntK % ss == 0 && ((ntK / ss) & 1) == 0 && ntK / ss >= 4) { r = rem; s = ss; nfull = nwg - rem; } } }
    }
    __device__ __forceinline__ void map(int wgid, Unit& u) const {
        { const int q = nwg / NXCD, rr = nwg % NXCD, xcd = wgid % NXCD, off = wgid / NXCD; wgid = (xcd < rr ? xcd * (q + 1) : rr * (q + 1) + (xcd - rr) * q) + off; }
        const int nig = WGM * nN, gid = wgid / nig, fm = gid * WGM, gsz = (nM - fm) < WGM ? (nM - fm) : WGM;
        u.pm = fm + ((wgid % nig) % gsz); u.pn = (wgid % nig) / gsz;
    }
    __device__ __forceinline__ bool next(int i0, Unit& u) const {
        const int i = i0 + ibeg; int wg, kt0 = 0, nt = ntK, part = -1; bool ok;
        if (r) {
            if (i == 0) { wg = nfull + c / s; nt = ntK / s; kt0 = (c % s) * nt; part = c; ok = true; }
            else { const long L = (long)(i - 1) * G + c; ok = L < nfull; wg = ok ? (int)L : 0; }
        } else { const long L = (long)i * G + c; ok = L < nwg; wg = ok ? (int)L : 0; }
        Unit t; map(wg, t); t.kt0 = kt0; t.nt = nt; t.part = part; u = t; return ok && i < iend;
    }
};
__device__ __forceinline__ void store16_sc1(float* p, f32x4 v) { asm volatile("global_store_dwordx4 %0, %1, off sc1\n\ts_nop 1" :: "v"(p), "v"(v) : "memory"); }
template <class Epi, class Sched>
__device__ __forceinline__ void gemm_phase(LAS unsigned char* lds, const Gemm g, const Sched& S, const Epi& E, const int wid, const bool do_fix = true) {
    const int lane = fresh_lane(), tid = wid * 64 + lane, wr = wid >> 2, wc = wid & 3, fr = lane & 15, fq = lane >> 4;
    const int K = g.K;
    unsigned voffA[2], voffB[2];
#pragma unroll
    for (int i = 0; i < 2; ++i) { int R, C; stage_rc(tid * 16 + i * 8192, R, C); const int Rb = (R & ~31) + perm32(R & 31);
        voffA[i] = (unsigned)(R * g.lda + C) * 2u; voffB[i] = (unsigned)(Rb * K + C) * 2u; }
    const size_t kstep = (size_t)(BK * 2);
    const size_t hstepA = (size_t)HALF * g.lda * 2, hstepB = (size_t)HALF * K * 2;
    const size_t tstepA = 2 * hstepA, tstepB = 2 * hstepB;
    const unsigned ldsw = (unsigned)wid * 1024u;
    const int aoff = lds_byte(wr * 64 + fr, fq * 8), boff = lds_byte(wc * 32 + fr, fq * 8);
#define PG8_SA(b, h) (((b) * 2 + (h)) * HTB)
#define PG8_SB(b, h) ((4 + (b) * 2 + (h)) * HTB)
#define PG8_STAGE(bufoff, gbase, voff) do { _Pragma("unroll") for (int _i = 0; _i < 2; ++_i) \
        __builtin_amdgcn_global_load_lds((const unsigned*)((const char*)(gbase) + (voff)[_i]), (LAS unsigned*)(lds + (bufoff) + ldsw + _i * 8192), 16, 0, 0); } while (0)
#define PG8_LDA(dst, b, h) do { _Pragma("unroll") for (int m = 0; m < 4; ++m) _Pragma("unroll") for (int k = 0; k < 2; ++k) dst[m][k] = *(const LAS bf16x8*)(lds + PG8_SA(b, h) + aoff + m * 2048 + k * 1024); } while (0)
#define PG8_LDB(dst, b, h) do { _Pragma("unroll") for (int n = 0; n < 2; ++n) _Pragma("unroll") for (int k = 0; k < 2; ++k) dst[n][k] = *(const LAS bf16x8*)(lds + PG8_SB(b, h) + boff + n * 2048 + k * 1024); } while (0)
#define PG8_MMA(ai, bj, At, Bt) do { __builtin_amdgcn_s_setprio(1); _Pragma("unroll") for (int m = 0; m < 4; ++m) _Pragma("unroll") for (int n = 0; n < 2; ++n) _Pragma("unroll") for (int k = 0; k < 2; ++k) \
        acc[ai][bj][m][n] = __builtin_amdgcn_mfma_f32_16x16x32_bf16(Bt[n][k], At[m][k], acc[ai][bj][m][n], 0, 0, 0); __builtin_amdgcn_s_setprio(0); } while (0)
#define PG8_WAIT_V(n) asm volatile("s_waitcnt vmcnt(" #n ")" ::: "memory")
#define PG8_WAIT_L(n) asm volatile("s_waitcnt lgkmcnt(" #n ")" ::: "memory")
#define PG8_BAR __builtin_amdgcn_s_barrier()
#define PG8_SCHED __builtin_amdgcn_sched_barrier(0)
    Unit cur, nxt; int ui = 0;
    if (S.next(0, cur)) {
    f32x4 acc[2][2][4][2];
#pragma unroll
    for (int a = 0; a < 2; ++a)
#pragma unroll
        for (int b = 0; b < 2; ++b)
#pragma unroll
            for (int m = 0; m < 4; ++m)
#pragma unroll
                for (int n = 0; n < 2; ++n) acc[a][b][m][n] = (f32x4){0.f, 0.f, 0.f, 0.f};
    bf16x8 At[4][2], B0[2][2], B1[2][2];
    const char* cA = (const char*)g.A + (size_t)cur.pm * tstepA + (size_t)(cur.pn / g.adiv) * K * 2 + (size_t)cur.kt0 * kstep; const char* cB = (const char*)g.Bt + (size_t)cur.pn * tstepB + (size_t)cur.kt0 * kstep;
    PG8_STAGE(PG8_SB(0, 0), cB, voffB); PG8_STAGE(PG8_SB(0, 1), cB + hstepB, voffB); PG8_STAGE(PG8_SA(0, 0), cA, voffA); PG8_STAGE(PG8_SA(0, 1), cA + hstepA, voffA);
    if (wr == 1) PG8_BAR;
    PG8_WAIT_V(2); PG8_BAR;
    PG8_STAGE(PG8_SB(1, 0), cB + kstep, voffB); PG8_STAGE(PG8_SA(1, 0), cA + kstep, voffA); PG8_STAGE(PG8_SB(1, 1), cB + hstepB + kstep, voffB);
    PG8_WAIT_V(6); PG8_BAR;
    for (;;) {
        const bool has_next = S.next(ui + 1, nxt);
        const char* nA = has_next ? (const char*)g.A + (size_t)nxt.pm * tstepA + (size_t)(nxt.pn / g.adiv) * K * 2 + (size_t)nxt.kt0 * kstep : cA; const char* nB = has_next ? (const char*)g.Bt + (size_t)nxt.pn * tstepB + (size_t)nxt.kt0 * kstep : cB;
        const int nt = cur.nt;
        for (int t = 0; t < nt; t += 2) {
            const bool last = (t == nt - 2);
            const char* a1 = cA + (size_t)(t + 1) * kstep;
            const char* a2 = last ? nA : cA + (size_t)(t + 2) * kstep; const char* b2 = last ? nB : cB + (size_t)(t + 2) * kstep;
            const char* a3 = a2 + kstep; const char* b3 = b2 + kstep;
            PG8_LDB(B0, 0, 0); PG8_LDB(B1, 0, 1); PG8_SCHED; PG8_LDA(At, 0, 0); PG8_STAGE(PG8_SA(1, 1), a1 + hstepA, voffA);
            PG8_WAIT_V(8); PG8_WAIT_L(0); PG8_BAR; PG8_MMA(0, 0, At, B0); PG8_MMA(0, 1, At, B1); PG8_BAR; PG8_SCHED;
            PG8_LDA(At, 0, 1); PG8_STAGE(PG8_SB(0, 0), b2, voffB); PG8_STAGE(PG8_SB(0, 1), b2 + hstepB, voffB); PG8_STAGE(PG8_SA(0, 0), a2, voffA);
            PG8_WAIT_V(8); PG8_WAIT_L(0); PG8_BAR; PG8_MMA(1, 0, At, B0); PG8_MMA(1, 1, At, B1); PG8_BAR; PG8_SCHED;
            PG8_LDB(B0, 1, 0); PG8_LDB(B1, 1, 1); PG8_SCHED; PG8_LDA(At, 1, 0); PG8_STAGE(PG8_SA(0, 1), a2 + hstepA, voffA);
            PG8_WAIT_V(8); PG8_WAIT_L(0); PG8_BAR; PG8_MMA(0, 0, At, B0); PG8_MMA(0, 1, At, B1); PG8_BAR; PG8_SCHED;
            PG8_LDA(At, 1, 1); PG8_STAGE(PG8_SB(1, 0), b3, voffB); PG8_STAGE(PG8_SB(1, 1), b3 + hstepB, voffB); PG8_STAGE(PG8_SA(1, 0), a3, voffA);
            PG8_WAIT_V(8); PG8_WAIT_L(0); PG8_BAR; PG8_MMA(1, 0, At, B0); PG8_MMA(1, 1, At, B1); PG8_BAR; PG8_SCHED;
        }
        if (wr == 0) PG8_BAR;
        if (cur.part >= 0) {
            float* pb = S.part + (size_t)cur.part * 65536 + (size_t)(wr * 64 + fr) * 256 + wc * 32 + 8 * fq;
#pragma unroll
            for (int ai = 0; ai < 2; ++ai)
#pragma unroll
                for (int m = 0; m < 4; ++m)
#pragma unroll
                    for (int bj = 0; bj < 2; ++bj)
#pragma unroll
                        for (int n = 0; n < 2; ++n) store16_sc1(pb + (size_t)(ai * HALF + m * 16) * 256 + bj * HALF + 4 * n, acc[ai][bj][m][n]);
            asm volatile("s_waitcnt vmcnt(0)" ::: "memory");
            if (lane == 0) __hip_atomic_fetch_add(S.cnt + 64 * (cur.part / S.s), 1u, __ATOMIC_RELAXED, __HIP_MEMORY_SCOPE_AGENT);
        } else E(acc, cur, wr, wc, fr, fq);
        if (!has_next) break;
#pragma unroll
        for (int a = 0; a < 2; ++a)
#pragma unroll
            for (int b = 0; b < 2; ++b)
#pragma unroll
                for (int m = 0; m < 4; ++m)
#pragma unroll
                    for (int n = 0; n < 2; ++n) acc[a][b][m][n] = (f32x4){0.f, 0.f, 0.f, 0.f};
        cur = nxt; cA = nA; cB = nB; ++ui;
        if (wr == 1) PG8_BAR;
    }
    PG8_WAIT_V(0);
    PG8_BAR;
    }
    if (S.r && do_fix) {
        const int su = S.c / S.s, j = S.c % S.s, rows = BM / S.s; Unit fu; S.map(S.nfull + su, fu);
        if (wid == 0) { unsigned* cw = S.cnt + 64 * su; unsigned sp = 0;
            while ((unsigned)__builtin_amdgcn_readfirstlane(__hip_atomic_load(cw, __ATOMIC_RELAXED, __HIP_MEMORY_SCOPE_AGENT)) < 8u * (unsigned)S.s) { __builtin_amdgcn_s_sleep(2); if (++sp > (1u << 22)) break; }
            __builtin_amdgcn_fence(__ATOMIC_ACQUIRE, "agent"); asm volatile("s_waitcnt vmcnt(0)" ::: "memory"); }
        __syncthreads();
        const float* pbase = S.part + (size_t)(su * S.s) * 65536;
        for (int rr = wid; rr < rows; rr += 8) { const int row = j * rows + rr; f32x4 v = {0.f, 0.f, 0.f, 0.f};
            for (int q = 0; q < S.s; ++q) v += *(const f32x4*)(pbase + (size_t)q * 65536 + row * 256 + lane * 4);
            E.fix(v, fu.pm * BM + row, fu.pn * BM + lane * 4, lane); }
    }
#undef PG8_SA
#undef PG8_SB
#undef PG8_STAGE
#undef PG8_LDA
#undef PG8_LDB
#undef PG8_MMA
#undef PG8_WAIT_V
#undef PG8_WAIT_L
#undef PG8_BAR
#undef PG8_SCHED
}

struct EpiProj {
    bf16_t* O;
    __device__ __forceinline__ void fix(f32x4 v, int row, int col, int) const { u32x2 w; w.x = cvt_pk_bf16(v[0], v[1]); w.y = cvt_pk_bf16(v[2], v[3]); *(u32x2*)(O + (size_t)row * PP + col) = w; }
    __device__ __forceinline__ void operator()(const f32x4 (&acc)[2][2][4][2], const Unit& u, int wr, int wc, int fr, int fq) const {
        const int row0 = u.pm * BM + wr * 64 + fr;
        const int col0 = u.pn * BM + wc * 32 + 8 * fq;
#pragma unroll
        for (int ai = 0; ai < 2; ++ai)
#pragma unroll
            for (int m = 0; m < 4; ++m) { bf16_t* rowp = O + (size_t)(row0 + ai * HALF + m * 16) * PP + col0;
#pragma unroll
                for (int bj = 0; bj < 2; ++bj) { const f32x4 v0 = acc[ai][bj][m][0], v1 = acc[ai][bj][m][1];
                    u32x4 w; w.x = cvt_pk_bf16(v0[0], v0[1]); w.y = cvt_pk_bf16(v0[2], v0[3]); w.z = cvt_pk_bf16(v1[0], v1[1]); w.w = cvt_pk_bf16(v1[2], v1[3]);
                    *(u32x4*)(rowp + bj * HALF) = w; } }
    }
};
struct EpiPool {
    bf16_t* O; const float* scale;
    __device__ __forceinline__ void fix(f32x4, int, int, int) const {}
    __device__ __forceinline__ void operator()(const f32x4 (&acc)[2][2][4][2], const Unit& u, int wr, int wc, int fr, int fq) const {
        const int row0 = u.pm * BM + wr * 64 + fr, col0 = u.pn * BM + wc * 32 + 8 * fq;
        f32x4 sv[2][2];
#pragma unroll
        for (int bj = 0; bj < 2; ++bj)
#pragma unroll
            for (int n = 0; n < 2; ++n) sv[bj][n] = *(const f32x4*)(scale + col0 + bj * HALF + 4 * n);
#pragma unroll
        for (int ai = 0; ai < 2; ++ai)
#pragma unroll
            for (int m = 0; m < 4; ++m) { bf16_t* rowp = O + (size_t)(row0 + ai * HALF + m * 16) * DM + col0;
#pragma unroll
                for (int bj = 0; bj < 2; ++bj) { const f32x4 v0 = acc[ai][bj][m][0] * sv[bj][0], v1 = acc[ai][bj][m][1] * sv[bj][1];
                    u32x4 w; w.x = cvt_pk_bf16(v0[0], v0[1]); w.y = cvt_pk_bf16(v0[2], v0[3]); w.z = cvt_pk_bf16(v1[0], v1[1]); w.w = cvt_pk_bf16(v1[2], v1[3]);
                    *(u32x4*)(rowp + bj * HALF) = w; } }
    }
};
struct EpiOut {
    const float* xp; const float* xs; float* Y; bf16_t* X1G; const float* g2; float* rowss;
    __device__ __forceinline__ void fix(f32x4 v, int row, int col, int lane) const {
        const float* xin = (row < MP) ? xp + (size_t)row * DM : xs + (size_t)(row - MP) * DM;
        const f32x4 x1 = *(const f32x4*)(xin + col) + v; *(f32x4*)(Y + (size_t)row * DM + col) = x1;
        const f32x4 w = x1 * *(const f32x4*)(g2 + col); u32x2 o; o.x = cvt_pk_bf16(w[0], w[1]); o.y = cvt_pk_bf16(w[2], w[3]); *(u32x2*)(X1G + (size_t)row * DM + col) = o;
        float ss = (x1[0] * x1[0] + x1[1] * x1[1]) + (x1[2] * x1[2] + x1[3] * x1[3]);
        ss += swz_xor<1>(ss); ss += swz_xor<2>(ss); ss += swz_xor<4>(ss); ss += swz_xor<8>(ss); ss += swz_xor<16>(ss); ss = half_sum(ss);
        if (lane == 0) __hip_atomic_fetch_add(rowss + row, ss, __ATOMIC_RELAXED, __HIP_MEMORY_SCOPE_AGENT);
    }
    __device__ __forceinline__ void operator()(const f32x4 (&acc)[2][2][4][2], const Unit& u, int wr, int wc, int fr, int fq) const {
        const int row0 = u.pm * BM + wr * 64 + fr, col0 = u.pn * BM + wc * 32 + 8 * fq;
        const float* xin = (u.pm < MP / BM) ? xp : xs - (size_t)MP * DM;
        f32x4 gv[2][2];
#pragma unroll
        for (int bj = 0; bj < 2; ++bj)
#pragma unroll
            for (int n = 0; n < 2; ++n) gv[bj][n] = *(const f32x4*)(g2 + col0 + bj * HALF + 4 * n);
#pragma unroll
        for (int ai = 0; ai < 2; ++ai) {
            f32x4 xv[4][2][2];
#pragma unroll
            for (int m = 0; m < 4; ++m)
#pragma unroll
                for (int bj = 0; bj < 2; ++bj)
#pragma unroll
                    for (int n = 0; n < 2; ++n) xv[m][bj][n] = *(const f32x4*)(xin + (size_t)(row0 + ai * HALF + m * 16) * DM + col0 + bj * HALF + 4 * n);
#pragma unroll
            for (int m = 0; m < 4; ++m) { const int row = row0 + ai * HALF + m * 16; const size_t off = (size_t)row * DM + col0; float ss = 0.f;
#pragma unroll
                for (int bj = 0; bj < 2; ++bj) {
                    const f32x4 v0 = xv[m][bj][0] + acc[ai][bj][m][0], v1 = xv[m][bj][1] + acc[ai][bj][m][1];
                    *(f32x4*)(Y + off + bj * HALF) = v0; *(f32x4*)(Y + off + bj * HALF + 4) = v1;
                    ss += (v0[0] * v0[0] + v0[1] * v0[1]) + (v0[2] * v0[2] + v0[3] * v0[3]) + (v1[0] * v1[0] + v1[1] * v1[1]) + (v1[2] * v1[2] + v1[3] * v1[3]);
                    const f32x4 w0 = v0 * gv[bj][0], w1 = v1 * gv[bj][1];
                    u32x4 w; w.x = cvt_pk_bf16(w0[0], w0[1]); w.y = cvt_pk_bf16(w0[2], w0[3]); w.z = cvt_pk_bf16(w1[0], w1[1]); w.w = cvt_pk_bf16(w1[2], w1[3]);
                    *(u32x4*)(X1G + off + bj * HALF) = w; }
                ss += swz_xor<16>(ss); ss = half_sum(ss);
                if (fq == 0) __hip_atomic_fetch_add(rowss + row, ss, __ATOMIC_RELAXED, __HIP_MEMORY_SCOPE_AGENT); }
            asm volatile("" ::: "memory"); }
    }
};
struct EpiUp {
    bf16_t* O; const float* rowss;
    __device__ __forceinline__ void fix(f32x4 v, int row, int col, int) const {
        const float rs = __builtin_amdgcn_rsqf(rowss[row] * (1.0f / DM) + EPS); v = v * rs;
#pragma unroll
        for (int j = 0; j < 4; ++j) v[j] = fmaxf(v[j], 0.f);
        v = v * v; u32x2 o; o.x = cvt_pk_bf16(v[0], v[1]); o.y = cvt_pk_bf16(v[2], v[3]); *(u32x2*)(O + (size_t)row * DFF + col) = o;
    }
    __device__ __forceinline__ void operator()(const f32x4 (&acc)[2][2][4][2], const Unit& u, int wr, int wc, int fr, int fq) const {
        const int row0 = u.pm * BM + wr * 64 + fr, col0 = u.pn * BM + wc * 32 + 8 * fq;
#pragma unroll
        for (int ai = 0; ai < 2; ++ai)
#pragma unroll
            for (int m = 0; m < 4; ++m) { const int row = row0 + ai * HALF + m * 16; bf16_t* rowp = O + (size_t)row * DFF + col0;
                const float rs = __builtin_amdgcn_rsqf(rowss[row] * (1.0f / DM) + EPS);
#pragma unroll
                for (int bj = 0; bj < 2; ++bj) { f32x4 v0 = acc[ai][bj][m][0] * rs, v1 = acc[ai][bj][m][1] * rs;
#pragma unroll
                    for (int j = 0; j < 4; ++j) { v0[j] = fmaxf(v0[j], 0.f); v1[j] = fmaxf(v1[j], 0.f); }
                    v0 = v0 * v0; v1 = v1 * v1;
                    u32x4 w; w.x = cvt_pk_bf16(v0[0], v0[1]); w.y = cvt_pk_bf16(v0[2], v0[3]); w.z = cvt_pk_bf16(v1[0], v1[1]); w.w = cvt_pk_bf16(v1[2], v1[3]);
                    *(u32x4*)(rowp + bj * HALF) = w; } }
    }
};
struct EpiDown {
    float* Y;
    __device__ __forceinline__ void fix(f32x4 v, int row, int col, int) const { float* p = Y + (size_t)row * DM + col; *(f32x4*)p = *(const f32x4*)p + v; }
    __device__ __forceinline__ void operator()(const f32x4 (&acc)[2][2][4][2], const Unit& u, int wr, int wc, int fr, int fq) const {
        const int row0 = u.pm * BM + wr * 64 + fr, col0 = u.pn * BM + wc * 32 + 8 * fq;
#pragma unroll
        for (int ai = 0; ai < 2; ++ai) {
            f32x4 yv[4][2][2];
#pragma unroll
            for (int m = 0; m < 4; ++m)
#pragma unroll
                for (int bj = 0; bj < 2; ++bj)
#pragma unroll
                    for (int n = 0; n < 2; ++n) yv[m][bj][n] = *(const f32x4*)(Y + (size_t)(row0 + ai * HALF + m * 16) * DM + col0 + bj * HALF + 4 * n);
#pragma unroll
            for (int m = 0; m < 4; ++m)
#pragma unroll
                for (int bj = 0; bj < 2; ++bj)
#pragma unroll
                    for (int n = 0; n < 2; ++n) *(f32x4*)(Y + (size_t)(row0 + ai * HALF + m * 16) * DM + col0 + bj * HALF + 4 * n) = yv[m][bj][n] + acc[ai][bj][m][n];
            asm volatile("" ::: "memory"); }
    }
};
}

namespace att {
constexpr int D = 128, NW = 8, QBLK = 32, KVBLK = 64, QB = NW * QBLK;
constexpr int SHM_V = KVBLK * D * 2, SHM_K = KVBLK * D * 2;
constexpr int OFF_K = 2 * SHM_V, OFF_WS = 2 * SHM_V + 2 * SHM_K, OFF_CB = OFF_WS + NW * 64 * 4, LDS_NEED = OFF_CB + 8192 * 4;
constexpr int PO = DM;
constexpr float THR2 = 8.f * LOG2E;
typedef LAS char* lptr;
#define KSWZ(row, colB) ((row) * 256 + ((colB) ^ (((row) & 7) << 4)))
#define SBAR() __builtin_amdgcn_sched_barrier(0)
__device__ __forceinline__ int v_st(int k, int c) { const int kk = (k & ~0xC) | ((k & 4) << 1) | ((k & 8) >> 1); return ((kk >> 3) * 4 + (c >> 5)) * 512 + ((kk & 7) * 32 + (c & 31)) * 2; }
__device__ __forceinline__ int v_rd_base(int lane) { return ((lane & 3) << 3) | (((lane >> 2) & 3) << 6) | (((lane >> 4) & 1) << 5) | (((lane >> 5) & 1) << 8); }
constexpr int v_rd_off(int d0, int ks, int half) { return d0 * 512 + ks * 4096 + half * 2048; }
__device__ __forceinline__ int crow(int r, int hi) { return (r & 3) + 8 * (r >> 2) + 4 * hi; }
__device__ __forceinline__ bf16x8 load8(const bf16_t* p) { return *reinterpret_cast<const bf16x8*>(p); }
__device__ __forceinline__ void mask_tile(f32x16& p0, f32x16& p1, int dq) {
    const float NEG = -__builtin_inff();
#pragma unroll
    for (int r = 0; r < 16; ++r) { const int c = (r & 3) + 8 * (r >> 2);
        if (dq - c < 0) p0[r] = NEG;
        if (dq - c - 32 < 0) p1[r] = NEG; }
}
__device__ __forceinline__ void partialSM(f32x16& p0, f32x16& p1, float& m_reg, float& mn, float& alpha) {
    float pmax = p0[0];
#pragma unroll
    for (int r = 1; r < 16; ++r) pmax = fmaxf(pmax, p0[r]);
#pragma unroll
    for (int r = 0; r < 16; ++r) pmax = fmaxf(pmax, p1[r]);
    { auto rr = __builtin_amdgcn_permlane32_swap(__float_as_uint(pmax), __float_as_uint(pmax), false, false);
      pmax = fmaxf(__uint_as_float(rr[0]), __uint_as_float(rr[1])); }
    if (__builtin_expect(__all((pmax - m_reg) <= THR2), 1)) { mn = m_reg; alpha = 1.f; }
    else { mn = fmaxf(m_reg, pmax); alpha = __builtin_amdgcn_exp2f(m_reg - mn); m_reg = mn; }
#pragma unroll
    for (int r = 0; r < 16; ++r) p0[r] = p0[r] - mn;
#pragma unroll
    for (int r = 0; r < 16; ++r) p1[r] = p1[r] - mn;
#pragma unroll
    for (int r = 0; r < 16; ++r) p0[r] = __builtin_amdgcn_exp2f(p0[r]);
}
__device__ __forceinline__ void finishSM(f32x16& p0, f32x16& p1, float alpha, float& l_reg, bf16x8& pa0, bf16x8& pa1, bf16x8& pa2, bf16x8& pa3) {
#pragma unroll
    for (int r = 0; r < 16; ++r) p1[r] = __builtin_amdgcn_exp2f(p1[r]);
    float ps = 0;
#pragma unroll
    for (int r = 0; r < 16; ++r) ps += p0[r];
#pragma unroll
    for (int r = 0; r < 16; ++r) ps += p1[r];
    { auto rr = __builtin_amdgcn_permlane32_swap(__float_as_uint(ps), __float_as_uint(ps), false, false);
      ps = __uint_as_float(rr[0]) + __uint_as_float(rr[1]); }
    l_reg = l_reg * alpha + ps;
#define PK4(P, B_, OUT) do { unsigned a0 = cvt_pk_bf16(P[B_+0], P[B_+1]), a1 = cvt_pk_bf16(P[B_+2], P[B_+3]);                          \
        unsigned b0 = cvt_pk_bf16(P[B_+4], P[B_+5]), b1 = cvt_pk_bf16(P[B_+6], P[B_+7]);                                             \
        auto r0 = __builtin_amdgcn_permlane32_swap(a0, b0, false, false); auto r1 = __builtin_amdgcn_permlane32_swap(a1, b1, false, false); \
        u32x4 w = {r0[0], r1[0], r0[1], r1[1]}; OUT = __builtin_bit_cast(bf16x8, w); } while (0)
    PK4(p0, 0, pa0); PK4(p0, 8, pa1); PK4(p1, 0, pa2); PK4(p1, 8, pa3);
}
template <int KB>
__device__ __forceinline__ void qkt(f32x16& p0, f32x16& p1, lptr K_lds, const LAS float* cbt, int r32, int hi, const bf16x8* qr) {
#pragma unroll
    for (int i = 0; i < 4; ++i) { const f32x4 b0 = *(const LAS f32x4*)(cbt + 8 * i), b1 = *(const LAS f32x4*)(cbt + 32 + 8 * i);
        p0[4 * i] = b0[0]; p0[4 * i + 1] = b0[1]; p0[4 * i + 2] = b0[2]; p0[4 * i + 3] = b0[3];
        p1[4 * i] = b1[0]; p1[4 * i + 1] = b1[1]; p1[4 * i + 2] = b1[2]; p1[4 * i + 3] = b1[3]; }
    lptr kb[4];
#pragma unroll
    for (int dd = 0; dd < 4; ++dd) kb[dd] = K_lds + KB * SHM_K + KSWZ(r32, (dd * 16 + hi * 8) * 2);
#pragma unroll
    for (int d0 = 0; d0 < 8; ++d0) { lptr a = kb[d0 & 3] + (d0 >> 2) * 128;
        bf16x8 b0 = *reinterpret_cast<const LAS bf16x8*>(a);
        bf16x8 b1 = *reinterpret_cast<const LAS bf16x8*>(a + 32 * 256);
        p0 = __builtin_amdgcn_mfma_f32_32x32x16_bf16(b0, qr[d0], p0, 0, 0, 0);
        p1 = __builtin_amdgcn_mfma_f32_32x32x16_bf16(b1, qr[d0], p1, 0, 0, 0); }
}
template <int VB>
__device__ __forceinline__ void pv_tile(f32x16* o, int vb0, bf16x8 pa0, bf16x8 pa1, bf16x8 pa2, bf16x8 pa3) {
#define TRRD(dst, off) asm volatile("ds_read_b64_tr_b16 %0, %1 offset:%2" : "=&v"(dst) : "v"(vb0), "i"(off) : "memory")
#define PV_D0(d0) do { s16x4 l0, l1, l2, l3, h0, h1, h2, h3; constexpr int b_ = VB * SHM_V + v_rd_off(d0, 0, 0);   \
        TRRD(l0, b_); TRRD(h0, b_ + 2048); TRRD(l1, b_ + 4096); TRRD(h1, b_ + 6144); TRRD(l2, b_ + 8192); TRRD(h2, b_ + 10240); TRRD(l3, b_ + 12288); TRRD(h3, b_ + 14336); \
        asm volatile("s_waitcnt lgkmcnt(0)" ::: "memory"); SBAR();   \
        o[d0] = __builtin_amdgcn_mfma_f32_32x32x16_bf16(pa0, (bf16x8){l0[0], l0[1], l0[2], l0[3], h0[0], h0[1], h0[2], h0[3]}, o[d0], 0, 0, 0);   \
        o[d0] = __builtin_amdgcn_mfma_f32_32x32x16_bf16(pa1, (bf16x8){l1[0], l1[1], l1[2], l1[3], h1[0], h1[1], h1[2], h1[3]}, o[d0], 0, 0, 0);   \
        o[d0] = __builtin_amdgcn_mfma_f32_32x32x16_bf16(pa2, (bf16x8){l2[0], l2[1], l2[2], l2[3], h2[0], h2[1], h2[2], h2[3]}, o[d0], 0, 0, 0);   \
        o[d0] = __builtin_amdgcn_mfma_f32_32x32x16_bf16(pa3, (bf16x8){l3[0], l3[1], l3[2], l3[3], h3[0], h3[1], h3[2], h3[3]}, o[d0], 0, 0, 0); } while (0)
    PV_D0(0); PV_D0(1); PV_D0(2); PV_D0(3);
#undef PV_D0
#undef TRRD
}
struct Blk { int h, qb, jlo; };
struct Seam { bf16x8 qr[8]; bf16x8 st_v0, st_v1, st_k0, st_k1; };
#define VMW() asm volatile("s_waitcnt vmcnt(0)" ::: "memory")
#define VMWN(n) asm volatile("s_waitcnt vmcnt(%0)" :: "i"(n) : "memory")
#define SLOAD_H(hh, k0) do { const bf16_t* kt_ = PROJ + (size_t)(k0) * PP + (PW + AW) + (hh) * HD;                                         \
                         S.st_v0 = load8(kt_ + AW + toff); S.st_v1 = load8(kt_ + AW + 32 * PP + toff);                                      \
                         S.st_k0 = load8(kt_ + toff); S.st_k1 = load8(kt_ + 32 * PP + toff); } while (0)
#define QLOAD(hh, qq) do { const bf16_t* qt_ = PROJ + (size_t)((qq) * QB + wid * QBLK) * PP + PW + (hh) * HD;                                \
                         _Pragma("unroll") for (int d0 = 0; d0 < 8; ++d0) S.qr[d0] = load8(qt_ + qoff + d0 * 16); } while (0)
#define SWRITE_HK(bf) do { *(LAS bf16x8*)(K_lds + (bf) * SHM_K + kws) = S.st_k0; *(LAS bf16x8*)(K_lds + (bf) * SHM_K + kws + 32 * 256) = S.st_k1; } while (0)
#define SWRITE_HV(bf) do { *(LAS bf16x8*)(V_lds + (bf) * SHM_V + vst0) = S.st_v0; *(LAS bf16x8*)(V_lds + (bf) * SHM_V + vst1) = S.st_v1; } while (0)
#define SWRITE_H(bf) do { SWRITE_HV(bf); SWRITE_HK(bf); } while (0)
__device__ __forceinline__ void attn_prime(const Blk cur, const bf16_t* PROJ, lptr lds, Seam& S, const int wid) {
    const int lane = fresh_lane(), tid = wid * 64 + lane, r32 = lane & 31, hi = lane >> 5;
    const int sr = tid >> 4, sc = (tid & 15) * 8, kws = KSWZ(sr, sc * 2); lptr K_lds = lds + OFF_K;
    const unsigned toff = (unsigned)(sr * PP + sc), qoff = (unsigned)(r32 * PP + hi * 8);
    QLOAD(cur.h, cur.qb);
    SLOAD_H(cur.h, cur.jlo * KVBLK); VMW(); SWRITE_HK(0);
    __syncthreads();
}
__device__ __forceinline__ void attn_block(const Blk cur, const Blk nxt, const bf16_t* PROJ, bf16_t* MIX, const float* CB, lptr lds, Seam& S, const int wid) {
    const int lane = fresh_lane(), tid = wid * 64 + lane, r32 = lane & 31, hi = lane >> 5;
    const int P0 = cur.qb * QB, j_lo = cur.jlo, j_hi = (P0 + QB - 1) / KVBLK + 1;
    const int NT = j_hi - j_lo;
    const int qlo = P0 + wid * QBLK, qm = qlo + r32 - 4 * hi;
    lptr V_lds = lds; lptr K_lds = lds + OFF_K;
    LAS float* ws = (LAS float*)(lds + OFF_WS) + wid * 64; LAS float* li_l = ws; LAS float* al_l = ws + 32;
    LAS float* cb = (LAS float*)(lds + OFF_CB);
    float m_reg = -1e30f, l_reg = 0; f32x16 o[4] = {};
    const int sr = tid >> 4, sc = (tid & 15) * 8, vst0 = v_st(sr, sc), vst1 = v_st(32 + sr, sc), kws = KSWZ(sr, sc * 2);
    const unsigned toff = (unsigned)(sr * PP + sc);
    const int vb0 = (int)(unsigned)(size_t)V_lds + v_rd_base(lane);
    const int hh = cur.h;
    { const float* c2 = CB + (size_t)hh * SEQ; const float cref = c2[P0]; const float* csrc = c2 + j_lo * KVBLK;
      for (int i = tid * 4; i < NT * KVBLK; i += 2048) { const f32x4 c = *(const f32x4*)(csrc + i); *(LAS f32x4*)(cb + i) = cref - c; }
      __syncthreads(); }
    const LAS float* cbl = cb + 4 * hi;
#define RESC(a) do { if (__any((a) < 1.f)) { if (hi == 0) al_l[r32] = (a); asm volatile("s_waitcnt lgkmcnt(0)" ::: "memory");              \
                     _Pragma("unroll") for (int d_ = 0; d_ < 4; ++d_) _Pragma("unroll") for (int r = 0; r < 16; ++r) o[d_][r] *= al_l[crow(r, hi)]; } } while (0)
#define KBASE(t) ((j_lo + (t)) * KVBLK)
#define MASKT(P0_, P1_, t) do { const int kb_ = KBASE(t); if (kb_ + KVBLK - 1 > qlo) mask_tile(P0_, P1_, qm - kb_); } while (0)
#define SEAM_K0() do { VMWN(8); SWRITE_HK(0); SBAR(); } while (0)
    f32x16 pA0, pA1, pB0, pB1; float mnA, mnB, alA, alB; bf16x8 pa0, pa1, pa2, pa3;
    SWRITE_HV(0); SBAR();
    if (NT > 1) { SLOAD_H(hh, KBASE(1)); }
    SBAR(); qkt<0>(pA0, pA1, K_lds, cbl, r32, hi, S.qr);
    MASKT(pA0, pA1, 0); partialSM(pA0, pA1, m_reg, mnA, alA);
    if (NT > 1) { VMW(); SWRITE_H(1); }
    __syncthreads();
#define HALF_STEP(PX0, PX1, mnX, alX, PY0, PY1, alY, t, KB, VB, SB) do {                                                      \
        SBAR(); qkt<KB>(PX0, PX1, K_lds, cbl + (t) * KVBLK, r32, hi, S.qr);                                                   \
        finishSM(PY0, PY1, alY, l_reg, pa0, pa1, pa2, pa3); SBAR();                                                           \
        if ((t) + 1 < NT) { SLOAD_H(hh, KBASE((t) + 1)); SBAR(); }                                                            \
        pv_tile<VB>(o, vb0, pa0, pa1, pa2, pa3); MASKT(PX0, PX1, (t)); partialSM(PX0, PX1, m_reg, mnX, alX);                   \
        __syncthreads();                                                                                                      \
        if ((t) + 1 < NT) { VMW(); SWRITE_H(SB); }                                                                            \
        RESC(alX); __syncthreads(); } while (0)
    for (int t = 1; t + 1 < NT; t += 2) {
        HALF_STEP(pB0, pB1, mnB, alB, pA0, pA1, alA, t, 1, 0, 0);
        HALF_STEP(pA0, pA1, mnA, alA, pB0, pB1, alB, t + 1, 0, 1, 1);
    }
    const bool even = (NT & 1) == 0;
    const int l2_ = fresh_lane(), r32b_ = l2_ & 31, hib_ = l2_ >> 5, qmb_ = qlo + r32b_ - 4 * hib_;
    { const int r32 = r32b_, hi = hib_, qm = qmb_;
    if (even) { SBAR(); qkt<1>(pB0, pB1, K_lds, cbl + (NT - 1) * KVBLK, r32, hi, S.qr); SBAR(); }
    SLOAD_H(nxt.h, nxt.jlo * KVBLK); SBAR();
    { const unsigned qoff = (unsigned)(r32 * PP + hi * 8); QLOAD(nxt.h, nxt.qb); }
    SBAR();
    finishSM(pA0, pA1, alA, l_reg, pa0, pa1, pa2, pa3); SBAR();
    pv_tile<0>(o, vb0, pa0, pa1, pa2, pa3);
    if (even) { MASKT(pB0, pB1, NT - 1); partialSM(pB0, pB1, m_reg, mnB, alB); __syncthreads(); RESC(alB);
        finishSM(pB0, pB1, alB, l_reg, pa0, pa1, pa2, pa3); SBAR(); pv_tile<1>(o, vb0, pa0, pa1, pa2, pa3); }
    SBAR(); SEAM_K0();
    if (hi == 0) li_l[r32] = l_reg; asm volatile("s_waitcnt lgkmcnt(0)" ::: "memory");
    bf16_t* Ow = MIX + (size_t)(P0 + wid * QBLK) * PO + PW + hh * HD;
    const unsigned ooff = (unsigned)(4 * hi * PO + r32);
#pragma unroll
    for (int r = 0; r < 16; ++r) { const float rl = __builtin_amdgcn_rcpf(li_l[crow(r, hi)]);
#pragma unroll
        for (int d0 = 0; d0 < 4; ++d0) { const float v = o[d0][r] * rl;
            const float vn = swz_xor<1>(v);
            if ((r32 & 1) == 0) *(unsigned*)(Ow + ooff + (unsigned)(((r & 3) + 8 * (r >> 2)) * PO + d0 * 32)) = cvt_pk_bf16(v, vn); } }
    }
    __syncthreads();
#undef RESC
#undef KBASE
#undef MASKT
#undef SEAM_K0
#undef HALF_STEP
}
#undef QLOAD
#undef SLOAD_H
#undef SWRITE_HK
#undef SWRITE_HV
#undef SWRITE_H

constexpr int SOFF_ML = 0, SOFF_Q = 2048, SOFF_KST = 10240, KST_BYTES = 16 * 1040, SOFF_OT = SOFF_KST  , SLDS_NEED = SOFF_KST + 8 * KST_BYTES;
static_assert(SLDS_NEED <= MISC_OFF && SOFF_OT + 8 * 64 * 32 * 4 <= MISC_OFF, "sample attention LDS map");
template <bool NEWK>
__device__ __forceinline__ void samp_chunk(const float* Kc, const float* Vc, const bf16_t* Kn, const bf16_t* Vn, const float* bias, const LAS char* qlds, LAS char* kst, int lane,
                                           float& m_reg, float& l_reg, f32x16* oT, int r32, int hi) {
    f32x4 kr[16]; float vr[2][4][8]; bf16x8 kf[8]; short vn[2][4][8];
    if constexpr (NEWK) {
#pragma unroll
        for (int d0 = 0; d0 < 8; ++d0) kf[d0] = load8(Kn + (size_t)r32 * PP + d0 * 16 + hi * 8);
#pragma unroll
        for (int ks = 0; ks < 2; ++ks)
#pragma unroll
            for (int d0 = 0; d0 < 4; ++d0)
#pragma unroll
                for (int j = 0; j < 8; ++j) vn[ks][d0][j] = (short)Vn[(size_t)(16 * ks + 8 * hi + j) * PP + 32 * d0 + r32];
    } else {
        const float* kp = Kc + (size_t)(lane >> 5) * (NH * HD) + 4 * (lane & 31);
#pragma unroll
        for (int i = 0; i < 16; ++i) kr[i] = __builtin_nontemporal_load((const f32x4*)(kp + (size_t)(2 * i) * (NH * HD)));
        const float* vp = Vc + (size_t)(8 * hi) * (NH * HD) + r32;
#pragma unroll
        for (int ks = 0; ks < 2; ++ks)
#pragma unroll
            for (int d0 = 0; d0 < 4; ++d0)
#pragma unroll
                for (int j = 0; j < 8; ++j) vr[ks][d0][j] = __builtin_nontemporal_load(vp + (size_t)(16 * ks + j) * (NH * HD) + 32 * d0);
    }
    asm volatile("" ::: "memory");
    f32x16 s;
#pragma unroll
    for (int i = 0; i < 4; ++i) { const f32x4 b = *(const f32x4*)(bias + 8 * i + 4 * hi); s[4 * i] = b[0]; s[4 * i + 1] = b[1]; s[4 * i + 2] = b[2]; s[4 * i + 3] = b[3]; }
    if constexpr (!NEWK) {
#pragma unroll
        for (int i = 0; i < 16; ++i) *(LAS f32x4*)(kst + i * 1040 + lane * 16) = kr[i];
        const LAS char* kf_src = kst + (r32 >> 1) * 1040 + (r32 & 1) * 512 + hi * 32;
#pragma unroll
        for (int d0 = 0; d0 < 8; ++d0) kf[d0] = pack8(*(const LAS f32x4*)(kf_src + d0 * 64), *(const LAS f32x4*)(kf_src + d0 * 64 + 16));
    }
#pragma unroll
    for (int d0 = 0; d0 < 8; ++d0) s = __builtin_amdgcn_mfma_f32_32x32x16_bf16(kf[d0], *(const LAS bf16x8*)(qlds + d0 * 1024), s, 0, 0, 0);
    if constexpr (NEWK) {
        const float NEG = -__builtin_inff();
#pragma unroll
        for (int r = 0; r < 16; ++r) if (crow(r, hi) > r32) s[r] = NEG;
    }
    float pmax = s[0];
#pragma unroll
    for (int r = 1; r < 16; ++r) pmax = fmaxf(pmax, s[r]);
    { auto rr = __builtin_amdgcn_permlane32_swap(__float_as_uint(pmax), __float_as_uint(pmax), false, false); pmax = fmaxf(__uint_as_float(rr[0]), __uint_as_float(rr[1])); }
    const float mn = fmaxf(m_reg, pmax), alpha = __builtin_amdgcn_exp2f(m_reg - mn); m_reg = mn;
    float ps = 0.f;
#pragma unroll
    for (int r = 0; r < 16; ++r) { s[r] = __builtin_amdgcn_exp2f(s[r] - mn); ps += s[r]; }
    { auto rr = __builtin_amdgcn_permlane32_swap(__float_as_uint(ps), __float_as_uint(ps), false, false); ps = __uint_as_float(rr[0]) + __uint_as_float(rr[1]); }
    l_reg = l_reg * alpha + ps;
    if (__any(alpha < 1.f)) {
#pragma unroll
        for (int d0 = 0; d0 < 4; ++d0) oT[d0] = oT[d0] * alpha;
    }
    bf16x8 pa0, pa1; PK4(s, 0, pa0); PK4(s, 8, pa1);
#pragma unroll
    for (int ks = 0; ks < 2; ++ks) {
#pragma unroll
        for (int d0 = 0; d0 < 4; ++d0) {
            bf16x8 vf;
            if constexpr (NEWK) { const short* e = vn[ks][d0]; vf = (bf16x8){e[0], e[1], e[2], e[3], e[4], e[5], e[6], e[7]}; }
            else { const float* e = vr[ks][d0]; vf = pack8((f32x4){e[0], e[1], e[2], e[3]}, (f32x4){e[4], e[5], e[6], e[7]}); }
            oT[d0] = __builtin_amdgcn_mfma_f32_32x32x16_bf16(vf, ks == 0 ? pa0 : pa1, oT[d0], 0, 0, 0);
        }
    }
}
#undef PK4
__device__ __forceinline__ void samp_unit(int b, int h, const bf16_t* PROJ, const float* cache_k, const float* cache_v, const float* CS, bf16_t* MIX, lptr lds, const int wid) {
    const int lane = fresh_lane(), tid = wid * 64 + lane, r32 = lane & 31, hi = lane >> 5;
    const bf16_t* Qp = PROJ + (size_t)(MP + b * DS) * PP + PW + h * HD;
    const bf16_t* Kn = PROJ + (size_t)(MP + b * DS) * PP + PW + AW + h * HD;
    const bf16_t* Vn = PROJ + (size_t)(MP + b * DS) * PP + PW + 2 * AW + h * HD;
    const float* bias = CS + (size_t)(b * NH + h) * 2080;
    { const bf16x8 q = load8(Qp + (size_t)r32 * PP + wid * 16 + hi * 8); *(LAS bf16x8*)(lds + SOFF_Q + wid * 1024 + lane * 16) = q; }
    asm volatile("s_waitcnt lgkmcnt(0)" ::: "memory"); __syncthreads();
    const LAS char* qlds = lds + SOFF_Q + lane * 16; LAS char* kst = lds + SOFF_KST + wid * KST_BYTES;
    float m_reg = -1e30f, l_reg = 0.f; f32x16 oT[4] = {};
    const float* Kc = cache_k + ((size_t)(b * PAST + wid * 256) * NH + h) * HD;
    const float* Vc = cache_v + ((size_t)(b * PAST + wid * 256) * NH + h) * HD;
#pragma unroll 1
    for (int c = 0; c < 8; ++c)
        samp_chunk<false>(Kc + (size_t)c * 32 * NH * HD, Vc + (size_t)c * 32 * NH * HD, nullptr, nullptr, bias + wid * 256 + c * 32, qlds, kst, lane, m_reg, l_reg, oT, r32, hi);
    if (wid == 7) samp_chunk<true>(nullptr, nullptr, Kn, Vn, bias + PAST, qlds, kst, lane, m_reg, l_reg, oT, r32, hi);
    LAS float* ML = (LAS float*)(lds + SOFF_ML); LAS float* OT = (LAS float*)(lds + SOFF_OT);
    if (hi == 0) { ML[(wid * 32 + r32) * 2] = m_reg; ML[(wid * 32 + r32) * 2 + 1] = l_reg; }
    __syncthreads();
    float Mx = -1e30f;
#pragma unroll
    for (int w = 0; w < 8; ++w) Mx = fmaxf(Mx, ML[(w * 32 + r32) * 2]);
    float L = 0.f;
#pragma unroll
    for (int w = 0; w < 8; ++w) L += ML[(w * 32 + r32) * 2 + 1] * __builtin_amdgcn_exp2f(ML[(w * 32 + r32) * 2] - Mx);
    const float f = __builtin_amdgcn_exp2f(m_reg - Mx) / L;
#pragma unroll
    for (int half = 0; half < 2; ++half) {
#pragma unroll
        for (int dd = 0; dd < 2; ++dd)
#pragma unroll
            for (int r = 0; r < 16; ++r) OT[(wid * 64 + dd * 32 + crow(r, hi)) * 32 + r32] = oT[half * 2 + dd][r] * f;
        __syncthreads();
        float acc4[4] = {0.f, 0.f, 0.f, 0.f};
#pragma unroll
        for (int w = 0; w < 8; ++w)
#pragma unroll
            for (int j = 0; j < 4; ++j) acc4[j] += OT[(w * 64 + 8 * wid + 4 * hi + j) * 32 + r32];
        u32x2 o2; o2.x = cvt_pk_bf16(acc4[0], acc4[1]); o2.y = cvt_pk_bf16(acc4[2], acc4[3]);
        *(u32x2*)(MIX + (size_t)(MP + b * DS + r32) * DM + PW + h * HD + half * 64 + 8 * wid + 4 * hi) = o2;
        __syncthreads();
    }
}
}

#define XB_TMO      128
#define XB_XCNT(j)  (256  + 64 * (j))
#define XB_XSUB(j)  (1280 + 64 * (j))
#define XB_XGEN(j)  (2304 + 64 * (j))
#define XB_TOP      3328
#define XB_TOPGEN   3392
#define XCD_BAR_WORDS 3456
#define XB_SPIN_CAP (1u << 22)
__device__ __forceinline__ unsigned xb_ld(unsigned* p)              { return __hip_atomic_load(p, __ATOMIC_RELAXED, __HIP_MEMORY_SCOPE_AGENT); }
__device__ __forceinline__ unsigned xb_add(unsigned* p, unsigned v) { return __hip_atomic_fetch_add(p, v, __ATOMIC_RELAXED, __HIP_MEMORY_SCOPE_AGENT); }
__device__ __forceinline__ unsigned xb_xcc_id() { return (unsigned)__builtin_amdgcn_s_getreg((3 << 11) | 20) & 0xFu; }
#define XB_SPIN(cond, bar) do { unsigned _sp = 0; while (cond) { __builtin_amdgcn_s_sleep(1); \
    if ((++_sp & 255u) == 0u) { if (xb_ld(&(bar)[XB_TMO])) break; if (_sp > XB_SPIN_CAP) { atomicAdd(&(bar)[XB_TMO], 1u); break; } } } } while (0)
struct XcdBarrier { unsigned* bar; unsigned x; volatile LAS unsigned* st; };
__device__ __forceinline__ XcdBarrier xcd_barrier_post(unsigned* bar, volatile LAS unsigned* st, bool leader) {
    XcdBarrier b; b.bar = bar; b.x = xb_xcc_id(); b.st = st;
    if (leader) (void)xb_add(&bar[XB_XCNT(b.x)], 1u);
    return b;
}
__device__ __forceinline__ void xcd_barrier_complete(unsigned* bar, unsigned x, unsigned& nloc, unsigned& nx) {
    const unsigned G = gridDim.x * gridDim.y * gridDim.z;
    unsigned sum, cnt, mine, sp = 0u;
    for (;;) {
        sum = 0u; cnt = 0u; mine = 0u;
#pragma unroll
        for (unsigned j = 0; j < 16; ++j) { const unsigned c = xb_ld(&bar[XB_XCNT(j)]); sum += c; cnt += (c > 0u) ? 1u : 0u; mine = (j == x) ? c : mine; }
        if (sum == G) break;
        __builtin_amdgcn_s_sleep(1);
        if ((++sp & 255u) == 0u) { if (xb_ld(&bar[XB_TMO])) break; if (sp > XB_SPIN_CAP) { atomicAdd(&bar[XB_TMO], 1u); break; } }
    }
    nloc = mine > 0u ? mine : 1u; nx = cnt > 0u ? cnt : 1u;
}
__device__ __forceinline__ void xcd_barrier(const XcdBarrier& b, bool leader) {
    asm volatile("s_waitcnt vmcnt(0)" ::: "memory");
    __syncthreads();
    if (leader) {
        unsigned* bar = b.bar;
        __builtin_amdgcn_s_waitcnt(0);
        unsigned nloc = b.st[0], nx = b.st[1];
        if (nloc == 0u) { xcd_barrier_complete(bar, b.x, nloc, nx); b.st[0] = nloc; b.st[1] = nx; }
        const unsigned old = xb_add(&bar[XB_XSUB(b.x)], 1u);
        const unsigned gen = old / nloc;
        if (old + 1u == (gen + 1u) * nloc) {
            __builtin_amdgcn_fence(__ATOMIC_RELEASE, "agent");
            asm volatile("s_waitcnt vmcnt(0)" ::: "memory");
            const unsigned og = xb_add(&bar[XB_TOP], 1u);
            const unsigned tg = og / nx;
            if (og + 1u == (tg + 1u) * nx) xb_add(&bar[XB_TOPGEN], 1u);
            else XB_SPIN(xb_ld(&bar[XB_TOPGEN]) == tg, bar);
            __builtin_amdgcn_fence(__ATOMIC_ACQUIRE, "agent");
            xb_add(&bar[XB_XGEN(b.x)], 1u);
            asm volatile("s_waitcnt vmcnt(0)" ::: "memory");
        } else {
            XB_SPIN(xb_ld(&bar[XB_XGEN(b.x)]) == gen, bar);
            __builtin_amdgcn_fence(__ATOMIC_ACQUIRE, "agent");
            asm volatile("s_waitcnt vmcnt(0)" ::: "memory");
        }
    }
    __syncthreads();
}

#ifndef PHASES
#define PHASES 0xfff
#endif
#ifndef PROBE
#define PROBE 0
#endif
#define REPS(id) for (int rep_ = 0; rep_ < ((PROBE == (id)) ? 2 : 1); ++rep_)
struct Args {
    const float *x_prompt, *x_sample, *cache_k, *cache_v, *cache_logf, *state_pool, *attn_norm_g, *w_in, *b_f, *q_norm_g, *k_norm_g, *w_pool, *pool_scale, *w_out, *mlp_norm_g, *w_up, *w_down;
    float* out; unsigned char* ws;
};
__device__ __forceinline__ float wave_sum(float v) { v += swz_xor<1>(v); v += swz_xor<2>(v); v += swz_xor<4>(v); v += swz_xor<8>(v); v += swz_xor<16>(v); return half_sum(v); }
__device__ __forceinline__ float wave_max(float v) { v = fmaxf(v, swz_xor<1>(v)); v = fmaxf(v, swz_xor<2>(v)); v = fmaxf(v, swz_xor<4>(v)); v = fmaxf(v, swz_xor<8>(v)); v = fmaxf(v, swz_xor<16>(v)); return half_max(v); }
constexpr int TR_LDS = 64 * 33 * 4;
__device__ __forceinline__ void transpose_tile(const float* W, int K, int N, bf16_t* WT, LAS unsigned* scr, int kb, int nb, int lane) {
    const int k0 = 64 * kb, n0 = 64 * nb, kq = lane >> 4, n4 = lane & 15;
    const bool okc = n0 + 4 * n4 < N;
    f32x4 ra[8], rb[8];
    const float* src = W + (size_t)(k0 + 2 * kq) * N + n0 + 4 * n4;
#pragma unroll
    for (int j = 0; j < 8; ++j) {
        ra[j] = okc ? __builtin_nontemporal_load((const f32x4*)(src + (size_t)(8 * j) * N)) : (f32x4){0.f, 0.f, 0.f, 0.f};
        rb[j] = okc ? __builtin_nontemporal_load((const f32x4*)(src + (size_t)(8 * j + 1) * N)) : (f32x4){0.f, 0.f, 0.f, 0.f}; }
#pragma unroll
    for (int j = 0; j < 8; ++j)
#pragma unroll
        for (int e = 0; e < 4; ++e) scr[(4 * n4 + e) * 33 + 4 * j + kq] = cvt_pk_bf16(ra[j][e], rb[j][e]);
    asm volatile("s_waitcnt lgkmcnt(0)" ::: "memory");
    const int c = lane & 7;
#pragma unroll
    for (int i = 0; i < 8; ++i) { const int n = (lane >> 3) + 8 * i; const LAS unsigned* p = scr + n * 33 + 4 * c;
        u32x4 o; o.x = p[0]; o.y = p[1]; o.z = p[2]; o.w = p[3];
        if (n0 + n < N) __builtin_nontemporal_store(o, (u32x4*)(WT + (size_t)(n0 + n) * K + k0 + 8 * c)); }
    asm volatile("s_waitcnt lgkmcnt(0)" ::: "memory");
}
__device__ __forceinline__ float log_sigmoid(float x) { return fminf(x, 0.f) - log1pf(__expf(-fabsf(x))); }

__global__ void __launch_bounds__(512, 2) hymba_fwd(Args a) {
    extern __shared__ __attribute__((aligned(16))) unsigned char lds_raw[];
    LAS unsigned char* lds = (LAS unsigned char*)lds_raw;
    volatile LAS unsigned* MISC = (volatile LAS unsigned*)(lds + MISC_OFF);
    const int wave = __builtin_amdgcn_readfirstlane((int)threadIdx.x >> 6);
    const int G = gridDim.x; const int bx = blockIdx.x; const int vcu = (G % 8 == 0) ? (bx % 8) * (G / 8) + bx / 8 : bx;
    unsigned char* ws = a.ws;
    unsigned* ctl = (unsigned*)(ws + WS_CTL);
    bf16_t* WI = (bf16_t*)(ws + WS_WI); bf16_t* WP = (bf16_t*)(ws + WS_WP); bf16_t* WO = (bf16_t*)(ws + WS_WO); bf16_t* WU = (bf16_t*)(ws + WS_WU); bf16_t* WD = (bf16_t*)(ws + WS_WD);
    bf16_t* XN = (bf16_t*)(ws + WS_XN); bf16_t* PROJ = (bf16_t*)(ws + WS_PROJ); float* FL = (float*)(ws + WS_FL); float* CB = (float*)(ws + WS_CB); float* CS = (float*)(ws + WS_CS);
    bf16_t* DP = (bf16_t*)(ws + WS_DP); bf16_t* MIX = (bf16_t*)(ws + WS_MIX); bf16_t* X1G = (bf16_t*)(ws + WS_X1G); bf16_t* HID = (bf16_t*)(ws + WS_HID); float* PART = (float*)(ws + WS_PART);
    int* JLO = (int*)(ctl + CW_JLO); float* RSS = (float*)(ctl + CW_RSS);
    float* out = a.out;
    for (int u = wave * 64 + fresh_lane(); u < (LDS_BYTES - 131072) / 4; u += 512) ((LAS unsigned*)(lds + 131072))[u] = 0u;
    __syncthreads();
    XcdBarrier bar = xcd_barrier_post(ctl + CW_BAR, MISC + 8, wave == 0 && fresh_lane() == 0);
    const int gw = vcu * 8 + wave, NGW = G * 8;

    REPS(1) {
        const int lane = fresh_lane();
        LAS unsigned* scr = (LAS unsigned*)(lds + wave * TR_LDS);
        constexpr int NB_I = (NPROJ + 63) / 64, I_I = (DM / 64) * NB_I, I_P = 4 * (PG / 64) * (PG / 64), I_O = (DM / 64) * (DM / 64);
        constexpr int NITEMS = I_I + I_P + I_O;
        for (int it = gw; it < NITEMS; it += NGW) {
            int r = it;
            if (r < I_I) { transpose_tile(a.w_in, DM, NPROJ, WI, scr, r / NB_I, r % NB_I, lane); continue; } r -= I_I;
            if (r < I_P) { const int g = r / ((PG / 64) * (PG / 64)), q = r % ((PG / 64) * (PG / 64)); transpose_tile(a.w_pool + (size_t)g * PG * PG, PG, PG, WP + (size_t)g * PG * PG, scr, q / (PG / 64), q % (PG / 64), lane); continue; } r -= I_P;
            transpose_tile(a.w_out, DM, DM, WO, scr, r / (DM / 64), r % (DM / 64), lane);
        }
        for (int m = gw; m < M; m += NGW) {
            const float* xrow = (m < MP) ? a.x_prompt + (size_t)m * DM : a.x_sample + (size_t)(m - MP) * DM;
            f32x4 v[16]; float s = 0.f;
#pragma unroll
            for (int j = 0; j < 16; ++j) { v[j] = *(const f32x4*)(xrow + 256 * j + 4 * lane); s += (v[j][0] * v[j][0] + v[j][1] * v[j][1]) + (v[j][2] * v[j][2] + v[j][3] * v[j][3]); }
            const float rstd = __builtin_amdgcn_rsqf(wave_sum(s) * (1.0f / DM) + EPS);
#pragma unroll
            for (int j = 0; j < 16; ++j) { const f32x4 gg = *(const f32x4*)(a.attn_norm_g + 256 * j + 4 * lane); const f32x4 y = v[j] * rstd * gg;
                u32x2 o; o.x = cvt_pk_bf16(y[0], y[1]); o.y = cvt_pk_bf16(y[2], y[3]); *(u32x2*)(XN + (size_t)m * DM + 256 * j + 4 * lane) = o; }
        }
    }
    xcd_barrier(bar, wave == 0 && fresh_lane() == 0);

    REPS(2) {
        {
            const int lane = fresh_lane(), fr = lane & 15, fq = lane >> 4;
            for (int t = gw; t < (M / 16) * 4; t += NGW) {
                const int rg = t >> 2, kq = t & 3;
                const bf16_t* xa = XN + (size_t)(rg * 16 + fr) * DM + kq * 1024 + 8 * fq;
                const bf16_t* wb = WI + (size_t)(PW + 3 * AW + fr) * DM + kq * 1024 + 8 * fq;
                f32x4 acc = {0.f, 0.f, 0.f, 0.f};
#pragma unroll 8
                for (int k = 0; k < 32; ++k) { const bf16x8 xv = *(const bf16x8*)(xa + 32 * k), wv = *(const bf16x8*)(wb + 32 * k);
                    acc = __builtin_amdgcn_mfma_f32_16x16x32_bf16(wv, xv, acc, 0, 0, 0); }
                *(f32x4*)(FL + ((size_t)kq * M + rg * 16 + fr) * NH + 4 * fq) = acc;
            }
        }
        pg8::Gemm g{XN, WI, M, PP, DM, DM, 1 << 30}; pg8::SplitOrder S; S.init(M, PP, DM, G, bx, PART, ctl + CW_SPLIT + (0 + 4 * rep_) * 8192);
        pg8::EpiProj E{PROJ};
        const int ncls = (S.r && G == 256) ? S.nfull / G + 1 : 1, cls = (bx >> 3) % ncls;
#pragma unroll 1
        for (int seg = 0; seg < 2; ++seg) {
            S.ibeg = seg == 0 ? 0 : cls; S.iend = seg == 0 ? cls : (1 << 30);
            pg8::gemm_phase<pg8::EpiProj, pg8::SplitOrder>(lds, g, S, E, wave, seg == 1);
            if (seg == 0) {
                const int lane = fresh_lane(); LAS unsigned* scr = (LAS unsigned*)(lds + wave * TR_LDS);
                constexpr int I_U = (DM / 64) * (DFF / 64), I_D = (DFF / 64) * (DM / 64);
                for (int it = gw; it < I_U + I_D; it += NGW) {
                    if (it < I_U) transpose_tile(a.w_up, DM, DFF, WU, scr, it / (DFF / 64), it % (DFF / 64), lane);
                    else { const int r = it - I_U; transpose_tile(a.w_down, DFF, DM, WD, scr, r / (DM / 64), r % (DM / 64), lane); }
                }
                asm volatile("s_waitcnt vmcnt(0) lgkmcnt(0)" ::: "memory"); __syncthreads();
            }
        }
    }
    xcd_barrier(bar, wave == 0 && fresh_lane() == 0);

    {
        const int lane = fresh_lane(), tid = wave * 64 + lane;
#define FLS(i) ((FL[(i)] + FL[(size_t)M * NH + (i)]) + (FL[(size_t)2 * M * NH + (i)] + FL[(size_t)3 * M * NH + (i)]))
        if (vcu < 16) {
            const int h = vcu; LAS float* cl = (LAS float*)lds; LAS double* tot = (LAS double*)(lds + 65536);
            const float bf = a.b_f[h]; float lf[16]; double run = 0.0;
#pragma unroll
            for (int j = 0; j < 16; ++j) lf[j] = log_sigmoid(FLS((size_t)(tid * 16 + j) * NH + h) + bf);
#pragma unroll
            for (int j = 0; j < 16; ++j) { out[O_FP + (size_t)(tid * 16 + j) * NH + h] = lf[j]; run += (double)lf[j]; }
            tot[tid] = run; __syncthreads();
            if (tid == 0) { double s = 0.0; for (int i = 0; i < 512; ++i) { const double t = tot[i]; tot[i] = s; s += t; } }
            __syncthreads();
            double c = tot[tid];
#pragma unroll
            for (int j = 0; j < 16; ++j) { c += (double)lf[j]; cl[tid * 16 + j] = (float)c; CB[(size_t)h * SEQ + tid * 16 + j] = (float)(c * (double)LOG2E); }
            __syncthreads();
            if (tid < 64) {
                float gq = fmaxf(fabsf(a.q_norm_g[tid]), fabsf(a.q_norm_g[tid + 64])), gk = fmaxf(fabsf(a.k_norm_g[tid]), fabsf(a.k_norm_g[tid + 64]));
                gq = wave_max(gq); gk = wave_max(gk);
                const float U = 11.3137085f * gq * gk; const float thr = -(2.f * U + PRUNE_T);
                if (tid < 32) { const int qb = tid; const float cP = cl[qb * 256]; int j = 0; while (j < 4 * qb && (cP - cl[64 * j + 63]) < thr) ++j; JLO[h * 32 + qb] = j; }
            }
            __syncthreads();
        } else if (vcu < 32) {
            const int b = vcu - 16, h = tid & 15, seg = tid >> 4; LAS double* tot = (LAS double*)(lds + 65536);
            const float* lsrc = a.cache_logf + ((size_t)b * PAST + seg * 64) * NH + h;
            double run = 0.0;
#pragma unroll 16
            for (int j = 0; j < 64; ++j) run += (double)lsrc[(size_t)j * NH];
            tot[tid] = run; __syncthreads();
            double c = 0.0; for (int s = 0; s < seg; ++s) c += tot[s * 16 + h];
            double ctot = 0.0; for (int s = 0; s < 32; ++s) ctot += tot[s * 16 + h];
            const float bf = a.b_f[h];
            const float lf0 = log_sigmoid(FLS((size_t)(MP + b * DS) * NH + h) + bf);
            const double cref = ctot + (double)lf0;
            float* csd = CS + (size_t)(b * NH + h) * 2080;
#pragma unroll 16
            for (int j = 0; j < 64; ++j) { c += (double)lsrc[(size_t)j * NH]; csd[seg * 64 + j] = (float)((cref - c) * (double)LOG2E); }
            if (seg == 31) {
                double cn = ctot;
                for (int s = 0; s < DS; ++s) { const float l = log_sigmoid(FLS((size_t)(MP + b * DS + s) * NH + h) + bf); out[O_FS + (size_t)(b * DS + s) * NH + h] = l; cn += (double)l; csd[PAST + s] = (float)((cref - cn) * (double)LOG2E); }
            }
            __syncthreads();
        }
#undef FLS
        for (int m = gw; m < M; m += NGW) {
            bf16_t* pr = PROJ + (size_t)m * PP + 32 * lane;
            float* ko = ((m < MP) ? out + O_KP + (size_t)m * AW : out + O_KS + (size_t)(m - MP) * AW) + 32 * lane;
            float* vo = ((m < MP) ? out + O_VP + (size_t)m * AW : out + O_VS + (size_t)(m - MP) * AW) + 32 * lane;
            const int dofs = (32 * lane) & 127;
#pragma unroll
            for (int which = 0; which < 2; ++which) {
                bf16_t* p = pr + PW + which * AW; const float* gsrc = (which == 0 ? a.q_norm_g : a.k_norm_g) + dofs;
                u32x4 w4[4];
#pragma unroll
                for (int j = 0; j < 4; ++j) w4[j] = *(const u32x4*)(p + 8 * j);
                float v[32]; float ss = 0.f;
#pragma unroll
                for (int j = 0; j < 4; ++j)
#pragma unroll
                    for (int e = 0; e < 4; ++e) { v[8 * j + 2 * e] = bf_lo(w4[j][e]); v[8 * j + 2 * e + 1] = bf_hi(w4[j][e]); }
#pragma unroll
                for (int i = 0; i < 32; ++i) ss += v[i] * v[i];
                ss += swz_xor<1>(ss); ss += swz_xor<2>(ss);
                const float rs = __builtin_amdgcn_rsqf(ss * (1.0f / HD) + EPS) * (which == 0 ? QSCALE : 1.0f);
#pragma unroll
                for (int j = 0; j < 8; ++j) { const f32x4 gg = *(const f32x4*)(gsrc + 4 * j);
#pragma unroll
                    for (int e = 0; e < 4; ++e) v[4 * j + e] = v[4 * j + e] * rs * gg[e]; }
#pragma unroll
                for (int j = 0; j < 4; ++j) { u32x4 w; w.x = cvt_pk_bf16(v[8 * j], v[8 * j + 1]); w.y = cvt_pk_bf16(v[8 * j + 2], v[8 * j + 3]); w.z = cvt_pk_bf16(v[8 * j + 4], v[8 * j + 5]); w.w = cvt_pk_bf16(v[8 * j + 6], v[8 * j + 7]);
                    *(u32x4*)(p + 8 * j) = w; }
                if (which == 1) {
#pragma unroll
                    for (int j = 0; j < 8; ++j) *(f32x4*)(ko + 4 * j) = (f32x4){v[4 * j], v[4 * j + 1], v[4 * j + 2], v[4 * j + 3]};
                }
            }
            {
                u32x4 vw[4];
#pragma unroll
                for (int j = 0; j < 4; ++j) vw[j] = *(const u32x4*)(pr + PW + 2 * AW + 8 * j);
#pragma unroll
                for (int j = 0; j < 4; ++j) { *(f32x4*)(vo + 8 * j) = (f32x4){bf_lo(vw[j][0]), bf_hi(vw[j][0]), bf_lo(vw[j][1]), bf_hi(vw[j][1])};
                    *(f32x4*)(vo + 8 * j + 4) = (f32x4){bf_lo(vw[j][2]), bf_hi(vw[j][2]), bf_lo(vw[j][3]), bf_hi(vw[j][3])}; }
            }
        }
        for (int task = gw; task < (M / 32) * 4; task += NGW) {
            const int chunk = task >> 2, g = task & 3, w = 2 << g; const int col = g * PG + 8 * lane;
            const bool samp = chunk >= MP / 32; const int r0 = chunk * 32; const int b = chunk - MP / 32;
            const float inv_w = 1.0f / (float)w;
            auto ld8 = [&](int e, float (&v)[8]) {
                if (e >= 0 || (!samp && r0 + e >= 0)) { const u32x4 wv = *(const u32x4*)(PROJ + (size_t)(r0 + e) * PP + col);
#pragma unroll
                    for (int i = 0; i < 4; ++i) { v[2 * i] = bf_lo(wv[i]); v[2 * i + 1] = bf_hi(wv[i]); } }
                else if (samp) { const float* sp = a.state_pool + ((size_t)b * PH + (PH + e)) * PW + col; const f32x4 x0 = *(const f32x4*)sp, x1 = *(const f32x4*)(sp + 4);
                    v[0] = x0[0]; v[1] = x0[1]; v[2] = x0[2]; v[3] = x0[3]; v[4] = x1[0]; v[5] = x1[1]; v[6] = x1[2]; v[7] = x1[3]; }
                else {
#pragma unroll
                    for (int i = 0; i < 8; ++i) v[i] = 0.f; }
            };
            float Sx[8];
#pragma unroll
            for (int i = 0; i < 8; ++i) Sx[i] = 0.f;
            for (int e = -(w - 1); e < 0; ++e) { float t[8]; ld8(e, t);
#pragma unroll
                for (int i = 0; i < 8; ++i) Sx[i] += t[i]; }
            for (int e = 0; e < 32; ++e) {
                float cur[8], old[8]; ld8(e, cur); ld8(e - w + 1, old);
#pragma unroll
                for (int i = 0; i < 8; ++i) Sx[i] += cur[i];
                float ic = inv_w; if (!samp) { const int pos = r0 + e; if (pos + 1 < w) ic = 1.0f / (float)(pos + 1); }
                float d[8];
#pragma unroll
                for (int i = 0; i < 8; ++i) d[i] = Sx[i] * ic - cur[i];
                u32x4 o; o.x = cvt_pk_bf16(d[0], d[1]); o.y = cvt_pk_bf16(d[2], d[3]); o.z = cvt_pk_bf16(d[4], d[5]); o.w = cvt_pk_bf16(d[6], d[7]);
                *(u32x4*)(DP + (size_t)(r0 + e) * PW + col) = o;
#pragma unroll
                for (int i = 0; i < 8; ++i) Sx[i] -= old[i];
            }
        }
        for (int t = gw; t < PH * (1 + DB); t += NGW) {
            const int s = t / PH, j = t % PH;
            const int row = (s == 0) ? (MP - PH + j) : (MP + (s - 1) * DS + (DS - PH) + j);
            float* dst = (s == 0) ? out + O_HP + (size_t)j * PW : out + O_HS + ((size_t)(s - 1) * PH + j) * PW;
#pragma unroll
            for (int i = 0; i < 4; ++i) { const u32x4 wv = *(const u32x4*)(PROJ + (size_t)row * PP + 32 * lane + 8 * i);
                *(f32x4*)(dst + 32 * lane + 8 * i) = (f32x4){bf_lo(wv[0]), bf_hi(wv[0]), bf_lo(wv[1]), bf_hi(wv[1])};
                *(f32x4*)(dst + 32 * lane + 8 * i + 4) = (f32x4){bf_lo(wv[2]), bf_hi(wv[2]), bf_lo(wv[3]), bf_hi(wv[3])}; }
        }
    }
    xcd_barrier(bar, wave == 0 && fresh_lane() == 0);

    REPS(3) {
        const int cls3 = (G == 256) ? (bx >> 3) % 3 : 2;
#define SAMP_JOB() do { for (int u = vcu; u < DB * NH; u += G) att::samp_unit(u >> 4, u & 15, PROJ, a.cache_k, a.cache_v, CS, MIX, (att::lptr)lds, wave); \
                        asm volatile("s_waitcnt vmcnt(0)" ::: "memory"); __syncthreads(); } while (0)
        if (cls3 == 0) SAMP_JOB();
        {
            pg8::Gemm g{DP, WP, M, PW, PG, PW, 2}; pg8::SplitOrder S; S.init(M, PW, PG, G, bx, nullptr, nullptr);
            pg8::EpiPool E{MIX, a.pool_scale};
            pg8::gemm_phase<pg8::EpiPool, pg8::SplitOrder>(lds, g, S, E, wave);
        }
        if (cls3 == 1) SAMP_JOB();
        {
            int nblk = 0; for (int it = vcu; it < 256; it += G) nblk += 2;
            auto ref = [&](int i) { const int item = vcu + (i >> 1) * G, h = item >> 4, x = item & 15, qb = (i & 1) ? 31 - x : x;
                att::Blk r; r.h = h; r.qb = qb; r.jlo = JLO[h * 32 + qb]; return r; };
            if (nblk > 0) {
                att::Seam S; att::Blk cur = ref(0);
                att::attn_prime(cur, PROJ, (att::lptr)lds, S, wave);
                for (int i = 0; i < nblk; ++i) { const att::Blk nxt = (i + 1 < nblk) ? ref(i + 1) : cur; att::attn_block(cur, nxt, PROJ, MIX, CB, (att::lptr)lds, S, wave); cur = nxt; }
            }
            asm volatile("s_waitcnt vmcnt(0)" ::: "memory"); __syncthreads();
        }
        if (cls3 == 2) SAMP_JOB();
#undef SAMP_JOB
    }
    xcd_barrier(bar, wave == 0 && fresh_lane() == 0);

    REPS(6) {
        pg8::Gemm g{MIX, WO, M, DM, DM, DM, 1 << 30}; pg8::SplitOrder S; S.init(M, DM, DM, G, bx, PART, ctl + CW_SPLIT + (1 + 4 * rep_) * 8192);
        pg8::EpiOut E{a.x_prompt, a.x_sample, out, X1G, a.mlp_norm_g, rep_ ? RSS + 16384 : RSS};
        pg8::gemm_phase<pg8::EpiOut, pg8::SplitOrder>(lds, g, S, E, wave);
    }
    xcd_barrier(bar, wave == 0 && fresh_lane() == 0);

    REPS(7) {
        pg8::Gemm g{X1G, WU, M, DFF, DM, DM, 1 << 30}; pg8::SplitOrder S; S.init(M, DFF, DM, G, bx, PART, ctl + CW_SPLIT + (2 + 4 * rep_) * 8192);
        pg8::EpiUp E{HID, RSS};
        pg8::gemm_phase<pg8::EpiUp, pg8::SplitOrder>(lds, g, S, E, wave);
    }
    xcd_barrier(bar, wave == 0 && fresh_lane() == 0);

    REPS(8) {
        pg8::Gemm g{HID, WD, M, DM, DFF, DFF, 1 << 30}; pg8::SplitOrder S; S.init(M, DM, DFF, G, bx, PART, ctl + CW_SPLIT + (3 + 4 * rep_) * 8192);
        pg8::EpiDown E{rep_ ? (float*)(ws + WS_END) : out};
        pg8::gemm_phase<pg8::EpiDown, pg8::SplitOrder>(lds, g, S, E, wave);
    }
}

extern "C" void kernel_launch(void* const* d_in, const int* in_sizes, int n_in, void* d_out, int out_size, void* d_ws, size_t ws_size, hipStream_t stream) {
    static int grid = 0;
    if (grid == 0) {
        if (n_in != 17 || in_sizes[0] != MP * DM || (size_t)out_size != O_END || ws_size < WS_END + (PROBE == 8 ? (size_t)M * DM * 4 : 0)) {
            fprintf(stderr, "kernel_launch: shape mismatch (n_in %d, in0 %d, out %d, ws %zu; need 17, %d, %zu, >= %zu)\n", n_in, n_in > 0 ? in_sizes[0] : -1, out_size, ws_size, MP * DM, (size_t)O_END, (size_t)WS_END);
            grid = -1; return; }
        int dev = 0, cus = 0, per_cu = 0;
        if (hipGetDevice(&dev) != hipSuccess || hipDeviceGetAttribute(&cus, hipDeviceAttributeMultiprocessorCount, dev) != hipSuccess) { grid = -1; return; }
        if (hipFuncSetAttribute((const void*)hymba_fwd, hipFuncAttributeMaxDynamicSharedMemorySize, LDS_BYTES) != hipSuccess) { fprintf(stderr, "kernel_launch: hipFuncSetAttribute failed\n"); grid = -1; return; }
        if (hipOccupancyMaxActiveBlocksPerMultiprocessor(&per_cu, (const void*)hymba_fwd, 512, LDS_BYTES) != hipSuccess || per_cu < 1) { fprintf(stderr, "kernel_launch: occupancy query says %d\n", per_cu); }
        (void)hipGetLastError();
        grid = cus;
    }
    if (grid < 0) return;
    if (hipMemsetAsync((char*)d_ws + WS_CTL, 0, CTL_ZERO_BYTES, stream) != hipSuccess) { fprintf(stderr, "kernel_launch: memset failed\n"); return; }
    Args a{};
    a.x_prompt = (const float*)d_in[0]; a.x_sample = (const float*)d_in[1]; a.cache_k = (const float*)d_in[2]; a.cache_v = (const float*)d_in[3]; a.cache_logf = (const float*)d_in[4];
    a.state_pool = (const float*)d_in[5]; a.attn_norm_g = (const float*)d_in[6]; a.w_in = (const float*)d_in[7]; a.b_f = (const float*)d_in[8]; a.q_norm_g = (const float*)d_in[9];
    a.k_norm_g = (const float*)d_in[10]; a.w_pool = (const float*)d_in[11]; a.pool_scale = (const float*)d_in[12]; a.w_out = (const float*)d_in[13]; a.mlp_norm_g = (const float*)d_in[14];
    a.w_up = (const float*)d_in[15]; a.w_down = (const float*)d_in[16];
    a.out = (float*)d_out; a.ws = (unsigned char*)d_ws;
    hipLaunchKernelGGL(hymba_fwd, dim3(grid), dim3(512), LDS_BYTES, stream, a);
    const hipError_t le = hipPeekAtLastError();
    if (le != hipSuccess) fprintf(stderr, "kernel_launch: launch failed: %s\n", hipGetErrorName(le));
}
```

```cpp
#include <hip/hip_runtime.h>
#include <cstdio>
#include <cstdint>

#define LAS __attribute__((address_space(3)))
#define GAS __attribute__((address_space(1)))
typedef unsigned short bf16_t;
typedef short bf16x8 __attribute__((ext_vector_type(8)));
typedef short s16x4 __attribute__((ext_vector_type(4)));
typedef float f32x2 __attribute__((ext_vector_type(2)));
typedef float f32x4 __attribute__((ext_vector_type(4)));
typedef float f32x16 __attribute__((ext_vector_type(16)));
typedef unsigned u32x2 __attribute__((ext_vector_type(2)));
typedef unsigned u32x4 __attribute__((ext_vector_type(4)));

constexpr int DM = 4096, SEQ = 8192, DB = 16, DS = 32, PAST = 2048;
constexpr int MP = SEQ, MS = DB * DS, M = MP + MS;
constexpr int PW = 2048, AW = 2048, NH = 16, HD = 128, PH = 15, PG = 512;
constexpr int NPROJ = PW + 3 * AW + NH;
constexpr int NPROJ_PAD = 8448;
constexpr int PP = 8192;
constexpr int DFF = 16384;
constexpr float EPS = 1e-6f;
constexpr float QSCALE = 0.08838834764831845f * 1.4426950408889634f;
constexpr float LOG2E = 1.4426950408889634f;
constexpr float PRUNE_T = 40.0f;
constexpr size_t O_YP = 0, O_YS = (size_t)MP * DM, O_KP = O_YS + (size_t)MS * DM, O_VP = O_KP + (size_t)MP * AW, O_FP = O_VP + (size_t)MP * AW,
                 O_HP = O_FP + (size_t)MP * NH, O_KS = O_HP + (size_t)PH * PW, O_VS = O_KS + (size_t)MS * AW, O_FS = O_VS + (size_t)MS * AW,
                 O_HS = O_FS + (size_t)MS * NH, O_END = O_HS + (size_t)DB * PH * PW;
static_assert(O_END == 71964672, "output size");
constexpr size_t MiB = 1u << 20;
constexpr size_t WS_CTL = 0, CTL_ZERO_BYTES = 1 * MiB;
constexpr size_t WS_WI = 2 * MiB, WS_WP = 68 * MiB, WS_WO = 70 * MiB, WS_WU = 102 * MiB, WS_WD = 230 * MiB, WS_XN = 358 * MiB, WS_PROJ = 426 * MiB,
                 WS_FL = 562 * MiB, WS_CB = 565 * MiB, WS_CS = 566 * MiB, WS_DP = 569 * MiB, WS_MIX = 603 * MiB, WS_X1G = 671 * MiB, WS_HID = 739 * MiB, WS_PART = 1011 * MiB, WS_END = 1075 * MiB;
static_assert(WS_WI + (size_t)NPROJ_PAD * DM * 2 <= WS_WP && WS_XN + (size_t)M * DM * 2 <= WS_PROJ && WS_PROJ + (size_t)M * PP * 2 <= WS_FL && WS_FL + (size_t)4 * M * NH * 4 <= WS_CB && WS_CS + (size_t)DB * NH * 2080 * 4 <= WS_DP &&
              WS_DP + (size_t)M * PW * 2 <= WS_MIX && WS_HID + (size_t)M * DFF * 2 <= WS_PART && WS_PART + (size_t)256 * 65536 * 4 <= WS_END, "ws map");
constexpr int CW_BAR = 4096;
constexpr int CW_JLO = 16384;
constexpr int CW_RSS = 32768;
constexpr int CW_SPLIT = 65536;
static_assert((CW_RSS + 16384 + M) <= CW_SPLIT && (CW_SPLIT + 8 * 8192) * 4 <= (int)CTL_ZERO_BYTES, "ctl");
constexpr int LDS_BYTES = 147456;
constexpr int MISC_OFF = LDS_BYTES - 128;

__device__ __forceinline__ int fresh_lane() { int l; asm volatile("v_mbcnt_lo_u32_b32 %0, -1, 0\n\tv_mbcnt_hi_u32_b32 %0, -1, %0" : "=v"(l)); return l; }
template <int X> __device__ __forceinline__ float swz_xor(float v) { return __int_as_float(__builtin_amdgcn_ds_swizzle(__float_as_int(v), (X << 10) | 0x1f)); }
__device__ __forceinline__ float half_sum(float v) { auto rr = __builtin_amdgcn_permlane32_swap(__float_as_uint(v), __float_as_uint(v), false, false); return __uint_as_float(rr[0]) + __uint_as_float(rr[1]); }
__device__ __forceinline__ float half_max(float v) { auto rr = __builtin_amdgcn_permlane32_swap(__float_as_uint(v), __float_as_uint(v), false, false); return fmaxf(__uint_as_float(rr[0]), __uint_as_float(rr[1])); }
__device__ __forceinline__ unsigned cvt_pk_bf16(float lo, float hi) { unsigned r; asm volatile("v_cvt_pk_bf16_f32 %0, %1, %2" : "=v"(r) : "v"(lo), "v"(hi)); return r; }
__device__ __forceinline__ float bf_lo(unsigned w) { return __uint_as_float(w << 16); }
__device__ __forceinline__ float bf_hi(unsigned w) { return __uint_as_float(w & 0xffff0000u); }
__device__ __forceinline__ bf16x8 pack8(f32x4 a, f32x4 b) { u32x4 w = {cvt_pk_bf16(a[0], a[1]), cvt_pk_bf16(a[2], a[3]), cvt_pk_bf16(b[0], b[1]), cvt_pk_bf16(b[2], b[3])}; return __builtin_bit_cast(bf16x8, w); }

namespace pg8 {
constexpr int BM = 256, BK = 64, HALF = 128, HTB = HALF * BK * 2, STAGE_BYTES = 8 * HTB, NXCD = 8, WGM = 8;
__host__ __device__ __forceinline__ int lds_byte(int r, int c) { const int st = (r >> 4) * 2 + (c >> 5), rr = r & 15, cc = c & 31, ob = rr * 64 + cc * 2; return st * 1024 + (ob ^ (((ob >> 9) & 1) << 5)); }
__host__ __device__ __forceinline__ void stage_rc(int b, int& R, int& C) { const int st = b / 1024, sb = b % 1024, swz = sb ^ (((sb >> 9) & 1) << 5); R = (st >> 1) * 16 + swz / 64; C = (st & 1) * 32 + (swz % 64) / 2; }
__host__ __device__ __forceinline__ int perm32(int rho) { const int n = rho >> 4, i = rho & 15; return 8 * (i >> 2) + 4 * n + (i & 3); }
struct Unit { int pm, pn, kt0, nt, part; };
struct Gemm { const bf16_t* A; const bf16_t* Bt; int M, N, K, lda, adiv; };
struct SplitOrder {
    int nM, nN, nwg, G, c, R, r, s, ntK, nfull, ibeg, iend, mode, plast; float* part; unsigned* cnt;
    __device__ __forceinline__ void init(int M_, int N_, int K_, int G_, int c_, float* part_, unsigned* cnt_) {
        nM = M_ / BM; nN = N_ / BM; nwg = nM * nN; G = G_; c = c_; ntK = K_ / BK; part = part_; cnt = cnt_;
        r = 0; s = 1; nfull = nwg; ibeg = 0; iend = 1 << 30; mode = 0; plast = 0;
        if (G == 256 && part_ != nullptr) { const int rem = nwg % 256; if (rem != 0 && 256 % rem == 0) { const int ss = 256 / rem; if (ntK % ss == 0 && ((ntK / ss) & 1) == 0 && ntK / ss >= 4) { r = rem; s = ss; nfull = nwg - rem; } } }
    }
    __device__ __forceinline__ void map(int wgid, Unit& u) const {
        if (mode == 1) {
            if (wgid < nfull) { const int rd = wgid >> 8, cc = wgid & 255, x = cc & 7, l = cc >> 3, nb = nN >> 4, pmb = rd / nb, pnb = rd - pmb * nb;
                u.pm = 16 * pmb + 4 * (x >> 1) + (l & 3); u.pn = 16 * pnb + 8 * (x & 1) + (l >> 2); }
            else { const int k = wgid - nfull; u.pm = nfull / nN + k / nN; u.pn = k % nN; }
            return; }
        { const int q = nwg / NXCD, rr = nwg % NXCD, xcd = wgid % NXCD, off = wgid / NXCD; wgid = (xcd < rr ? xcd * (q + 1) : rr * (q + 1) + (xcd - rr) * q) + off; }
        const int nig = WGM * nN, gid = wgid / nig, fm = gid * WGM, gsz = (nM - fm) < WGM ? (nM - fm) : WGM;
        u.pm = fm + ((wgid % nig) % gsz); u.pn = (wgid % nig) / gsz;
    }
    __device__ __forceinline__ bool next(int i0, Unit& u) const {
        const int i = i0 + ibeg; int wg, kt0 = 0, nt = ntK, part = -1; bool ok;
        if (r) {
            const int nr = nfull / G;
            if (i == (plast ? nr : 0)) { wg = nfull + c / s; nt = ntK / s; kt0 = (c % s) * nt; part = c; ok = true; }
            else { const long L = (long)(plast ? i : i - 1) * G + c; ok = L < nfull && i <= nr; wg = ok ? (int)L : 0; }
        } else { const long L = (long)i * G + c; ok = L < nwg; wg = ok ? (int)L : 0; }
        Unit t; map(wg, t); t.kt0 = kt0; t.nt = nt; t.part = part; u = t; return ok && i < iend;
    }
};
__device__ __forceinline__ void store16u_sc1(bf16_t* p, u32x4 v) { asm volatile("global_store_dwordx4 %0, %1, off sc1\n\ts_nop 1" :: "v"(p), "v"(v) : "memory"); }
__device__ __forceinline__ void store16_sc1(float* p, f32x4 v) { asm volatile("global_store_dwordx4 %0, %1, off sc1\n\ts_nop 1" :: "v"(p), "v"(v) : "memory"); }
template <class Epi, class Sched, int STAMP = 0>
__device__ __forceinline__ void gemm_phase(LAS unsigned char* lds, const Gemm g, const Sched& S, const Epi& E, const int wid, const bool do_fix = true) {
    volatile LAS unsigned long long* stw = (volatile LAS unsigned long long*)(lds + 143424);
#define PG8_ST(k) do { if (STAMP && wid == 0 && lane == 0) { stw[2 * (k)] = (unsigned long long)clock64(); stw[2 * (k) + 1] = (unsigned long long)wall_clock64(); } } while (0)
    const int lane = fresh_lane(), tid = wid * 64 + lane, wr = wid >> 2, wc = wid & 3, fr = lane & 15, fq = lane >> 4;
    PG8_ST(3);
    const int K = g.K;
    unsigned voffA[2], voffB[2];
#pragma unroll
    for (int i = 0; i < 2; ++i) { int R, C; stage_rc(tid * 16 + i * 8192, R, C); const int Rb = (R & ~31) + perm32(R & 31);
        voffA[i] = (unsigned)(R * g.lda + C) * 2u; voffB[i] = (unsigned)(Rb * K + C) * 2u; }
    const size_t kstep = (size_t)(BK * 2);
    const size_t hstepA = (size_t)HALF * g.lda * 2, hstepB = (size_t)HALF * K * 2;
    const size_t tstepA = 2 * hstepA, tstepB = 2 * hstepB;
    const unsigned ldsw = (unsigned)wid * 1024u;
    const int aoff = lds_byte(wr * 64 + fr, fq * 8), boff = lds_byte(wc * 32 + fr, fq * 8);
#define PG8_SA(b, h) (((b) * 2 + (h)) * HTB)
#define PG8_SB(b, h) ((4 + (b) * 2 + (h)) * HTB)
#define PG8_STAGE(bufoff, gbase, voff) do { _Pragma("unroll") for (int _i = 0; _i < 2; ++_i) \
        __builtin_amdgcn_global_load_lds((const unsigned*)((const char*)(gbase) + (voff)[_i]), (LAS unsigned*)(lds + (bufoff) + ldsw + _i * 8192), 16, 0, 0); } while (0)
#define PG8_LDA(dst, b, h) do { _Pragma("unroll") for (int m = 0; m < 4; ++m) _Pragma("unroll") for (int k = 0; k < 2; ++k) dst[m][k] = *(const LAS bf16x8*)(lds + PG8_SA(b, h) + aoff + m * 2048 + k * 1024); } while (0)
#define PG8_LDB(dst, b, h) do { _Pragma("unroll") for (int n = 0; n < 2; ++n) _Pragma("unroll") for (int k = 0; k < 2; ++k) dst[n][k] = *(const LAS bf16x8*)(lds + PG8_SB(b, h) + boff + n * 2048 + k * 1024); } while (0)
#define PG8_MMA(ai, bj, At, Bt) do { __builtin_amdgcn_s_setprio(1); _Pragma("unroll") for (int m = 0; m < 4; ++m) _Pragma("unroll") for (int n = 0; n < 2; ++n) _Pragma("unroll") for (int k = 0; k < 2; ++k) \
        acc[ai][bj][m][n] = __builtin_amdgcn_mfma_f32_16x16x32_bf16(Bt[n][k], At[m][k], acc[ai][bj][m][n], 0, 0, 0); __builtin_amdgcn_s_setprio(0); } while (0)
#define PG8_WAIT_V(n) asm volatile("s_waitcnt vmcnt(" #n ")" ::: "memory")
#define PG8_WAIT_L(n) asm volatile("s_waitcnt lgkmcnt(" #n ")" ::: "memory")
#define PG8_BAR __builtin_amdgcn_s_barrier()
#define PG8_SCHED __builtin_amdgcn_sched_barrier(0)
    Unit cur, nxt; int ui = 0;
    if (S.next(0, cur)) {
    f32x4 acc[2][2][4][2];
#pragma unroll
    for (int a = 0; a < 2; ++a)
#pragma unroll
        for (int b = 0; b < 2; ++b)
#pragma unroll
            for (int m = 0; m < 4; ++m)
#pragma unroll
                for (int n = 0; n < 2; ++n) acc[a][b][m][n] = (f32x4){0.f, 0.f, 0.f, 0.f};
    bf16x8 At[4][2], B0[2][2], B1[2][2];
    const char* cA = (const char*)g.A + (size_t)cur.pm * tstepA + (size_t)(cur.pn / g.adiv) * K * 2 + (size_t)cur.kt0 * kstep; const char* cB = (const char*)g.Bt + (size_t)cur.pn * tstepB + (size_t)cur.kt0 * kstep;
    PG8_STAGE(PG8_SB(0, 0), cB, voffB); PG8_STAGE(PG8_SB(0, 1), cB + hstepB, voffB); PG8_STAGE(PG8_SA(0, 0), cA, voffA); PG8_STAGE(PG8_SA(0, 1), cA + hstepA, voffA);
    if (wr == 1) PG8_BAR;
    PG8_WAIT_V(2); PG8_BAR;
    PG8_STAGE(PG8_SB(1, 0), cB + kstep, voffB); PG8_STAGE(PG8_SA(1, 0), cA + kstep, voffA); PG8_STAGE(PG8_SB(1, 1), cB + hstepB + kstep, voffB);
    PG8_WAIT_V(6); PG8_BAR;
    for (;;) {
        const bool has_next = S.next(ui + 1, nxt);
        const char* nA = has_next ? (const char*)g.A + (size_t)nxt.pm * tstepA + (size_t)(nxt.pn / g.adiv) * K * 2 + (size_t)nxt.kt0 * kstep : cA; const char* nB = has_next ? (const char*)g.Bt + (size_t)nxt.pn * tstepB + (size_t)nxt.kt0 * kstep : cB;
        const int nt = cur.nt;
        if (ui == 3) PG8_ST(0);
        for (int t = 0; t < nt; t += 2) {
            const bool last = (t == nt - 2);
            const char* a1 = cA + (size_t)(t + 1) * kstep;
            const char* a2 = last ? nA : cA + (size_t)(t + 2) * kstep; const char* b2 = last ? nB : cB + (size_t)(t + 2) * kstep;
            const char* a3 = a2 + kstep; const char* b3 = b2 + kstep;
            PG8_LDB(B0, 0, 0); PG8_LDB(B1, 0, 1); PG8_SCHED; PG8_LDA(At, 0, 0); PG8_STAGE(PG8_SA(1, 1), a1 + hstepA, voffA);
            PG8_WAIT_V(8); PG8_WAIT_L(0); PG8_BAR; PG8_MMA(0, 0, At, B0); PG8_MMA(0, 1, At, B1); PG8_BAR; PG8_SCHED;
            PG8_LDA(At, 0, 1); PG8_STAGE(PG8_SB(0, 0), b2, voffB); PG8_STAGE(PG8_SB(0, 1), b2 + hstepB, voffB); PG8_STAGE(PG8_SA(0, 0), a2, voffA);
            PG8_WAIT_V(8); PG8_WAIT_L(0); PG8_BAR; PG8_MMA(1, 0, At, B0); PG8_MMA(1, 1, At, B1); PG8_BAR; PG8_SCHED;
            PG8_LDB(B0, 1, 0); PG8_LDB(B1, 1, 1); PG8_SCHED; PG8_LDA(At, 1, 0); PG8_STAGE(PG8_SA(0, 1), a2 + hstepA, voffA);
            PG8_WAIT_V(8); PG8_WAIT_L(0); PG8_BAR; PG8_MMA(0, 0, At, B0); PG8_MMA(0, 1, At, B1); PG8_BAR; PG8_SCHED;
            PG8_LDA(At, 1, 1); PG8_STAGE(PG8_SB(1, 0), b3, voffB); PG8_STAGE(PG8_SB(1, 1), b3 + hstepB, voffB); PG8_STAGE(PG8_SA(1, 0), a3, voffA);
            PG8_WAIT_V(8); PG8_WAIT_L(0); PG8_BAR; PG8_MMA(1, 0, At, B0); PG8_MMA(1, 1, At, B1); PG8_BAR; PG8_SCHED;
        }
        if (ui == 3) PG8_ST(1);
        if (wr == 0) PG8_BAR;
        if (cur.part >= 0) {
            bf16_t* pb = (bf16_t*)S.part + (size_t)cur.part * 65536 + (size_t)(wid * 16 * 64 + lane) * 8;
#pragma unroll
            for (int ai = 0; ai < 2; ++ai)
#pragma unroll
                for (int m = 0; m < 4; ++m)
#pragma unroll
                    for (int bj = 0; bj < 2; ++bj) { const f32x4 v0 = acc[ai][bj][m][0], v1 = acc[ai][bj][m][1];
                        u32x4 w; w.x = cvt_pk_bf16(v0[0], v0[1]); w.y = cvt_pk_bf16(v0[2], v0[3]); w.z = cvt_pk_bf16(v1[0], v1[1]); w.w = cvt_pk_bf16(v1[2], v1[3]);
                        store16u_sc1(pb + (size_t)((ai * 4 + m) * 2 + bj) * 512, w); }
            asm volatile("s_waitcnt vmcnt(0)" ::: "memory");
            if (lane == 0) __hip_atomic_fetch_add(S.cnt + 64 * (cur.part / S.s), 1u, __ATOMIC_RELAXED, __HIP_MEMORY_SCOPE_AGENT);
        } else E(acc, cur, wr, wc, fr, fq);
        if (ui == 3) PG8_ST(2);
        if (!has_next) break;
#pragma unroll
        for (int a = 0; a < 2; ++a)
#pragma unroll
            for (int b = 0; b < 2; ++b)
#pragma unroll
                for (int m = 0; m < 4; ++m)
#pragma unroll
                    for (int n = 0; n < 2; ++n) acc[a][b][m][n] = (f32x4){0.f, 0.f, 0.f, 0.f};
        cur = nxt; cA = nA; cB = nB; ++ui;
        if (wr == 1) PG8_BAR;
    }
    PG8_WAIT_V(0);
    PG8_BAR;
    }
    if (S.r && do_fix) {
        const int su = S.c / S.s, j = S.c % S.s, rows = BM / S.s; Unit fu; S.map(S.nfull + su, fu);
        if (wid == 0) { unsigned* cw = S.cnt + 64 * su; unsigned sp = 0;
            while ((unsigned)__builtin_amdgcn_readfirstlane(__hip_atomic_load(cw, __ATOMIC_RELAXED, __HIP_MEMORY_SCOPE_AGENT)) < 8u * (unsigned)S.s) { __builtin_amdgcn_s_sleep(2); if (++sp > (1u << 22)) break; }
            __builtin_amdgcn_fence(__ATOMIC_ACQUIRE, "agent"); asm volatile("s_waitcnt vmcnt(0)" ::: "memory"); }
        __syncthreads();
        const bf16_t* pbase = (const bf16_t*)S.part + (size_t)(su * S.s) * 65536 + (size_t)(wid * 16 * 64 + lane) * 8;
        f32x4 facc[2][2][4][2]; unsigned rmask = 0u;
#pragma unroll
        for (int ai = 0; ai < 2; ++ai)
#pragma unroll
            for (int m = 0; m < 4; ++m) { const int p = ai * 4 + m; const bool mine = (p & (S.s - 1)) == j; rmask |= mine ? (1u << p) : 0u;
#pragma unroll
                for (int bj = 0; bj < 2; ++bj) { f32x4 s0 = {0.f, 0.f, 0.f, 0.f}, s1 = s0;
                    if (mine) {
#pragma unroll
                        for (int q = 0; q < 8; ++q) if (q < S.s) { const u32x4 w = *(const u32x4*)(pbase + (size_t)q * 65536 + (size_t)(p * 2 + bj) * 512);
                            s0 += (f32x4){bf_lo(w.x), bf_hi(w.x), bf_lo(w.y), bf_hi(w.y)}; s1 += (f32x4){bf_lo(w.z), bf_hi(w.z), bf_lo(w.w), bf_hi(w.w)}; } }
                    facc[ai][bj][m][0] = s0; facc[ai][bj][m][1] = s1; } }
        E(facc, fu, wr, wc, fr, fq, rmask);
    }
    PG8_ST(4);
#undef PG8_ST
#undef PG8_SA
#undef PG8_SB
#undef PG8_STAGE
#undef PG8_LDA
#undef PG8_LDB
#undef PG8_MMA
#undef PG8_WAIT_V
#undef PG8_WAIT_L
#undef PG8_BAR
#undef PG8_SCHED
}

struct EpiProj {
    bf16_t* O;
    __device__ __forceinline__ void operator()(const f32x4 (&acc)[2][2][4][2], const Unit& u, int wr, int wc, int fr, int fq, unsigned rmask = 0xffu) const {
        const int row0 = u.pm * BM + wr * 64 + fr;
        const int col0 = u.pn * BM + wc * 32 + 8 * fq;
#pragma unroll
        for (int ai = 0; ai < 2; ++ai)
#pragma unroll
            for (int m = 0; m < 4; ++m) { if (!((rmask >> (ai * 4 + m)) & 1u)) continue; bf16_t* rowp = O + (size_t)(row0 + ai * HALF + m * 16) * PP + col0;
#pragma unroll
                for (int bj = 0; bj < 2; ++bj) { const f32x4 v0 = acc[ai][bj][m][0], v1 = acc[ai][bj][m][1];
                    u32x4 w; w.x = cvt_pk_bf16(v0[0], v0[1]); w.y = cvt_pk_bf16(v0[2], v0[3]); w.z = cvt_pk_bf16(v1[0], v1[1]); w.w = cvt_pk_bf16(v1[2], v1[3]);
                    *(u32x4*)(rowp + bj * HALF) = w; } }
    }
};
struct EpiPool {
    bf16_t* O; const float* scale;
    __device__ __forceinline__ void operator()(const f32x4 (&acc)[2][2][4][2], const Unit& u, int wr, int wc, int fr, int fq, unsigned rmask = 0xffu) const {
        const int row0 = u.pm * BM + wr * 64 + fr, col0 = u.pn * BM + wc * 32 + 8 * fq;
        f32x4 sv[2][2];
#pragma unroll
        for (int bj = 0; bj < 2; ++bj)
#pragma unroll
            for (int n = 0; n < 2; ++n) sv[bj][n] = *(const f32x4*)(scale + col0 + bj * HALF + 4 * n);
#pragma unroll
        for (int ai = 0; ai < 2; ++ai)
#pragma unroll
            for (int m = 0; m < 4; ++m) { if (!((rmask >> (ai * 4 + m)) & 1u)) continue; bf16_t* rowp = O + (size_t)(row0 + ai * HALF + m * 16) * DM + col0;
#pragma unroll
                for (int bj = 0; bj < 2; ++bj) { const f32x4 v0 = acc[ai][bj][m][0] * sv[bj][0], v1 = acc[ai][bj][m][1] * sv[bj][1];
                    u32x4 w; w.x = cvt_pk_bf16(v0[0], v0[1]); w.y = cvt_pk_bf16(v0[2], v0[3]); w.z = cvt_pk_bf16(v1[0], v1[1]); w.w = cvt_pk_bf16(v1[2], v1[3]);
                    *(u32x4*)(rowp + bj * HALF) = w; } }
    }
};
struct EpiOut {
    const float* xp; const float* xs; bf16_t* X1B; float* rowss;
    __device__ __forceinline__ void operator()(const f32x4 (&acc)[2][2][4][2], const Unit& u, int wr, int wc, int fr, int fq, unsigned rmask = 0xffu) const {
        const int row0 = u.pm * BM + wr * 64 + fr, col0 = u.pn * BM + wc * 32 + 8 * fq;
        const float* xin = (u.pm < MP / BM) ? xp : xs - (size_t)MP * DM;
#pragma unroll
        for (int ai = 0; ai < 2; ++ai) {
            f32x4 xv[4][2][2];
#pragma unroll
            for (int m = 0; m < 4; ++m)
#pragma unroll
                for (int bj = 0; bj < 2; ++bj)
#pragma unroll
                    for (int n = 0; n < 2; ++n) if ((rmask >> (ai * 4 + m)) & 1u) xv[m][bj][n] = *(const f32x4*)(xin + (size_t)(row0 + ai * HALF + m * 16) * DM + col0 + bj * HALF + 4 * n);
#pragma unroll
            for (int m = 0; m < 4; ++m) { if (!((rmask >> (ai * 4 + m)) & 1u)) continue; const int row = row0 + ai * HALF + m * 16; const size_t off = (size_t)row * DM + col0; float ss = 0.f;
#pragma unroll
                for (int bj = 0; bj < 2; ++bj) {
                    const f32x4 v0 = xv[m][bj][0] + acc[ai][bj][m][0], v1 = xv[m][bj][1] + acc[ai][bj][m][1];
                    ss += (v0[0] * v0[0] + v0[1] * v0[1]) + (v0[2] * v0[2] + v0[3] * v0[3]) + (v1[0] * v1[0] + v1[1] * v1[1]) + (v1[2] * v1[2] + v1[3] * v1[3]);
                    u32x4 w; w.x = cvt_pk_bf16(v0[0], v0[1]); w.y = cvt_pk_bf16(v0[2], v0[3]); w.z = cvt_pk_bf16(v1[0], v1[1]); w.w = cvt_pk_bf16(v1[2], v1[3]);
                    *(u32x4*)(X1B + off + bj * HALF) = w; }
                ss += swz_xor<16>(ss); ss = half_sum(ss);
                if (fq == 0) __hip_atomic_fetch_add(rowss + row, ss, __ATOMIC_RELAXED, __HIP_MEMORY_SCOPE_AGENT); }
            asm volatile("" ::: "memory"); }
    }
};
struct EpiUp {
    bf16_t* O; const float* rowss;
    __device__ __forceinline__ void operator()(const f32x4 (&acc)[2][2][4][2], const Unit& u, int wr, int wc, int fr, int fq, unsigned rmask = 0xffu) const {
        const int row0 = u.pm * BM + wr * 64 + fr, col0 = u.pn * BM + wc * 32 + 8 * fq;
#pragma unroll
        for (int ai = 0; ai < 2; ++ai)
#pragma unroll
            for (int m = 0; m < 4; ++m) { if (!((rmask >> (ai * 4 + m)) & 1u)) continue; const int row = row0 + ai * HALF + m * 16; bf16_t* rowp = O + (size_t)row * DFF + col0;
                const float rs = __builtin_amdgcn_rsqf(rowss[row] * (1.0f / DM) + EPS);
#pragma unroll
                for (int bj = 0; bj < 2; ++bj) { f32x4 v0 = acc[ai][bj][m][0] * rs, v1 = acc[ai][bj][m][1] * rs;
#pragma unroll
                    for (int j = 0; j < 4; ++j) { v0[j] = fmaxf(v0[j], 0.f); v1[j] = fmaxf(v1[j], 0.f); }
                    v0 = v0 * v0; v1 = v1 * v1;
                    u32x4 w; w.x = cvt_pk_bf16(v0[0], v0[1]); w.y = cvt_pk_bf16(v0[2], v0[3]); w.z = cvt_pk_bf16(v1[0], v1[1]); w.w = cvt_pk_bf16(v1[2], v1[3]);
                    *(u32x4*)(rowp + bj * HALF) = w; } }
    }
};
struct EpiDown {
    const bf16_t* X1B; float* Y;
    __device__ __forceinline__ void operator()(const f32x4 (&acc)[2][2][4][2], const Unit& u, int wr, int wc, int fr, int fq, unsigned rmask = 0xffu) const {
        const int row0 = u.pm * BM + wr * 64 + fr, col0 = u.pn * BM + wc * 32 + 8 * fq;
        u32x4 xv[2][4][2];
#pragma unroll
        for (int ai = 0; ai < 2; ++ai)
#pragma unroll
            for (int m = 0; m < 4; ++m)
#pragma unroll
                for (int bj = 0; bj < 2; ++bj) if ((rmask >> (ai * 4 + m)) & 1u) xv[ai][m][bj] = *(const u32x4*)(X1B + (size_t)(row0 + ai * HALF + m * 16) * DM + col0 + bj * HALF);
#pragma unroll
        for (int ai = 0; ai < 2; ++ai)
#pragma unroll
            for (int m = 0; m < 4; ++m)
#pragma unroll
                for (int bj = 0; bj < 2; ++bj) { if (!((rmask >> (ai * 4 + m)) & 1u)) continue; const u32x4 w = xv[ai][m][bj]; float* p = Y + (size_t)(row0 + ai * HALF + m * 16) * DM + col0 + bj * HALF;
                    *(f32x4*)p = (f32x4){bf_lo(w.x), bf_hi(w.x), bf_lo(w.y), bf_hi(w.y)} + acc[ai][bj][m][0];
                    *(f32x4*)(p + 4) = (f32x4){bf_lo(w.z), bf_hi(w.z), bf_lo(w.w), bf_hi(w.w)} + acc[ai][bj][m][1]; }
    }
};
}

namespace att {
constexpr int D = 128, NW = 8, QBLK = 32, KVBLK = 64, QB = NW * QBLK;
constexpr int SHM_V = KVBLK * D * 2, SHM_K = KVBLK * D * 2;
constexpr int OFF_K = 2 * SHM_V, OFF_WS = 2 * SHM_V + 2 * SHM_K, OFF_CB = OFF_WS + NW * 64 * 4, LDS_NEED = OFF_CB + 8192 * 4;
constexpr int PO = DM;
constexpr float THR2 = 8.f * LOG2E;
typedef LAS char* lptr;
#define KSWZ(row, colB) ((row) * 256 + ((colB) ^ (((row) & 7) << 4)))
#define SBAR() __builtin_amdgcn_sched_barrier(0)
__device__ __forceinline__ int v_st(int k, int c) { const int kk = (k & ~0xC) | ((k & 4) << 1) | ((k & 8) >> 1); return ((kk >> 3) * 4 + (c >> 5)) * 512 + ((kk & 7) * 32 + (c & 31)) * 2; }
__device__ __forceinline__ int v_rd_base(int lane) { return ((lane & 3) << 3) | (((lane >> 2) & 3) << 6) | (((lane >> 4) & 1) << 5) | (((lane >> 5) & 1) << 8); }
constexpr int v_rd_off(int d0, int ks, int half) { return d0 * 512 + ks * 4096 + half * 2048; }
__device__ __forceinline__ int crow(int r, int hi) { return (r & 3) + 8 * (r >> 2) + 4 * hi; }
__device__ __forceinline__ bf16x8 load8(const bf16_t* p) { return *reinterpret_cast<const bf16x8*>(p); }
__device__ __forceinline__ void mask_tile(f32x16& p0, f32x16& p1, int dq) {
    const float NEG = -__builtin_inff();
#pragma unroll
    for (int r = 0; r < 16; ++r) { const int c = (r & 3) + 8 * (r >> 2);
        if (dq - c < 0) p0[r] = NEG;
        if (dq - c - 32 < 0) p1[r] = NEG; }
}
__device__ __forceinline__ void partialSM(f32x16& p0, f32x16& p1, float& m_reg, float& mn, float& alpha) {
    float pmax = p0[0];
#pragma unroll
    for (int r = 1; r < 16; ++r) pmax = fmaxf(pmax, p0[r]);
#pragma unroll
    for (int r = 0; r < 16; ++r) pmax = fmaxf(pmax, p1[r]);
    { auto rr = __builtin_amdgcn_permlane32_swap(__float_as_uint(pmax), __float_as_uint(pmax), false, false);
      pmax = fmaxf(__uint_as_float(rr[0]), __uint_as_float(rr[1])); }
    if (__builtin_expect(__all((pmax - m_reg) <= THR2), 1)) { mn = m_reg; alpha = 1.f; }
    else { mn = fmaxf(m_reg, pmax); alpha = __builtin_amdgcn_exp2f(m_reg - mn); m_reg = mn; }
#pragma unroll
    for (int r = 0; r < 16; ++r) p0[r] = p0[r] - mn;
#pragma unroll
    for (int r = 0; r < 16; ++r) p1[r] = p1[r] - mn;
#pragma unroll
    for (int r = 0; r < 16; ++r) p0[r] = __builtin_amdgcn_exp2f(p0[r]);
}
__device__ __forceinline__ void finishSM(f32x16& p0, f32x16& p1, float alpha, float& l_reg, bf16x8& pa0, bf16x8& pa1, bf16x8& pa2, bf16x8& pa3) {
#pragma unroll
    for (int r = 0; r < 16; ++r) p1[r] = __builtin_amdgcn_exp2f(p1[r]);
    float ps = 0;
#pragma unroll
    for (int r = 0; r < 16; ++r) ps += p0[r];
#pragma unroll
    for (int r = 0; r < 16; ++r) ps += p1[r];
    { auto rr = __builtin_amdgcn_permlane32_swap(__float_as_uint(ps), __float_as_uint(ps), false, false);
      ps = __uint_as_float(rr[0]) + __uint_as_float(rr[1]); }
    l_reg = l_reg * alpha + ps;
#define PK4(P, B_, OUT) do { unsigned a0 = cvt_pk_bf16(P[B_+0], P[B_+1]), a1 = cvt_pk_bf16(P[B_+2], P[B_+3]);                          \
        unsigned b0 = cvt_pk_bf16(P[B_+4], P[B_+5]), b1 = cvt_pk_bf16(P[B_+6], P[B_+7]);                                             \
        auto r0 = __builtin_amdgcn_permlane32_swap(a0, b0, false, false); auto r1 = __builtin_amdgcn_permlane32_swap(a1, b1, false, false); \
        u32x4 w = {r0[0], r1[0], r0[1], r1[1]}; OUT = __builtin_bit_cast(bf16x8, w); } while (0)
    PK4(p0, 0, pa0); PK4(p0, 8, pa1); PK4(p1, 0, pa2); PK4(p1, 8, pa3);
}
template <int KB>
__device__ __forceinline__ void qkt(f32x16& p0, f32x16& p1, lptr K_lds, const LAS float* cbt, int r32, int hi, const bf16x8* qr) {
#pragma unroll
    for (int i = 0; i < 4; ++i) { const f32x4 b0 = *(const LAS f32x4*)(cbt + 8 * i), b1 = *(const LAS f32x4*)(cbt + 32 + 8 * i);
        p0[4 * i] = b0[0]; p0[4 * i + 1] = b0[1]; p0[4 * i + 2] = b0[2]; p0[4 * i + 3] = b0[3];
        p1[4 * i] = b1[0]; p1[4 * i + 1] = b1[1]; p1[4 * i + 2] = b1[2]; p1[4 * i + 3] = b1[3]; }
    lptr kb[4];
#pragma unroll
    for (int dd = 0; dd < 4; ++dd) kb[dd] = K_lds + KB * SHM_K + KSWZ(r32, (dd * 16 + hi * 8) * 2);
#pragma unroll
    for (int d0 = 0; d0 < 8; ++d0) { lptr a = kb[d0 & 3] + (d0 >> 2) * 128;
        bf16x8 b0 = *reinterpret_cast<const LAS bf16x8*>(a);
        bf16x8 b1 = *reinterpret_cast<const LAS bf16x8*>(a + 32 * 256);
        p0 = __builtin_amdgcn_mfma_f32_32x32x16_bf16(b0, qr[d0], p0, 0, 0, 0);
        p1 = __builtin_amdgcn_mfma_f32_32x32x16_bf16(b1, qr[d0], p1, 0, 0, 0); }
}
template <int VB>
__device__ __forceinline__ void pv_tile(f32x16* o, int vb0, bf16x8 pa0, bf16x8 pa1, bf16x8 pa2, bf16x8 pa3) {
#define TRRD(dst, off) asm volatile("ds_read_b64_tr_b16 %0, %1 offset:%2" : "=&v"(dst) : "v"(vb0), "i"(off) : "memory")
#define PV_D0(d0) do { s16x4 l0, l1, l2, l3, h0, h1, h2, h3; constexpr int b_ = VB * SHM_V + v_rd_off(d0, 0, 0);   \
        TRRD(l0, b_); TRRD(h0, b_ + 2048); TRRD(l1, b_ + 4096); TRRD(h1, b_ + 6144); TRRD(l2, b_ + 8192); TRRD(h2, b_ + 10240); TRRD(l3, b_ + 12288); TRRD(h3, b_ + 14336); \
        asm volatile("s_waitcnt lgkmcnt(0)" ::: "memory"); SBAR();   \
        o[d0] = __builtin_amdgcn_mfma_f32_32x32x16_bf16(pa0, (bf16x8){l0[0], l0[1], l0[2], l0[3], h0[0], h0[1], h0[2], h0[3]}, o[d0], 0, 0, 0);   \
        o[d0] = __builtin_amdgcn_mfma_f32_32x32x16_bf16(pa1, (bf16x8){l1[0], l1[1], l1[2], l1[3], h1[0], h1[1], h1[2], h1[3]}, o[d0], 0, 0, 0);   \
        o[d0] = __builtin_amdgcn_mfma_f32_32x32x16_bf16(pa2, (bf16x8){l2[0], l2[1], l2[2], l2[3], h2[0], h2[1], h2[2], h2[3]}, o[d0], 0, 0, 0);   \
        o[d0] = __builtin_amdgcn_mfma_f32_32x32x16_bf16(pa3, (bf16x8){l3[0], l3[1], l3[2], l3[3], h3[0], h3[1], h3[2], h3[3]}, o[d0], 0, 0, 0); } while (0)
    PV_D0(0); PV_D0(1); PV_D0(2); PV_D0(3);
#undef PV_D0
#undef TRRD
}
struct Blk { int h, qb, jlo; };
struct Seam { bf16x8 qr[8]; bf16x8 st_v0, st_v1, st_k0, st_k1; };
#define VMW() asm volatile("s_waitcnt vmcnt(0)" ::: "memory")
#define VMWN(n) asm volatile("s_waitcnt vmcnt(%0)" :: "i"(n) : "memory")
#define SLOAD_H(hh, k0) do { const bf16_t* kt_ = PROJ + (size_t)(k0) * PP + (PW + AW) + (hh) * HD;                                         \
                         S.st_v0 = load8(kt_ + AW + toff); S.st_v1 = load8(kt_ + AW + 32 * PP + toff);                                      \
                         S.st_k0 = load8(kt_ + toff); S.st_k1 = load8(kt_ + 32 * PP + toff); } while (0)
#define QLOAD(hh, qq) do { const bf16_t* qt_ = PROJ + (size_t)((qq) * QB + wid * QBLK) * PP + PW + (hh) * HD;                                \
                         _Pragma("unroll") for (int d0 = 0; d0 < 8; ++d0) S.qr[d0] = load8(qt_ + qoff + d0 * 16); } while (0)
#define SWRITE_HK(bf) do { *(LAS bf16x8*)(K_lds + (bf) * SHM_K + kws) = S.st_k0; *(LAS bf16x8*)(K_lds + (bf) * SHM_K + kws + 32 * 256) = S.st_k1; } while (0)
#define SWRITE_HV(bf) do { *(LAS bf16x8*)(V_lds + (bf) * SHM_V + vst0) = S.st_v0; *(LAS bf16x8*)(V_lds + (bf) * SHM_V + vst1) = S.st_v1; } while (0)
#define SWRITE_H(bf) do { SWRITE_HV(bf); SWRITE_HK(bf); } while (0)
__device__ __forceinline__ void attn_prime(const Blk cur, const bf16_t* PROJ, lptr lds, Seam& S, const int wid) {
    const int lane = fresh_lane(), tid = wid * 64 + lane, r32 = lane & 31, hi = lane >> 5;
    const int sr = tid >> 4, sc = (tid & 15) * 8, kws = KSWZ(sr, sc * 2); lptr K_lds = lds + OFF_K;
    const unsigned toff = (unsigned)(sr * PP + sc), qoff = (unsigned)(r32 * PP + hi * 8);
    QLOAD(cur.h, cur.qb);
    SLOAD_H(cur.h, cur.jlo * KVBLK); VMW(); SWRITE_HK(0);
    __syncthreads();
}
__device__ __forceinline__ void attn_block(const Blk cur, const Blk nxt, const bf16_t* PROJ, bf16_t* MIX, const float* CB, lptr lds, Seam& S, const int wid) {
    const int lane = fresh_lane(), tid = wid * 64 + lane, r32 = lane & 31, hi = lane >> 5;
    const int P0 = cur.qb * QB, j_lo = cur.jlo, j_hi = (P0 + QB - 1) / KVBLK + 1;
    const int NT = j_hi - j_lo;
    const int qlo = P0 + wid * QBLK, qm = qlo + r32 - 4 * hi;
    lptr V_lds = lds; lptr K_lds = lds + OFF_K;
    LAS float* ws = (LAS float*)(lds + OFF_WS) + wid * 64; LAS float* li_l = ws; LAS float* al_l = ws + 32;
    LAS float* cb = (LAS float*)(lds + OFF_CB);
    float m_reg = -1e30f, l_reg = 0; f32x16 o[4] = {};
    const int sr = tid >> 4, sc = (tid & 15) * 8, vst0 = v_st(sr, sc), vst1 = v_st(32 + sr, sc), kws = KSWZ(sr, sc * 2);
    const unsigned toff = (unsigned)(sr * PP + sc);
    const int vb0 = (int)(unsigned)(size_t)V_lds + v_rd_base(lane);
    const int hh = cur.h;
    { const float* c2 = CB + (size_t)hh * SEQ; const float cref = c2[P0]; const float* csrc = c2 + j_lo * KVBLK;
      for (int i = tid * 4; i < NT * KVBLK; i += 2048) { const f32x4 c = *(const f32x4*)(csrc + i); *(LAS f32x4*)(cb + i) = cref - c; }
      __syncthreads(); }
    const LAS float* cbl = cb + 4 * hi;
#define RESC(a) do { if (__any((a) < 1.f)) { if (hi == 0) al_l[r32] = (a); asm volatile("s_waitcnt lgkmcnt(0)" ::: "memory");              \
                     _Pragma("unroll") for (int d_ = 0; d_ < 4; ++d_) _Pragma("unroll") for (int r = 0; r < 16; ++r) o[d_][r] *= al_l[crow(r, hi)]; } } while (0)
#define KBASE(t) ((j_lo + (t)) * KVBLK)
#define MASKT(P0_, P1_, t) do { const int kb_ = KBASE(t); if (kb_ + KVBLK - 1 > qlo) mask_tile(P0_, P1_, qm - kb_); } while (0)
#define SEAM_K0() do { VMWN(8); SWRITE_HK(0); SBAR(); } while (0)
    f32x16 pA0, pA1, pB0, pB1; float mnA, mnB, alA, alB; bf16x8 pa0, pa1, pa2, pa3;
    SWRITE_HV(0); SBAR();
    if (NT > 1) { SLOAD_H(hh, KBASE(1)); }
    SBAR(); qkt<0>(pA0, pA1, K_lds, cbl, r32, hi, S.qr);
    MASKT(pA0, pA1, 0); partialSM(pA0, pA1, m_reg, mnA, alA);
    if (NT > 1) { VMW(); SWRITE_H(1); }
    __syncthreads();
#define HALF_STEP(PX0, PX1, mnX, alX, PY0, PY1, alY, t, KB, VB, SB) do {                                                      \
        SBAR(); qkt<KB>(PX0, PX1, K_lds, cbl + (t) * KVBLK, r32, hi, S.qr);                                                   \
        finishSM(PY0, PY1, alY, l_reg, pa0, pa1, pa2, pa3); SBAR();                                                           \
        if ((t) + 1 < NT) { SLOAD_H(hh, KBASE((t) + 1)); SBAR(); }                                                            \
        pv_tile<VB>(o, vb0, pa0, pa1, pa2, pa3); MASKT(PX0, PX1, (t)); partialSM(PX0, PX1, m_reg, mnX, alX);                   \
        __syncthreads();                                                                                                      \
        if ((t) + 1 < NT) { VMW(); SWRITE_H(SB); }                                                                            \
        RESC(alX); __syncthreads(); } while (0)
    for (int t = 1; t + 1 < NT; t += 2) {
        HALF_STEP(pB0, pB1, mnB, alB, pA0, pA1, alA, t, 1, 0, 0);
        HALF_STEP(pA0, pA1, mnA, alA, pB0, pB1, alB, t + 1, 0, 1, 1);
    }
    const bool even = (NT & 1) == 0;
    const int l2_ = fresh_lane(), r32b_ = l2_ & 31, hib_ = l2_ >> 5, qmb_ = qlo + r32b_ - 4 * hib_;
    { const int r32 = r32b_, hi = hib_, qm = qmb_;
    if (even) { SBAR(); qkt<1>(pB0, pB1, K_lds, cbl + (NT - 1) * KVBLK, r32, hi, S.qr); SBAR(); }
    SLOAD_H(nxt.h, nxt.jlo * KVBLK); SBAR();
    { const unsigned qoff = (unsigned)(r32 * PP + hi * 8); QLOAD(nxt.h, nxt.qb); }
    SBAR();
    finishSM(pA0, pA1, alA, l_reg, pa0, pa1, pa2, pa3); SBAR();
    pv_tile<0>(o, vb0, pa0, pa1, pa2, pa3);
    if (even) { MASKT(pB0, pB1, NT - 1); partialSM(pB0, pB1, m_reg, mnB, alB); __syncthreads(); RESC(alB);
        finishSM(pB0, pB1, alB, l_reg, pa0, pa1, pa2, pa3); SBAR(); pv_tile<1>(o, vb0, pa0, pa1, pa2, pa3); }
    SBAR(); SEAM_K0();
    if (hi == 0) li_l[r32] = l_reg; asm volatile("s_waitcnt lgkmcnt(0)" ::: "memory");
    bf16_t* Ow = MIX + (size_t)(P0 + wid * QBLK) * PO + PW + hh * HD;
    const unsigned ooff = (unsigned)(4 * hi * PO + r32);
#pragma unroll
    for (int r = 0; r < 16; ++r) { const float rl = __builtin_amdgcn_rcpf(li_l[crow(r, hi)]);
#pragma unroll
        for (int d0 = 0; d0 < 4; ++d0) { const float v = o[d0][r] * rl;
            const float vn = swz_xor<1>(v);
            if ((r32 & 1) == 0) *(unsigned*)(Ow + ooff + (unsigned)(((r & 3) + 8 * (r >> 2)) * PO + d0 * 32)) = cvt_pk_bf16(v, vn); } }
    }
    __syncthreads();
#undef RESC
#undef KBASE
#undef MASKT
#undef SEAM_K0
#undef HALF_STEP
}
#undef QLOAD
#undef SLOAD_H
#undef SWRITE_HK
#undef SWRITE_HV
#undef SWRITE_H

constexpr int SOFF_ML = 0, SOFF_Q = 2048, SOFF_KST = 10240, KST_BYTES = 16 * 1040, SOFF_OT = SOFF_KST  , SLDS_NEED = SOFF_KST + 8 * KST_BYTES;
static_assert(SLDS_NEED <= MISC_OFF && SOFF_OT + 8 * 64 * 32 * 4 <= MISC_OFF, "sample attention LDS map");
template <bool NEWK>
__device__ __forceinline__ bool samp_chunk(const bool vlate, const float* Kc, const float* Vc, const bf16_t* Kn, const bf16_t* Vn, const float* bias, const LAS char* qlds, LAS char* kst, int lane,
                                           float& m_reg, float& l_reg, f32x16* oT, int r32, int hi) {
    f32x4 kr[16]; float vr[2][4][8]; bf16x8 kf[8]; short vn[2][4][8];
    if constexpr (NEWK) {
#pragma unroll
        for (int d0 = 0; d0 < 8; ++d0) kf[d0] = load8(Kn + (size_t)r32 * PP + d0 * 16 + hi * 8);
#pragma unroll
        for (int ks = 0; ks < 2; ++ks)
#pragma unroll
            for (int d0 = 0; d0 < 4; ++d0)
#pragma unroll
                for (int j = 0; j < 8; ++j) vn[ks][d0][j] = (short)Vn[(size_t)(16 * ks + 8 * hi + j) * PP + 32 * d0 + r32];
    } else {
        const float* kp = Kc + (size_t)(lane >> 5) * (NH * HD) + 4 * (lane & 31);
#pragma unroll
        for (int i = 0; i < 16; ++i) kr[i] = __builtin_nontemporal_load((const f32x4*)(kp + (size_t)(2 * i) * (NH * HD)));
        if (!vlate) {
            const float* vp = Vc + (size_t)(8 * hi) * (NH * HD) + r32;
#pragma unroll
            for (int ks = 0; ks < 2; ++ks)
#pragma unroll
                for (int d0 = 0; d0 < 4; ++d0)
#pragma unroll
                    for (int j = 0; j < 8; ++j) vr[ks][d0][j] = __builtin_nontemporal_load(vp + (size_t)(16 * ks + j) * (NH * HD) + 32 * d0);
        }
    }
    asm volatile("" ::: "memory");
    f32x16 s;
#pragma unroll
    for (int i = 0; i < 4; ++i) { const f32x4 b = *(const f32x4*)(bias + 8 * i + 4 * hi); s[4 * i] = b[0]; s[4 * i + 1] = b[1]; s[4 * i + 2] = b[2]; s[4 * i + 3] = b[3]; }
    if constexpr (!NEWK) {
#pragma unroll
        for (int i = 0; i < 16; ++i) *(LAS f32x4*)(kst + i * 1040 + lane * 16) = kr[i];
        const LAS char* kf_src = kst + (r32 >> 1) * 1040 + (r32 & 1) * 512 + hi * 32;
#pragma unroll
        for (int hf = 0; hf < 2; ++hf) {
            bf16x8 kh[4];
#pragma unroll
            for (int d = 0; d < 4; ++d) kh[d] = pack8(*(const LAS f32x4*)(kf_src + (4 * hf + d) * 64), *(const LAS f32x4*)(kf_src + (4 * hf + d) * 64 + 16));
#pragma unroll
            for (int d = 0; d < 4; ++d) s = __builtin_amdgcn_mfma_f32_32x32x16_bf16(kh[d], *(const LAS bf16x8*)(qlds + (4 * hf + d) * 1024), s, 0, 0, 0);
            asm volatile("" ::: "memory"); }
    } else {
#pragma unroll
        for (int d0 = 0; d0 < 8; ++d0) s = __builtin_amdgcn_mfma_f32_32x32x16_bf16(kf[d0], *(const LAS bf16x8*)(qlds + d0 * 1024), s, 0, 0, 0);
    }
    if constexpr (NEWK) {
        const float NEG = -__builtin_inff();
#pragma unroll
        for (int r = 0; r < 16; ++r) if (crow(r, hi) > r32) s[r] = NEG;
    }
    float pmax = s[0];
#pragma unroll
    for (int r = 1; r < 16; ++r) pmax = fmaxf(pmax, s[r]);
    { auto rr = __builtin_amdgcn_permlane32_swap(__float_as_uint(pmax), __float_as_uint(pmax), false, false); pmax = fmaxf(__uint_as_float(rr[0]), __uint_as_float(rr[1])); }
    const float mn = fmaxf(m_reg, pmax), alpha = __builtin_amdgcn_exp2f(m_reg - mn); m_reg = mn;
    float ps = 0.f;
#pragma unroll
    for (int r = 0; r < 16; ++r) { s[r] = __builtin_amdgcn_exp2f(s[r] - mn); ps += s[r]; }
    { auto rr = __builtin_amdgcn_permlane32_swap(__float_as_uint(ps), __float_as_uint(ps), false, false); ps = __uint_as_float(rr[0]) + __uint_as_float(rr[1]); }
    l_reg = l_reg * alpha + ps;
    if (__any(alpha < 1.f)) {
#pragma unroll
        for (int d0 = 0; d0 < 4; ++d0) oT[d0] = oT[d0] * alpha;
    }
    const bool allzero = __all(ps == 0.f);
    if constexpr (!NEWK) {
        if (allzero) return true;
        if (vlate) {
            const float* vp = Vc + (size_t)(8 * hi) * (NH * HD) + r32;
#pragma unroll
            for (int ks = 0; ks < 2; ++ks)
#pragma unroll
                for (int d0 = 0; d0 < 4; ++d0)
#pragma unroll
                    for (int j = 0; j < 8; ++j) vr[ks][d0][j] = __builtin_nontemporal_load(vp + (size_t)(16 * ks + j) * (NH * HD) + 32 * d0);
        }
    }
    bf16x8 pa0, pa1; PK4(s, 0, pa0); PK4(s, 8, pa1);
#pragma unroll
    for (int ks = 0; ks < 2; ++ks) {
#pragma unroll
        for (int d0 = 0; d0 < 4; ++d0) {
            bf16x8 vf;
            if constexpr (NEWK) { const short* e = vn[ks][d0]; vf = (bf16x8){e[0], e[1], e[2], e[3], e[4], e[5], e[6], e[7]}; }
            else { const float* e = vr[ks][d0]; vf = pack8((f32x4){e[0], e[1], e[2], e[3]}, (f32x4){e[4], e[5], e[6], e[7]}); }
            oT[d0] = __builtin_amdgcn_mfma_f32_32x32x16_bf16(vf, ks == 0 ? pa0 : pa1, oT[d0], 0, 0, 0);
        }
    }
    return allzero;
}
#undef PK4
__device__ __forceinline__ void samp_unit(int b, int h, const bf16_t* PROJ, const float* cache_k, const float* cache_v, const float* CS, bf16_t* MIX, lptr lds, const int wid) {
    const int lane = fresh_lane(), tid = wid * 64 + lane, r32 = lane & 31, hi = lane >> 5;
    const bf16_t* Qp = PROJ + (size_t)(MP + b * DS) * PP + PW + h * HD;
    const bf16_t* Kn = PROJ + (size_t)(MP + b * DS) * PP + PW + AW + h * HD;
    const bf16_t* Vn = PROJ + (size_t)(MP + b * DS) * PP + PW + 2 * AW + h * HD;
    const float* bias = CS + (size_t)(b * NH + h) * 2080;
    { const bf16x8 q = load8(Qp + (size_t)r32 * PP + wid * 16 + hi * 8); *(LAS bf16x8*)(lds + SOFF_Q + wid * 1024 + lane * 16) = q; }
    asm volatile("s_waitcnt lgkmcnt(0)" ::: "memory"); __syncthreads();
    const LAS char* qlds = lds + SOFF_Q + lane * 16; LAS char* kst = lds + SOFF_KST + wid * KST_BYTES;
    float m_reg;
    { const bf16_t* qrow = Qp + (size_t)r32 * PP + hi * 64; const bf16_t* krow = Kn + (size_t)r32 * PP + hi * 64; float dsum = 0.f;
#pragma unroll
      for (int j = 0; j < 8; ++j) { const u32x4 qa = *(const u32x4*)(qrow + 8 * j), ka = *(const u32x4*)(krow + 8 * j);
#pragma unroll
          for (int e = 0; e < 4; ++e) dsum += bf_lo(qa[e]) * bf_lo(ka[e]) + bf_hi(qa[e]) * bf_hi(ka[e]); }
      m_reg = half_sum(dsum) + bias[PAST + r32] - 1.0f; }
    float l_reg = 0.f; f32x16 oT[4] = {};
    if (wid == 7) samp_chunk<true>(false, nullptr, nullptr, Kn, Vn, bias + PAST, qlds, kst, lane, m_reg, l_reg, oT, r32, hi);
    bool vlate = false;
    size_t koff = ((size_t)(b * PAST + wid * 32 + 7 * 256) * NH + h) * HD; const float* bp = bias + wid * 32 + 7 * 256;
#pragma unroll 1
    for (int c = 7; c >= 0; --c) {
        vlate = samp_chunk<false>(vlate, cache_k + koff, cache_v + koff, nullptr, nullptr, bp, qlds, kst, lane, m_reg, l_reg, oT, r32, hi) || vlate;
        koff -= (size_t)256 * NH * HD; bp -= 256; }
    LAS float* ML = (LAS float*)(lds + SOFF_ML); LAS float* OT = (LAS float*)(lds + SOFF_OT);
    if (hi == 0) { ML[(wid * 32 + r32) * 2] = m_reg; ML[(wid * 32 + r32) * 2 + 1] = l_reg; }
    __syncthreads();
    float Mx = -1e30f;
#pragma unroll
    for (int w = 0; w < 8; ++w) Mx = fmaxf(Mx, ML[(w * 32 + r32) * 2]);
    float L = 0.f;
#pragma unroll
    for (int w = 0; w < 8; ++w) L += ML[(w * 32 + r32) * 2 + 1] * __builtin_amdgcn_exp2f(ML[(w * 32 + r32) * 2] - Mx);
    const float f = __builtin_amdgcn_exp2f(m_reg - Mx) / L;
#pragma unroll
    for (int half = 0; half < 2; ++half) {
#pragma unroll
        for (int dd = 0; dd < 2; ++dd)
#pragma unroll
            for (int r = 0; r < 16; ++r) OT[(wid * 64 + dd * 32 + crow(r, hi)) * 32 + r32] = oT[half * 2 + dd][r] * f;
        __syncthreads();
        float acc4[4] = {0.f, 0.f, 0.f, 0.f};
#pragma unroll
        for (int w = 0; w < 8; ++w)
#pragma unroll
            for (int j = 0; j < 4; ++j) acc4[j] += OT[(w * 64 + 8 * wid + 4 * hi + j) * 32 + r32];
        u32x2 o2; o2.x = cvt_pk_bf16(acc4[0], acc4[1]); o2.y = cvt_pk_bf16(acc4[2], acc4[3]);
        *(u32x2*)(MIX + (size_t)(MP + b * DS + r32) * DM + PW + h * HD + half * 64 + 8 * wid + 4 * hi) = o2;
        __syncthreads();
    }
}
}

#define XB_TMO      128
#define XB_XCNT(j)  (256  + 64 * (j))
#define XB_XSUB(j)  (1280 + 64 * (j))
#define XB_XGEN(j)  (2304 + 64 * (j))
#define XB_TOP      3328
#define XB_TOPGEN   3392
#define XCD_BAR_WORDS 3456
#define XB_SPIN_CAP (1u << 22)
__device__ __forceinline__ unsigned xb_ld(unsigned* p)              { return __hip_atomic_load(p, __ATOMIC_RELAXED, __HIP_MEMORY_SCOPE_AGENT); }
__device__ __forceinline__ unsigned xb_add(unsigned* p, unsigned v) { return __hip_atomic_fetch_add(p, v, __ATOMIC_RELAXED, __HIP_MEMORY_SCOPE_AGENT); }
__device__ __forceinline__ unsigned xb_xcc_id() { return (unsigned)__builtin_amdgcn_s_getreg((3 << 11) | 20) & 0xFu; }
#define XB_SPIN(cond, bar) do { unsigned _sp = 0; while (cond) { __builtin_amdgcn_s_sleep(1); \
    if ((++_sp & 255u) == 0u) { if (xb_ld(&(bar)[XB_TMO])) break; if (_sp > XB_SPIN_CAP) { atomicAdd(&(bar)[XB_TMO], 1u); break; } } } } while (0)
struct XcdBarrier { unsigned* bar; unsigned x; volatile LAS unsigned* st; };
__device__ __forceinline__ XcdBarrier xcd_barrier_post(unsigned* bar, volatile LAS unsigned* st, bool leader) {
    XcdBarrier b; b.bar = bar; b.x = xb_xcc_id(); b.st = st;
    if (leader) (void)xb_add(&bar[XB_XCNT(b.x)], 1u);
    return b;
}
__device__ __forceinline__ void xcd_barrier_complete(unsigned* bar, unsigned x, unsigned& nloc, unsigned& nx) {
    const unsigned G = gridDim.x * gridDim.y * gridDim.z;
    unsigned sum, cnt, mine, sp = 0u;
    for (;;) {
        sum = 0u; cnt = 0u; mine = 0u;
#pragma unroll
        for (unsigned j = 0; j < 16; ++j) { const unsigned c = xb_ld(&bar[XB_XCNT(j)]); sum += c; cnt += (c > 0u) ? 1u : 0u; mine = (j == x) ? c : mine; }
        if (sum == G) break;
        __builtin_amdgcn_s_sleep(1);
        if ((++sp & 255u) == 0u) { if (xb_ld(&bar[XB_TMO])) break; if (sp > XB_SPIN_CAP) { atomicAdd(&bar[XB_TMO], 1u); break; } }
    }
    nloc = mine > 0u ? mine : 1u; nx = cnt > 0u ? cnt : 1u;
}
__device__ __forceinline__ void xcd_barrier(const XcdBarrier& b, bool leader) {
    asm volatile("s_waitcnt vmcnt(0)" ::: "memory");
    __syncthreads();
    if (leader) {
        unsigned* bar = b.bar;
        __builtin_amdgcn_s_waitcnt(0);
        unsigned nloc = b.st[0], nx = b.st[1];
        if (nloc == 0u) { xcd_barrier_complete(bar, b.x, nloc, nx); b.st[0] = nloc; b.st[1] = nx; }
        const unsigned old = xb_add(&bar[XB_XSUB(b.x)], 1u);
        const unsigned gen = old / nloc;
        if (old + 1u == (gen + 1u) * nloc) {
            __builtin_amdgcn_fence(__ATOMIC_RELEASE, "agent");
            asm volatile("s_waitcnt vmcnt(0)" ::: "memory");
            const unsigned og = xb_add(&bar[XB_TOP], 1u);
            const unsigned tg = og / nx;
            if (og + 1u == (tg + 1u) * nx) xb_add(&bar[XB_TOPGEN], 1u);
            else XB_SPIN(xb_ld(&bar[XB_TOPGEN]) == tg, bar);
            __builtin_amdgcn_fence(__ATOMIC_ACQUIRE, "agent");
            xb_add(&bar[XB_XGEN(b.x)], 1u);
            asm volatile("s_waitcnt vmcnt(0)" ::: "memory");
        } else {
            XB_SPIN(xb_ld(&bar[XB_XGEN(b.x)]) == gen, bar);
            __builtin_amdgcn_fence(__ATOMIC_ACQUIRE, "agent");
            asm volatile("s_waitcnt vmcnt(0)" ::: "memory");
        }
    }
    __syncthreads();
}

#ifndef PHASES
#define PHASES 0xfff
#endif
#ifndef TPROBE
#define TPROBE 0
#endif
#ifndef PROBE
#define PROBE 0
#endif
#define REPS(id) for (int rep_ = 0; rep_ < ((PROBE == (id)) ? 2 : 1); ++rep_)
struct Args {
    const float *x_prompt, *x_sample, *cache_k, *cache_v, *cache_logf, *state_pool, *attn_norm_g, *w_in, *b_f, *q_norm_g, *k_norm_g, *w_pool, *pool_scale, *w_out, *mlp_norm_g, *w_up, *w_down;
    float* out; unsigned char* ws;
};
__device__ __forceinline__ float wave_sum(float v) { v += swz_xor<1>(v); v += swz_xor<2>(v); v += swz_xor<4>(v); v += swz_xor<8>(v); v += swz_xor<16>(v); return half_sum(v); }
__device__ __forceinline__ float wave_max(float v) { v = fmaxf(v, swz_xor<1>(v)); v = fmaxf(v, swz_xor<2>(v)); v = fmaxf(v, swz_xor<4>(v)); v = fmaxf(v, swz_xor<8>(v)); v = fmaxf(v, swz_xor<16>(v)); return half_max(v); }
constexpr int TR_LDS = 64 * 33 * 4;
struct TrTile { const float* W; bf16_t* WT; const float* kscale; int K, N, kb, nb; };
__device__ __forceinline__ void tr_load(const TrTile& t, int lane, f32x4 (&ra)[8], f32x4 (&rb)[8]) {
    const int k0 = 64 * t.kb, n0 = 64 * t.nb, kq = lane >> 4, n4 = lane & 15;
    const bool okc = n0 + 4 * n4 < t.N;
    const float* src = t.W + (size_t)(k0 + 2 * kq) * t.N + n0 + 4 * n4;
#pragma unroll
    for (int j = 0; j < 8; ++j) {
        ra[j] = okc ? __builtin_nontemporal_load((const f32x4*)(src + (size_t)(8 * j) * t.N)) : (f32x4){0.f, 0.f, 0.f, 0.f};
        rb[j] = okc ? __builtin_nontemporal_load((const f32x4*)(src + (size_t)(8 * j + 1) * t.N)) : (f32x4){0.f, 0.f, 0.f, 0.f}; }
}
__device__ __forceinline__ void tr_store(const TrTile& t, int lane, const f32x4 (&ra)[8], const f32x4 (&rb)[8], LAS unsigned* scr) {
    const int k0 = 64 * t.kb, n0 = 64 * t.nb, kq = lane >> 4, n4 = lane & 15;
#pragma unroll
    for (int j = 0; j < 8; ++j) { const f32x2 gg = t.kscale ? *(const f32x2*)(t.kscale + k0 + 8 * j + 2 * kq) : (f32x2){1.f, 1.f};
#pragma unroll
        for (int e = 0; e < 4; ++e) scr[(4 * n4 + e) * 33 + 4 * j + kq] = cvt_pk_bf16(ra[j][e] * gg.x, rb[j][e] * gg.y); }
    const int c = lane & 7;
#pragma unroll
    for (int i = 0; i < 8; ++i) { const int n = (lane >> 3) + 8 * i; const LAS unsigned* p = scr + n * 33 + 4 * c;
        u32x4 o; o.x = p[0]; o.y = p[1]; o.z = p[2]; o.w = p[3];
        if (n0 + n < t.N) __builtin_nontemporal_store(o, (u32x4*)(t.WT + (size_t)(n0 + n) * t.K + k0 + 8 * c)); }
}
template <class F> __device__ __forceinline__ void transpose_stream(F tile_of, int first, int stride, int total, LAS unsigned* scr, int lane) {
    if (first >= total) return;
    f32x4 ra[8], rb[8], na[8], nb[8];
    TrTile ta = tile_of(first), tb = ta; tr_load(ta, lane, ra, rb);
    bool hb = first + stride < total; if (hb) { tb = tile_of(first + stride); tr_load(tb, lane, na, nb); }
    for (int it = first + 2 * stride;; it += 2 * stride) {
        tr_store(ta, lane, ra, rb, scr);
        const bool ha = it < total; if (ha) { ta = tile_of(it); tr_load(ta, lane, ra, rb); }
        if (hb) tr_store(tb, lane, na, nb, scr);
        if (!ha) break;
        hb = it + stride < total; if (hb) { tb = tile_of(it + stride); tr_load(tb, lane, na, nb); }
    }
}

template <int W>
__device__ __forceinline__ void pool_task16(const bf16_t* PROJ, const float* state_pool, bf16_t* DP, int r0, int g, int lane) {
    const bool samp = r0 >= MP; const int b = samp ? (r0 - MP) / DS : 0, s0 = samp ? (r0 - MP) % DS : r0;
    const int col = g * PG + 8 * lane;
    u32x4 R[W + 15];
#pragma unroll
    for (int i = 0; i < W + 15; ++i) { const int se = s0 - (W - 1) + i;
        if (se >= 0) R[i] = *(const u32x4*)(PROJ + (size_t)(r0 - (W - 1) + i) * PP + col);
        else if (samp) { const float* sp = state_pool + ((size_t)b * PH + (PH + se)) * PW + col; const f32x4 x0 = *(const f32x4*)sp, x1 = *(const f32x4*)(sp + 4);
            R[i] = (u32x4){cvt_pk_bf16(x0[0], x0[1]), cvt_pk_bf16(x0[2], x0[3]), cvt_pk_bf16(x1[0], x1[1]), cvt_pk_bf16(x1[2], x1[3])}; }
        else R[i] = (u32x4){0u, 0u, 0u, 0u}; }
    float Sx[8];
#pragma unroll
    for (int i = 0; i < 8; ++i) Sx[i] = 0.f;
#pragma unroll
    for (int i = 0; i < W - 1; ++i)
#pragma unroll
        for (int c = 0; c < 4; ++c) { Sx[2 * c] += bf_lo(R[i][c]); Sx[2 * c + 1] += bf_hi(R[i][c]); }
#pragma unroll
    for (int e = 0; e < 16; ++e) {
        float cur[8], d[8];
#pragma unroll
        for (int c = 0; c < 4; ++c) { cur[2 * c] = bf_lo(R[W - 1 + e][c]); cur[2 * c + 1] = bf_hi(R[W - 1 + e][c]); }
#pragma unroll
        for (int i = 0; i < 8; ++i) Sx[i] += cur[i];
        float ic = 1.0f / (float)W; if (!samp && s0 + e + 1 < W) ic = 1.0f / (float)(s0 + e + 1);
#pragma unroll
        for (int i = 0; i < 8; ++i) d[i] = Sx[i] * ic - cur[i];
        u32x4 o; o.x = cvt_pk_bf16(d[0], d[1]); o.y = cvt_pk_bf16(d[2], d[3]); o.z = cvt_pk_bf16(d[4], d[5]); o.w = cvt_pk_bf16(d[6], d[7]);
        *(u32x4*)(DP + (size_t)(r0 + e) * PW + col) = o;
#pragma unroll
        for (int c = 0; c < 4; ++c) { Sx[2 * c] -= bf_lo(R[e][c]); Sx[2 * c + 1] -= bf_hi(R[e][c]); }
    }
}
__device__ __forceinline__ float log_sigmoid(float x) { return fminf(x, 0.f) - log1pf(__expf(-fabsf(x))); }

typedef const __attribute__((address_space(4))) Args* ArgP;
__device__ __forceinline__ ArgP argp() { ArgP p = (ArgP)__builtin_amdgcn_kernarg_segment_ptr(); asm volatile("" : "+s"(p)); return p; }
__global__ void __launch_bounds__(512, 2) hymba_fwd(Args a) {
    extern __shared__ __attribute__((aligned(16))) unsigned char lds_raw[];
    LAS unsigned char* lds = (LAS unsigned char*)lds_raw;
    volatile LAS unsigned* MISC = (volatile LAS unsigned*)(lds + MISC_OFF);
    const int wave = __builtin_amdgcn_readfirstlane((int)threadIdx.x >> 6);
    const int G = gridDim.x; const int bx = blockIdx.x; const int vcu = (G % 8 == 0) ? (bx % 8) * (G / 8) + bx / 8 : bx;
    ArgP AP = argp();
    unsigned char* ws = AP->ws;
    unsigned* ctl = (unsigned*)(ws + WS_CTL);
    bf16_t* WI = (bf16_t*)(ws + WS_WI); bf16_t* WP = (bf16_t*)(ws + WS_WP); bf16_t* WO = (bf16_t*)(ws + WS_WO); bf16_t* WU = (bf16_t*)(ws + WS_WU); bf16_t* WD = (bf16_t*)(ws + WS_WD);
    bf16_t* XN = (bf16_t*)(ws + WS_XN); bf16_t* PROJ = (bf16_t*)(ws + WS_PROJ); float* FL = (float*)(ws + WS_FL); float* CB = (float*)(ws + WS_CB); float* CS = (float*)(ws + WS_CS);
    bf16_t* DP = (bf16_t*)(ws + WS_DP); bf16_t* MIX = (bf16_t*)(ws + WS_MIX); bf16_t* X1G = (bf16_t*)(ws + WS_X1G); bf16_t* HID = (bf16_t*)(ws + WS_HID); float* PART = (float*)(ws + WS_PART);
    int* JLO = (int*)(ctl + CW_JLO); float* RSS = (float*)(ctl + CW_RSS);
    float* out = AP->out;
    for (int u = wave * 64 + fresh_lane(); u < (LDS_BYTES - 131072) / 4; u += 512) ((LAS unsigned*)(lds + 131072))[u] = 0u;
    __syncthreads();
    XcdBarrier bar = xcd_barrier_post(ctl + CW_BAR, MISC + 8, wave == 0 && fresh_lane() == 0);
    const int gw = vcu * 8 + wave, NGW = G * 8;
    if (TPROBE != 0 && wave == 0 && fresh_lane() == 0) { volatile LAS unsigned long long* stw = (volatile LAS unsigned long long*)(lds + 143424); stw[16] = (unsigned long long)wall_clock64(); }

    AP = argp();
    REPS(1) {
        const int lane = fresh_lane();
        LAS unsigned* scr = (LAS unsigned*)(lds + wave * TR_LDS);
        constexpr int NB_I = (NPROJ + 63) / 64, I_I = (DM / 64) * NB_I, I_P = 4 * (PG / 64) * (PG / 64), I_O = (DM / 64) * (DM / 64);
        constexpr int NITEMS = I_I + I_P + I_O;
        transpose_stream([&](int it) { TrTile t; int r = it;
            t.kscale = nullptr;
            if (r < I_I) { t.W = AP->w_in; t.WT = WI; t.K = DM; t.N = NPROJ; t.kb = r / NB_I; t.nb = r % NB_I; return t; } r -= I_I;
            if (r < I_P) { const int g = r / ((PG / 64) * (PG / 64)), q = r % ((PG / 64) * (PG / 64)); t.W = AP->w_pool + (size_t)g * PG * PG; t.WT = WP + (size_t)g * PG * PG; t.K = PG; t.N = PG; t.kb = q / (PG / 64); t.nb = q % (PG / 64); return t; } r -= I_P;
            t.W = AP->w_out; t.WT = WO; t.K = DM; t.N = DM; t.kb = r / (DM / 64); t.nb = r % (DM / 64); return t; }, gw, NGW, NITEMS, scr, lane);
        for (int m = gw + ((NITEMS - gw + NGW - 1) / NGW) * NGW - NITEMS; m < M; m += NGW) {
            const float* xrow = (m < MP) ? AP->x_prompt + (size_t)m * DM : AP->x_sample + (size_t)(m - MP) * DM;
            f32x4 v[16]; float s = 0.f;
#pragma unroll
            for (int j = 0; j < 16; ++j) { v[j] = *(const f32x4*)(xrow + 256 * j + 4 * lane); s += (v[j][0] * v[j][0] + v[j][1] * v[j][1]) + (v[j][2] * v[j][2] + v[j][3] * v[j][3]); }
            const float rstd = __builtin_amdgcn_rsqf(wave_sum(s) * (1.0f / DM) + EPS);
#pragma unroll
            for (int j = 0; j < 16; ++j) { const f32x4 gg = *(const f32x4*)(AP->attn_norm_g + 256 * j + 4 * lane); const f32x4 y = v[j] * rstd * gg;
                u32x2 o; o.x = cvt_pk_bf16(y[0], y[1]); o.y = cvt_pk_bf16(y[2], y[3]); *(u32x2*)(XN + (size_t)m * DM + 256 * j + 4 * lane) = o; }
        }
    }
    xcd_barrier(bar, wave == 0 && fresh_lane() == 0);
    if (TPROBE != 0 && wave == 0 && fresh_lane() == 0) { volatile LAS unsigned long long* stw = (volatile LAS unsigned long long*)(lds + 143424); stw[16 + 1] = (unsigned long long)wall_clock64(); }

    AP = argp();
    REPS(2) {
        {
            const int lane = fresh_lane(), fr = lane & 15, fq = lane >> 4;
            for (int t = gw; t < (M / 16) * 4; t += NGW) {
                const int rg = t >> 2, kq = t & 3;
                const bf16_t* xa = XN + (size_t)(rg * 16 + fr) * DM + kq * 1024 + 8 * fq;
                const bf16_t* wb = WI + (size_t)(PW + 3 * AW + fr) * DM + kq * 1024 + 8 * fq;
                f32x4 acc = {0.f, 0.f, 0.f, 0.f};
#pragma unroll 16
                for (int k = 0; k < 32; ++k) { const bf16x8 xv = *(const bf16x8*)(xa + 32 * k), wv = *(const bf16x8*)(wb + 32 * k);
                    acc = __builtin_amdgcn_mfma_f32_16x16x32_bf16(wv, xv, acc, 0, 0, 0); }
                *(f32x4*)(FL + ((size_t)kq * M + rg * 16 + fr) * NH + 4 * fq) = acc;
            }
        }
        pg8::Gemm g{XN, WI, M, PP, DM, DM, 1 << 30}; pg8::SplitOrder S; S.init(M, PP, DM, G, bx, PART, ctl + CW_SPLIT + (0 + 4 * rep_) * 8192); if (S.r && S.nfull == 32 * S.nN && (S.nN & 15) == 0) S.mode = 1;
        pg8::EpiProj E{PROJ};
        const int ncls = (S.r && G == 256) ? S.nfull / G + 1 : 1, cls = (bx >> 3) % ncls;
#pragma unroll 1
        for (int seg = 0; seg < 2; ++seg) {
            S.ibeg = seg == 0 ? 0 : cls; S.iend = seg == 0 ? cls : (1 << 30);
            pg8::gemm_phase<pg8::EpiProj, pg8::SplitOrder>(lds, g, S, E, wave, seg == 1);
            if (seg == 0) {
                const int lane = fresh_lane(); LAS unsigned* scr = (LAS unsigned*)(lds + wave * TR_LDS);
                constexpr int I_U = (DM / 64) * (DFF / 64), I_D = (DFF / 64) * (DM / 64);
                transpose_stream([&](int it) { TrTile t;
                    t.kscale = nullptr;
                    if (it < I_U) { const int x = it % (DFF / 64); t.kscale = AP->mlp_norm_g; t.W = AP->w_up; t.WT = WU; t.K = DM; t.N = DFF; t.kb = it / (DFF / 64); t.nb = ((x & 7) << 5) | (x >> 3); }
                    else { const int r = it - I_U, x = r % (DM / 64); t.W = AP->w_down; t.WT = WD; t.K = DFF; t.N = DM; t.kb = r / (DM / 64); t.nb = ((x & 7) << 3) | (x >> 3); }
                    return t; }, gw, NGW, I_U + I_D, scr, lane);
                asm volatile("s_waitcnt vmcnt(0) lgkmcnt(0)" ::: "memory"); __syncthreads();
            }
        }
    }
    xcd_barrier(bar, wave == 0 && fresh_lane() == 0);
    if (TPROBE != 0 && wave == 0 && fresh_lane() == 0) { volatile LAS unsigned long long* stw = (volatile LAS unsigned long long*)(lds + 143424); stw[16 + 2] = (unsigned long long)wall_clock64(); }

    AP = argp();
    {
        const int lane = fresh_lane(), tid = wave * 64 + lane;
        const bool solo = G >= 64;
        const bool worker = !(solo && vcu < 32);
        const int gw2 = solo ? (vcu - 32) * 8 + wave : gw, NGW2 = solo ? (G - 32) * 8 : NGW;
#define FLS(i) ((FL[(i)] + FL[(size_t)M * NH + (i)]) + (FL[(size_t)2 * M * NH + (i)] + FL[(size_t)3 * M * NH + (i)]))
        if (vcu < 16) {
            const int h = vcu; LAS float* cl = (LAS float*)lds; LAS double* tot = (LAS double*)(lds + 65536);
            const float bf = AP->b_f[h]; float lf[16]; double run = 0.0;
#pragma unroll
            for (int j = 0; j < 16; ++j) lf[j] = log_sigmoid(FLS((size_t)(tid * 16 + j) * NH + h) + bf);
#pragma unroll
            for (int j = 0; j < 16; ++j) { out[O_FP + (size_t)(tid * 16 + j) * NH + h] = lf[j]; run += (double)lf[j]; }
            tot[tid] = run; __syncthreads();
            LAS double* wtot = tot + 512;
            if (tid < 8) { double s = 0.0; for (int i = 0; i < 64; ++i) s += tot[tid * 64 + i]; wtot[tid] = s; }
            __syncthreads();
            double c = 0.0; for (int w = 0; w < wave; ++w) c += wtot[w];
            for (int l = 0; l < lane; ++l) c += tot[wave * 64 + l];
#pragma unroll
            for (int j = 0; j < 16; ++j) { c += (double)lf[j]; cl[tid * 16 + j] = (float)c; CB[(size_t)h * SEQ + tid * 16 + j] = (float)(c * (double)LOG2E); }
            __syncthreads();
            if (tid < 64) {
                float gq = fmaxf(fabsf(AP->q_norm_g[tid]), fabsf(AP->q_norm_g[tid + 64])), gk = fmaxf(fabsf(AP->k_norm_g[tid]), fabsf(AP->k_norm_g[tid + 64]));
                gq = wave_max(gq); gk = wave_max(gk);
                const float U = 11.3137085f * gq * gk; const float thr = -(2.f * U + PRUNE_T);
                if (tid < 32) { const int qb = tid; const float cP = cl[qb * 256]; int j = 0; while (j < 4 * qb && (cP - cl[64 * j + 63]) < thr) ++j; JLO[h * 32 + qb] = j; }
            }
            __syncthreads();
        } else if (vcu < 32) {
            const int b = vcu - 16, h = tid & 15, seg = tid >> 4; LAS double* tot = (LAS double*)(lds + 65536);
            const float* lsrc = AP->cache_logf + ((size_t)b * PAST + seg * 64) * NH + h;
            double run = 0.0;
#pragma unroll 16
            for (int j = 0; j < 64; ++j) run += (double)lsrc[(size_t)j * NH];
            tot[tid] = run; __syncthreads();
            double c = 0.0; for (int s = 0; s < seg; ++s) c += tot[s * 16 + h];
            double ctot = 0.0; for (int s = 0; s < 32; ++s) ctot += tot[s * 16 + h];
            const float bf = AP->b_f[h];
            LAS float* lnew = (LAS float*)(lds + 65536 + 8192);
            const float lmine = log_sigmoid(FLS((size_t)(MP + b * DS + seg) * NH + h) + bf);
            out[O_FS + (size_t)(b * DS + seg) * NH + h] = lmine; lnew[seg * 16 + h] = lmine;
            __syncthreads();
            const double cref = ctot + (double)lnew[h];
            float* csd = CS + (size_t)(b * NH + h) * 2080;
#pragma unroll 16
            for (int j = 0; j < 64; ++j) { c += (double)lsrc[(size_t)j * NH]; csd[seg * 64 + j] = (float)((cref - c) * (double)LOG2E); }
            { double cn = ctot; for (int s = 0; s <= seg; ++s) cn += (double)lnew[s * 16 + h]; csd[PAST + seg] = (float)((cref - cn) * (double)LOG2E); }
            __syncthreads();
        }
#undef FLS
        if (worker) {
        for (int m = gw2; m < M; m += NGW2) {
            bf16_t* pr = PROJ + (size_t)m * PP + PW + 8 * lane;
            float* ko = ((m < MP) ? out + O_KP + (size_t)m * AW : out + O_KS + (size_t)(m - MP) * AW) + 8 * lane;
            float* vo = ((m < MP) ? out + O_VP + (size_t)m * AW : out + O_VS + (size_t)(m - MP) * AW) + 8 * lane;
            const int dofs = 8 * (lane & 15);
            u32x4 w4[3][4];
#pragma unroll
            for (int which = 0; which < 3; ++which)
#pragma unroll
                for (int j = 0; j < 4; ++j) w4[which][j] = *(const u32x4*)(pr + which * AW + 512 * j);
#pragma unroll
            for (int which = 0; which < 2; ++which) {
                const float* gsrc = (which == 0 ? AP->q_norm_g : AP->k_norm_g) + dofs; const f32x4 g0 = *(const f32x4*)gsrc, g1 = *(const f32x4*)(gsrc + 4);
#pragma unroll
                for (int j = 0; j < 4; ++j) { float v[8];
#pragma unroll
                    for (int e = 0; e < 4; ++e) { v[2 * e] = bf_lo(w4[which][j][e]); v[2 * e + 1] = bf_hi(w4[which][j][e]); }
                    float ss = 0.f;
#pragma unroll
                    for (int i = 0; i < 8; ++i) ss += v[i] * v[i];
                    ss += swz_xor<1>(ss); ss += swz_xor<2>(ss); ss += swz_xor<4>(ss); ss += swz_xor<8>(ss);
                    const float rs = __builtin_amdgcn_rsqf(ss * (1.0f / HD) + EPS) * (which == 0 ? QSCALE : 1.0f);
#pragma unroll
                    for (int e = 0; e < 4; ++e) { v[e] = v[e] * rs * g0[e]; v[4 + e] = v[4 + e] * rs * g1[e]; }
                    u32x4 w; w.x = cvt_pk_bf16(v[0], v[1]); w.y = cvt_pk_bf16(v[2], v[3]); w.z = cvt_pk_bf16(v[4], v[5]); w.w = cvt_pk_bf16(v[6], v[7]);
                    *(u32x4*)(pr + which * AW + 512 * j) = w;
                    if (which == 1) { *(f32x4*)(ko + 512 * j) = (f32x4){v[0], v[1], v[2], v[3]}; *(f32x4*)(ko + 512 * j + 4) = (f32x4){v[4], v[5], v[6], v[7]}; } }
            }
#pragma unroll
            for (int j = 0; j < 4; ++j) { const u32x4 vw = w4[2][j]; *(f32x4*)(vo + 512 * j) = (f32x4){bf_lo(vw[0]), bf_hi(vw[0]), bf_lo(vw[1]), bf_hi(vw[1])};
                *(f32x4*)(vo + 512 * j + 4) = (f32x4){bf_lo(vw[2]), bf_hi(vw[2]), bf_lo(vw[3]), bf_hi(vw[3])}; }
        }
        for (int task = gw2 + ((M - gw2 + NGW2 - 1) / NGW2) * NGW2 - M; task < (M / 16) * 4; task += NGW2) {
            const int r0 = (task >> 2) * 16, g = task & 3;
            if (g == 0) pool_task16<2>(PROJ, AP->state_pool, DP, r0, 0, lane);
            else if (g == 1) pool_task16<4>(PROJ, AP->state_pool, DP, r0, 1, lane);
            else if (g == 2) pool_task16<8>(PROJ, AP->state_pool, DP, r0, 2, lane);
            else pool_task16<16>(PROJ, AP->state_pool, DP, r0, 3, lane);
        }
        for (int t = gw2 + ((M + (M / 16) * 4 - gw2 + NGW2 - 1) / NGW2) * NGW2 - (M + (M / 16) * 4); t < PH * (1 + DB); t += NGW2) {
            const int s = t / PH, j = t % PH;
            const int row = (s == 0) ? (MP - PH + j) : (MP + (s - 1) * DS + (DS - PH) + j);
            float* dst = (s == 0) ? out + O_HP + (size_t)j * PW : out + O_HS + ((size_t)(s - 1) * PH + j) * PW;
#pragma unroll
            for (int i = 0; i < 4; ++i) { const u32x4 wv = *(const u32x4*)(PROJ + (size_t)row * PP + 32 * lane + 8 * i);
                *(f32x4*)(dst + 32 * lane + 8 * i) = (f32x4){bf_lo(wv[0]), bf_hi(wv[0]), bf_lo(wv[1]), bf_hi(wv[1])};
                *(f32x4*)(dst + 32 * lane + 8 * i + 4) = (f32x4){bf_lo(wv[2]), bf_hi(wv[2]), bf_lo(wv[3]), bf_hi(wv[3])}; }
        }
        }
    }
    xcd_barrier(bar, wave == 0 && fresh_lane() == 0);
    if (TPROBE != 0 && wave == 0 && fresh_lane() == 0) { volatile LAS unsigned long long* stw = (volatile LAS unsigned long long*)(lds + 143424); stw[16 + 3] = (unsigned long long)wall_clock64(); }

    AP = argp();
    REPS(3) {
        const int cls3 = (G == 256) ? (bx & 7) % 3 : 2;
#define SAMP_JOB() do { for (int u = vcu; u < DB * NH; u += G) att::samp_unit(u >> 4, u & 15, PROJ, AP->cache_k, AP->cache_v, CS, MIX, (att::lptr)lds, wave); \
                        asm volatile("s_waitcnt vmcnt(0)" ::: "memory"); __syncthreads(); } while (0)
        if (cls3 == 0) SAMP_JOB();
        {
            pg8::Gemm g{DP, WP, M, PW, PG, PW, 2}; pg8::SplitOrder S; S.init(M, PW, PG, G, bx, nullptr, nullptr);
            pg8::EpiPool E{MIX, AP->pool_scale};
            pg8::gemm_phase<pg8::EpiPool, pg8::SplitOrder>(lds, g, S, E, wave);
        }
        if (cls3 == 1) SAMP_JOB();
        {
            int nblk = 0; for (int it = vcu; it < 256; it += G) nblk += 2;
            auto ref = [&](int i) { const int item = vcu + (i >> 1) * G, h = item >> 4, x = item & 15, qb = (i & 1) ? 31 - x : x;
                att::Blk r; r.h = h; r.qb = qb; r.jlo = JLO[h * 32 + qb]; return r; };
            if (nblk > 0) {
                att::Seam S; att::Blk cur = ref(0);
                att::attn_prime(cur, PROJ, (att::lptr)lds, S, wave);
                for (int i = 0; i < nblk; ++i) { const att::Blk nxt = (i + 1 < nblk) ? ref(i + 1) : cur; att::attn_block(cur, nxt, PROJ, MIX, CB, (att::lptr)lds, S, wave); cur = nxt; }
            }
            asm volatile("s_waitcnt vmcnt(0)" ::: "memory"); __syncthreads();
        }
        if (cls3 == 2) SAMP_JOB();
#undef SAMP_JOB
    }
    xcd_barrier(bar, wave == 0 && fresh_lane() == 0);
    if (TPROBE != 0 && wave == 0 && fresh_lane() == 0) { volatile LAS unsigned long long* stw = (volatile LAS unsigned long long*)(lds + 143424); stw[16 + 4] = (unsigned long long)wall_clock64(); }

    AP = argp();
    REPS(6) {
        pg8::Gemm g{MIX, WO, M, DM, DM, DM, 1 << 30}; pg8::SplitOrder S; S.init(M, DM, DM, G, bx, PART, ctl + CW_SPLIT + (1 + 4 * rep_) * 8192); if (S.r && S.nfull == 32 * S.nN && (S.nN & 15) == 0) S.mode = 1; if (S.r) S.plast = (bx / S.s) & 1;
        pg8::EpiOut E{AP->x_prompt, AP->x_sample, X1G, rep_ ? RSS + 16384 : RSS};
        pg8::gemm_phase<pg8::EpiOut, pg8::SplitOrder>(lds, g, S, E, wave);
    }
    xcd_barrier(bar, wave == 0 && fresh_lane() == 0);
    if (TPROBE != 0 && wave == 0 && fresh_lane() == 0) { volatile LAS unsigned long long* stw = (volatile LAS unsigned long long*)(lds + 143424); stw[16 + 5] = (unsigned long long)wall_clock64(); }

    AP = argp();
    REPS(7) {
        pg8::Gemm g{X1G, WU, M, DFF, DM, DM, 1 << 30}; pg8::SplitOrder S; S.init(M, DFF, DM, G, bx, PART, ctl + CW_SPLIT + (2 + 4 * rep_) * 8192); if (S.r && S.nfull == 32 * S.nN && (S.nN & 15) == 0) S.mode = 1; if (S.r) S.plast = (bx / S.s) & 1;
        pg8::EpiUp E{HID, RSS};
        const unsigned long long tw0_ = (TPROBE != 0) ? wall_clock64() : 0ull;
        pg8::gemm_phase<pg8::EpiUp, pg8::SplitOrder, (TPROBE != 0)>(lds, g, S, E, wave);
        if (TPROBE != 0 && wave == 0 && fresh_lane() == 0) {
            const unsigned dt = (unsigned)(wall_clock64() - tw0_);
            atomicMax(ctl + 200000, dt); atomicMax(ctl + 200064, 0xffffffffu - dt); atomicAdd(ctl + 200128, dt);
            atomicMax((unsigned long long*)(ctl + 200192), ((unsigned long long)dt << 32) | (unsigned)bx);
        }
    }
    xcd_barrier(bar, wave == 0 && fresh_lane() == 0);
    if (TPROBE != 0 && wave == 0 && fresh_lane() == 0) { volatile LAS unsigned long long* stw = (volatile LAS unsigned long long*)(lds + 143424); stw[16 + 6] = (unsigned long long)wall_clock64(); }

    AP = argp();
    REPS(8) {
        pg8::Gemm g{HID, WD, M, DM, DFF, DFF, 1 << 30}; pg8::SplitOrder S; S.init(M, DM, DFF, G, bx, PART, ctl + CW_SPLIT + (3 + 4 * rep_) * 8192); if (S.r && S.nfull == 32 * S.nN && (S.nN & 15) == 0) S.mode = 1; if (S.r) S.plast = (bx / S.s) & 1;
        pg8::EpiDown E{X1G, rep_ ? (float*)(ws + WS_END) : out};
        pg8::gemm_phase<pg8::EpiDown, pg8::SplitOrder>(lds, g, S, E, wave);
    }
    if (TPROBE != 0 && bx == 0 && wave == 0) {
        volatile LAS unsigned long long* stw = (volatile LAS unsigned long long*)(lds + 143424);
        const unsigned long long c0 = stw[0], w0 = stw[1], c1 = stw[2], w1 = stw[3], c2 = stw[4], w2 = stw[5];
        unsigned long long D = 0;
        if (TPROBE == 1) D = (c1 - c0) / 64 * 40;
        if (TPROBE == 2) D = (c1 - c0) * 1000 / (w1 - w0) * 50;
        if (TPROBE == 2) D /= 1000 / 100;
        if (TPROBE == 3) D = (c2 - c1);
        if (TPROBE == 4) D = (w1 - w0) * 10;
        if (TPROBE == 20) D = __hip_atomic_load(ctl + 200000, __ATOMIC_RELAXED, __HIP_MEMORY_SCOPE_AGENT);
        if (TPROBE == 21) D = 0xffffffffu - __hip_atomic_load(ctl + 200064, __ATOMIC_RELAXED, __HIP_MEMORY_SCOPE_AGENT);
        if (TPROBE == 22) D = __hip_atomic_load(ctl + 200128, __ATOMIC_RELAXED, __HIP_MEMORY_SCOPE_AGENT) / 256;
        if (TPROBE == 23) D = (__hip_atomic_load((unsigned long long*)(ctl + 200192), __ATOMIC_RELAXED, __HIP_MEMORY_SCOPE_AGENT) & 0xffffffffull) * 1000;
        if (TPROBE == 5) D = (stw[9] - stw[7]);
        if (TPROBE >= 10 && TPROBE < 17) { const int k = TPROBE - 10; const unsigned long long mul[7] = {5, 2, 5, 5, 2, 1, 1}; D = (k < 6 ? stw[17 + k] - stw[16 + k] : wall_clock64() - stw[22]) * mul[k]; }
        const unsigned long long t0 = wall_clock64();
        if (D > 400000) D = 400000;
        while (wall_clock64() - t0 < D) __builtin_amdgcn_s_sleep(8);
    }
}

extern "C" void kernel_launch(void* const* d_in, const int* in_sizes, int n_in, void* d_out, int out_size, void* d_ws, size_t ws_size, hipStream_t stream) {
    static int grid = 0;
    if (grid == 0) {
        if (n_in != 17 || in_sizes[0] != MP * DM || (size_t)out_size != O_END || ws_size < WS_END + (PROBE == 8 ? (size_t)M * DM * 4 : 0)) {
            fprintf(stderr, "kernel_launch: shape mismatch (n_in %d, in0 %d, out %d, ws %zu; need 17, %d, %zu, >= %zu)\n", n_in, n_in > 0 ? in_sizes[0] : -1, out_size, ws_size, MP * DM, (size_t)O_END, (size_t)WS_END);
            grid = -1; return; }
        int dev = 0, cus = 0, per_cu = 0;
        if (hipGetDevice(&dev) != hipSuccess || hipDeviceGetAttribute(&cus, hipDeviceAttributeMultiprocessorCount, dev) != hipSuccess) { grid = -1; return; }
        if (hipFuncSetAttribute((const void*)hymba_fwd, hipFuncAttributeMaxDynamicSharedMemorySize, LDS_BYTES) != hipSuccess) { fprintf(stderr, "kernel_launch: hipFuncSetAttribute failed\n"); grid = -1; return; }
        if (hipOccupancyMaxActiveBlocksPerMultiprocessor(&per_cu, (const void*)hymba_fwd, 512, LDS_BYTES) != hipSuccess || per_cu < 1) { fprintf(stderr, "kernel_launch: occupancy query says %d\n", per_cu); }
        (void)hipGetLastError();
        grid = cus;
    }
    if (grid < 0) return;
    if (hipMemsetAsync((char*)d_ws + WS_CTL, 0, CTL_ZERO_BYTES, stream) != hipSuccess) { fprintf(stderr, "kernel_launch: memset failed\n"); return; }
    Args a{};
    a.x_prompt = (const float*)d_in[0]; a.x_sample = (const float*)d_in[1]; a.cache_k = (const float*)d_in[2]; a.cache_v = (const float*)d_in[3]; a.cache_logf = (const float*)d_in[4];
    a.state_pool = (const float*)d_in[5]; a.attn_norm_g = (const float*)d_in[6]; a.w_in = (const float*)d_in[7]; a.b_f = (const float*)d_in[8]; a.q_norm_g = (const float*)d_in[9];
    a.k_norm_g = (const float*)d_in[10]; a.w_pool = (const float*)d_in[11]; a.pool_scale = (const float*)d_in[12]; a.w_out = (const float*)d_in[13]; a.mlp_norm_g = (const float*)d_in[14];
    a.w_up = (const float*)d_in[15]; a.w_down = (const float*)d_in[16];
    a.out = (float*)d_out; a.ws = (unsigned char*)d_ws;
    hipLaunchKernelGGL(hymba_fwd, dim3(grid), dim3(512), LDS_BYTES, stream, a);
    const hipError_t le = hipPeekAtLastError();
    if (le != hipSuccess) fprintf(stderr, "kernel_launch: launch failed: %s\n", hipGetErrorName(le));
}
```

```cpp
#include <hip/hip_runtime.h>
#include <cstdio>
#include <cstdint>

#define LAS __attribute__((address_space(3)))
#define GAS __attribute__((address_space(1)))
typedef unsigned short bf16_t;
typedef short bf16x8 __attribute__((ext_vector_type(8)));
typedef short s16x4 __attribute__((ext_vector_type(4)));
typedef float f32x2 __attribute__((ext_vector_type(2)));
typedef float f32x4 __attribute__((ext_vector_type(4)));
typedef float f32x16 __attribute__((ext_vector_type(16)));
typedef unsigned u32x2 __attribute__((ext_vector_type(2)));
typedef unsigned u32x4 __attribute__((ext_vector_type(4)));

constexpr int DM = 4096, SEQ = 8192, DB = 16, DS = 32, PAST = 2048;
constexpr int MP = SEQ, MS = DB * DS, M = MP + MS;
constexpr int PW = 2048, AW = 2048, NH = 16, HD = 128, PH = 15, PG = 512;
constexpr int NPROJ = PW + 3 * AW + NH;
constexpr int NPROJ_PAD = 8448;
constexpr int PP = 8192;
constexpr int DFF = 16384;
constexpr float EPS = 1e-6f;
constexpr float QSCALE = 0.08838834764831845f * 1.4426950408889634f;
constexpr float LOG2E = 1.4426950408889634f;
constexpr float PRUNE_T = 27.0f;
constexpr size_t O_YP = 0, O_YS = (size_t)MP * DM, O_KP = O_YS + (size_t)MS * DM, O_VP = O_KP + (size_t)MP * AW, O_FP = O_VP + (size_t)MP * AW,
                 O_HP = O_FP + (size_t)MP * NH, O_KS = O_HP + (size_t)PH * PW, O_VS = O_KS + (size_t)MS * AW, O_FS = O_VS + (size_t)MS * AW,
                 O_HS = O_FS + (size_t)MS * NH, O_END = O_HS + (size_t)DB * PH * PW;
static_assert(O_END == 71964672, "output size");
constexpr size_t MiB = 1u << 20;
constexpr size_t WS_CTL = 0, CTL_ZERO_BYTES = 1 * MiB;
constexpr size_t WS_WI = 2 * MiB, WS_WP = 68 * MiB, WS_WO = 70 * MiB, WS_WU = 102 * MiB, WS_WD = 230 * MiB, WS_XN = 358 * MiB, WS_PROJ = 426 * MiB,
                 WS_FL = 562 * MiB, WS_CB = 565 * MiB, WS_CS = 566 * MiB, WS_DP = 569 * MiB, WS_MIX = 603 * MiB, WS_X1G = 671 * MiB, WS_HID = 739 * MiB, WS_PART = 1011 * MiB, WS_END = 1075 * MiB;
static_assert(WS_WI + (size_t)NPROJ_PAD * DM * 2 <= WS_WP && WS_XN + (size_t)M * DM * 2 <= WS_PROJ && WS_PROJ + (size_t)M * PP * 2 <= WS_FL && WS_FL + (size_t)4 * M * NH * 4 <= WS_CB && WS_CS + (size_t)DB * NH * 2080 * 4 <= WS_DP &&
              WS_DP + (size_t)M * PW * 2 <= WS_MIX && WS_HID + (size_t)M * DFF * 2 <= WS_PART && WS_PART + (size_t)256 * 65536 * 4 <= WS_END, "ws map");
constexpr int CW_BAR = 4096;
constexpr int CW_JLO = 16384;
constexpr int CW_RSS = 32768;
constexpr int CW_SPLIT = 65536;
static_assert((CW_RSS + 16384 + M) <= CW_SPLIT && (CW_SPLIT + 8 * 8192) * 4 <= (int)CTL_ZERO_BYTES, "ctl");
constexpr int LDS_BYTES = 147456;
constexpr int MISC_OFF = LDS_BYTES - 128;

__device__ __forceinline__ int fresh_lane() { int l; asm volatile("v_mbcnt_lo_u32_b32 %0, -1, 0\n\tv_mbcnt_hi_u32_b32 %0, -1, %0" : "=v"(l)); return l; }
template <int X> __device__ __forceinline__ float swz_xor(float v) { return __int_as_float(__builtin_amdgcn_ds_swizzle(__float_as_int(v), (X << 10) | 0x1f)); }
__device__ __forceinline__ float half_sum(float v) { auto rr = __builtin_amdgcn_permlane32_swap(__float_as_uint(v), __float_as_uint(v), false, false); return __uint_as_float(rr[0]) + __uint_as_float(rr[1]); }
__device__ __forceinline__ float half_max(float v) { auto rr = __builtin_amdgcn_permlane32_swap(__float_as_uint(v), __float_as_uint(v), false, false); return fmaxf(__uint_as_float(rr[0]), __uint_as_float(rr[1])); }
__device__ __forceinline__ unsigned cvt_pk_bf16(float lo, float hi) { unsigned r; asm volatile("v_cvt_pk_bf16_f32 %0, %1, %2" : "=v"(r) : "v"(lo), "v"(hi)); return r; }
__device__ __forceinline__ float bf_lo(unsigned w) { return __uint_as_float(w << 16); }
__device__ __forceinline__ float bf_hi(unsigned w) { return __uint_as_float(w & 0xffff0000u); }
__device__ __forceinline__ bf16x8 pack8(f32x4 a, f32x4 b) { u32x4 w = {cvt_pk_bf16(a[0], a[1]), cvt_pk_bf16(a[2], a[3]), cvt_pk_bf16(b[0], b[1]), cvt_pk_bf16(b[2], b[3])}; return __builtin_bit_cast(bf16x8, w); }

namespace pg8 {
constexpr int BM = 256, BK = 64, HALF = 128, HTB = HALF * BK * 2, STAGE_BYTES = 8 * HTB, NXCD = 8, WGM = 8;
__host__ __device__ __forceinline__ int lds_byte(int r, int c) { const int st = (r >> 4) * 2 + (c >> 5), rr = r & 15, cc = c & 31, ob = rr * 64 + cc * 2; return st * 1024 + (ob ^ (((ob >> 9) & 1) << 5)); }
__host__ __device__ __forceinline__ void stage_rc(int b, int& R, int& C) { const int st = b / 1024, sb = b % 1024, swz = sb ^ (((sb >> 9) & 1) << 5); R = (st >> 1) * 16 + swz / 64; C = (st & 1) * 32 + (swz % 64) / 2; }
__host__ __device__ __forceinline__ int perm32(int rho) { const int n = rho >> 4, i = rho & 15; return 8 * (i >> 2) + 4 * n + (i & 3); }
struct Unit { int pm, pn, kt0, nt, part; };
struct Gemm { const bf16_t* A; const bf16_t* Bt; int M, N, K, lda, adiv; };
struct SplitOrder {
    int nM, nN, nwg, G, c, R, r, s, ntK, nfull, ibeg, iend, mode, plast; float* part; unsigned* cnt;
    __device__ __forceinline__ void init(int M_, int N_, int K_, int G_, int c_, float* part_, unsigned* cnt_) {
        nM = M_ / BM; nN = N_ / BM; nwg = nM * nN; G = G_; c = c_; ntK = K_ / BK; part = part_; cnt = cnt_;
        r = 0; s = 1; nfull = nwg; ibeg = 0; iend = 1 << 30; mode = 0; plast = 0;
        if (G == 256 && part_ != nullptr) { const int rem = nwg % 256; if (rem != 0 && 256 % rem == 0) { const int ss = 256 / rem; if (ntK % ss == 0 && ((ntK / ss) & 1) == 0 && ntK / ss >= 4) { r = rem; s = ss; nfull = nwg - rem; } } }
    }
    __device__ __forceinline__ void map(int wgid, Unit& u) const {
        if (mode == 1) {
            if (wgid < nfull) { const int rd = wgid >> 8, cc = wgid & 255, x = cc & 7, l = cc >> 3, nb = nN >> 4, pmb = rd / nb, pnb = rd - pmb * nb;
                u.pm = 16 * pmb + 4 * (x >> 1) + (l & 3); u.pn = 16 * pnb + 8 * (x & 1) + (l >> 2); }
            else { const int k = wgid - nfull; u.pm = nfull / nN + k / nN; u.pn = k % nN; }
            return; }
        { const int q = nwg / NXCD, rr = nwg % NXCD, xcd = wgid % NXCD, off = wgid / NXCD; wgid = (xcd < rr ? xcd * (q + 1) : rr * (q + 1) + (xcd - rr) * q) + off; }
        const int nig = WGM * nN, gid = wgid / nig, fm = gid * WGM, gsz = (nM - fm) < WGM ? (nM - fm) : WGM;
        u.pm = fm + ((wgid % nig) % gsz); u.pn = (wgid % nig) / gsz;
    }
    __device__ __forceinline__ bool next(int i0, Unit& u) const {
        const int i = i0 + ibeg; int wg, kt0 = 0, nt = ntK, part = -1; bool ok;
        if (r) {
            const int nr = nfull / G;
            if (i == (plast ? nr : 0)) { wg = nfull + c / s; nt = ntK / s; kt0 = (c % s) * nt; part = c; ok = true; }
            else { const long L = (long)(plast ? i : i - 1) * G + c; ok = L < nfull && i <= nr; wg = ok ? (int)L : 0; }
        } else { const long L = (long)i * G + c; ok = L < nwg; wg = ok ? (int)L : 0; }
        Unit t; map(wg, t); t.kt0 = kt0; t.nt = nt; t.part = part; u = t; return ok && i < iend;
    }
};
__device__ __forceinline__ void store16u_sc1(bf16_t* p, u32x4 v) { asm volatile("global_store_dwordx4 %0, %1, off sc1\n\ts_nop 1" :: "v"(p), "v"(v) : "memory"); }
__device__ __forceinline__ void store16_sc1(float* p, f32x4 v) { asm volatile("global_store_dwordx4 %0, %1, off sc1\n\ts_nop 1" :: "v"(p), "v"(v) : "memory"); }
template <class Epi, class Sched, int STAMP = 0>
__device__ __forceinline__ void gemm_phase(LAS unsigned char* lds, const Gemm g, const Sched& S, const Epi& E, const int wid, const bool do_fix = true) {
    volatile LAS unsigned long long* stw = (volatile LAS unsigned long long*)(lds + 143424);
#define PG8_ST(k) do { if (STAMP && wid == 0 && lane == 0) { stw[2 * (k)] = (unsigned long long)clock64(); stw[2 * (k) + 1] = (unsigned long long)wall_clock64(); } } while (0)
    const int lane = fresh_lane(), tid = wid * 64 + lane, wr = wid >> 2, wc = wid & 3, fr = lane & 15, fq = lane >> 4;
    PG8_ST(3);
    const int K = g.K;
    unsigned voffA[2], voffB[2];
#pragma unroll
    for (int i = 0; i < 2; ++i) { int R, C; stage_rc(tid * 16 + i * 8192, R, C); const int Rb = (R & ~31) + perm32(R & 31);
        voffA[i] = (unsigned)(R * g.lda + C) * 2u; voffB[i] = (unsigned)(Rb * K + C) * 2u; }
    const size_t kstep = (size_t)(BK * 2);
    const size_t hstepA = (size_t)HALF * g.lda * 2, hstepB = (size_t)HALF * K * 2;
    const size_t tstepA = 2 * hstepA, tstepB = 2 * hstepB;
    const unsigned ldsw = (unsigned)wid * 1024u;
    const int aoff = lds_byte(wr * 64 + fr, fq * 8), boff = lds_byte(wc * 32 + fr, fq * 8);
#define PG8_SA(b, h) (((b) * 2 + (h)) * HTB)
#define PG8_SB(b, h) ((4 + (b) * 2 + (h)) * HTB)
#define PG8_STAGE(bufoff, gbase, voff) do { _Pragma("unroll") for (int _i = 0; _i < 2; ++_i) \
        __builtin_amdgcn_global_load_lds((const unsigned*)((const char*)(gbase) + (voff)[_i]), (LAS unsigned*)(lds + (bufoff) + ldsw + _i * 8192), 16, 0, 0); } while (0)
#define PG8_LDA(dst, b, h) do { _Pragma("unroll") for (int m = 0; m < 4; ++m) _Pragma("unroll") for (int k = 0; k < 2; ++k) dst[m][k] = *(const LAS bf16x8*)(lds + PG8_SA(b, h) + aoff + m * 2048 + k * 1024); } while (0)
#define PG8_LDB(dst, b, h) do { _Pragma("unroll") for (int n = 0; n < 2; ++n) _Pragma("unroll") for (int k = 0; k < 2; ++k) dst[n][k] = *(const LAS bf16x8*)(lds + PG8_SB(b, h) + boff + n * 2048 + k * 1024); } while (0)
#define PG8_MMA(ai, bj, At, Bt) do { __builtin_amdgcn_s_setprio(1); _Pragma("unroll") for (int m = 0; m < 4; ++m) _Pragma("unroll") for (int n = 0; n < 2; ++n) _Pragma("unroll") for (int k = 0; k < 2; ++k) \
        acc[ai][bj][m][n] = __builtin_amdgcn_mfma_f32_16x16x32_bf16(Bt[n][k], At[m][k], acc[ai][bj][m][n], 0, 0, 0); __builtin_amdgcn_s_setprio(0); } while (0)
#define PG8_WAIT_V(n) asm volatile("s_waitcnt vmcnt(" #n ")" ::: "memory")
#define PG8_WAIT_L(n) asm volatile("s_waitcnt lgkmcnt(" #n ")" ::: "memory")
#define PG8_BAR __builtin_amdgcn_s_barrier()
#define PG8_SCHED __builtin_amdgcn_sched_barrier(0)
    Unit cur, nxt; int ui = 0;
    if (S.next(0, cur)) {
    f32x4 acc[2][2][4][2];
#pragma unroll
    for (int a = 0; a < 2; ++a)
#pragma unroll
        for (int b = 0; b < 2; ++b)
#pragma unroll
            for (int m = 0; m < 4; ++m)
#pragma unroll
                for (int n = 0; n < 2; ++n) acc[a][b][m][n] = (f32x4){0.f, 0.f, 0.f, 0.f};
    bf16x8 At[4][2], B0[2][2], B1[2][2];
    const char* cA = (const char*)g.A + (size_t)cur.pm * tstepA + (size_t)(cur.pn / g.adiv) * K * 2 + (size_t)cur.kt0 * kstep; const char* cB = (const char*)g.Bt + (size_t)cur.pn * tstepB + (size_t)cur.kt0 * kstep;
    PG8_STAGE(PG8_SB(0, 0), cB, voffB); PG8_STAGE(PG8_SB(0, 1), cB + hstepB, voffB); PG8_STAGE(PG8_SA(0, 0), cA, voffA); PG8_STAGE(PG8_SA(0, 1), cA + hstepA, voffA);
    if (wr == 1) PG8_BAR;
    PG8_WAIT_V(2); PG8_BAR;
    PG8_STAGE(PG8_SB(1, 0), cB + kstep, voffB); PG8_STAGE(PG8_SA(1, 0), cA + kstep, voffA); PG8_STAGE(PG8_SB(1, 1), cB + hstepB + kstep, voffB);
    PG8_WAIT_V(6); PG8_BAR;
    for (;;) {
        const bool has_next = S.next(ui + 1, nxt);
        const char* nA = has_next ? (const char*)g.A + (size_t)nxt.pm * tstepA + (size_t)(nxt.pn / g.adiv) * K * 2 + (size_t)nxt.kt0 * kstep : cA; const char* nB = has_next ? (const char*)g.Bt + (size_t)nxt.pn * tstepB + (size_t)nxt.kt0 * kstep : cB;
        const int nt = cur.nt;
        if constexpr (Epi::PREF != 0) { if (cur.part < 0) E.prefetch(cur, ui & 1, wid, lane); }
        if (ui == 3) PG8_ST(0);
        for (int t = 0; t < nt; t += 2) {
            const bool last = (t == nt - 2);
            const char* a1 = cA + (size_t)(t + 1) * kstep;
            const char* a2 = last ? nA : cA + (size_t)(t + 2) * kstep; const char* b2 = last ? nB : cB + (size_t)(t + 2) * kstep;
            const char* a3 = a2 + kstep; const char* b3 = b2 + kstep;
            PG8_LDB(B0, 0, 0); PG8_LDB(B1, 0, 1); PG8_SCHED; PG8_LDA(At, 0, 0); PG8_STAGE(PG8_SA(1, 1), a1 + hstepA, voffA);
            PG8_WAIT_V(8); PG8_WAIT_L(0); PG8_BAR; PG8_MMA(0, 0, At, B0); PG8_MMA(0, 1, At, B1); PG8_BAR; PG8_SCHED;
            PG8_LDA(At, 0, 1); PG8_STAGE(PG8_SB(0, 0), b2, voffB); PG8_STAGE(PG8_SB(0, 1), b2 + hstepB, voffB); PG8_STAGE(PG8_SA(0, 0), a2, voffA);
            PG8_WAIT_V(8); PG8_WAIT_L(0); PG8_BAR; PG8_MMA(1, 0, At, B0); PG8_MMA(1, 1, At, B1); PG8_BAR; PG8_SCHED;
            PG8_LDB(B0, 1, 0); PG8_LDB(B1, 1, 1); PG8_SCHED; PG8_LDA(At, 1, 0); PG8_STAGE(PG8_SA(0, 1), a2 + hstepA, voffA);
            PG8_WAIT_V(8); PG8_WAIT_L(0); PG8_BAR; PG8_MMA(0, 0, At, B0); PG8_MMA(0, 1, At, B1); PG8_BAR; PG8_SCHED;
            PG8_LDA(At, 1, 1); PG8_STAGE(PG8_SB(1, 0), b3, voffB); PG8_STAGE(PG8_SB(1, 1), b3 + hstepB, voffB); PG8_STAGE(PG8_SA(1, 0), a3, voffA);
            PG8_WAIT_V(8); PG8_WAIT_L(0); PG8_BAR; PG8_MMA(1, 0, At, B0); PG8_MMA(1, 1, At, B1); PG8_BAR; PG8_SCHED;
        }
        if (ui == 3) PG8_ST(1);
        if (wr == 0) PG8_BAR;
        if (cur.part >= 0) {
            bf16_t* pb = (bf16_t*)S.part + (size_t)cur.part * 65536 + (size_t)(wid * 16 * 64 + lane) * 8;
#pragma unroll
            for (int ai = 0; ai < 2; ++ai)
#pragma unroll
                for (int m = 0; m < 4; ++m)
#pragma unroll
                    for (int bj = 0; bj < 2; ++bj) { const f32x4 v0 = acc[ai][bj][m][0], v1 = acc[ai][bj][m][1];
                        u32x4 w; w.x = cvt_pk_bf16(v0[0], v0[1]); w.y = cvt_pk_bf16(v0[2], v0[3]); w.z = cvt_pk_bf16(v1[0], v1[1]); w.w = cvt_pk_bf16(v1[2], v1[3]);
                        store16u_sc1(pb + (size_t)((ai * 4 + m) * 2 + bj) * 512, w); }
            asm volatile("s_waitcnt vmcnt(0)" ::: "memory");
            if (lane == 0) __hip_atomic_fetch_add(S.cnt + 64 * (cur.part / S.s), 1u, __ATOMIC_RELAXED, __HIP_MEMORY_SCOPE_AGENT);
        } else { if constexpr (Epi::PREF != 0) E(acc, cur, wr, wc, fr, fq, 0xffu, ui & 1); else E(acc, cur, wr, wc, fr, fq); }
        if (ui == 3) PG8_ST(2);
        if (!has_next) break;
#pragma unroll
        for (int a = 0; a < 2; ++a)
#pragma unroll
            for (int b = 0; b < 2; ++b)
#pragma unroll
                for (int m = 0; m < 4; ++m)
#pragma unroll
                    for (int n = 0; n < 2; ++n) acc[a][b][m][n] = (f32x4){0.f, 0.f, 0.f, 0.f};
        cur = nxt; cA = nA; cB = nB; ++ui;
        if (wr == 1) PG8_BAR;
    }
    PG8_WAIT_V(0);
    PG8_BAR;
    }
    if (S.r && do_fix) {
        const int su = S.c / S.s, j = S.c % S.s, rows = BM / S.s; Unit fu; S.map(S.nfull + su, fu);
        if (wid == 0) { unsigned* cw = S.cnt + 64 * su; unsigned sp = 0;
            while ((unsigned)__builtin_amdgcn_readfirstlane(__hip_atomic_load(cw, __ATOMIC_RELAXED, __HIP_MEMORY_SCOPE_AGENT)) < 8u * (unsigned)S.s) { __builtin_amdgcn_s_sleep(2); if (++sp > (1u << 22)) break; }
            __builtin_amdgcn_fence(__ATOMIC_ACQUIRE, "agent"); asm volatile("s_waitcnt vmcnt(0)" ::: "memory"); }
        __syncthreads();
        const bf16_t* pbase = (const bf16_t*)S.part + (size_t)(su * S.s) * 65536 + (size_t)(wid * 16 * 64 + lane) * 8;
        f32x4 facc[2][2][4][2]; unsigned rmask = 0u;
#pragma unroll
        for (int ai = 0; ai < 2; ++ai)
#pragma unroll
            for (int m = 0; m < 4; ++m) { const int p = ai * 4 + m; const bool mine = (p & (S.s - 1)) == j; rmask |= mine ? (1u << p) : 0u;
#pragma unroll
                for (int bj = 0; bj < 2; ++bj) { f32x4 s0 = {0.f, 0.f, 0.f, 0.f}, s1 = s0;
                    if (mine) {
#pragma unroll
                        for (int q = 0; q < 8; ++q) if (q < S.s) { const u32x4 w = *(const u32x4*)(pbase + (size_t)q * 65536 + (size_t)(p * 2 + bj) * 512);
                            s0 += (f32x4){bf_lo(w.x), bf_hi(w.x), bf_lo(w.y), bf_hi(w.y)}; s1 += (f32x4){bf_lo(w.z), bf_hi(w.z), bf_lo(w.w), bf_hi(w.w)}; } }
                    facc[ai][bj][m][0] = s0; facc[ai][bj][m][1] = s1; } }
        E(facc, fu, wr, wc, fr, fq, rmask);
    }
    PG8_ST(4);
#undef PG8_ST
#undef PG8_SA
#undef PG8_SB
#undef PG8_STAGE
#undef PG8_LDA
#undef PG8_LDB
#undef PG8_MMA
#undef PG8_WAIT_V
#undef PG8_WAIT_L
#undef PG8_BAR
#undef PG8_SCHED
}

struct EpiProj {
    static constexpr int PREF = 0;
    bf16_t* O; const float* gq; const float* gk; LAS float* xch; float* out;
    __device__ __forceinline__ void operator()(const f32x4 (&acc)[2][2][4][2], const Unit& u, int wr, int wc, int fr, int fq, unsigned rmask = 0xffu) const {
        const int row0 = u.pm * BM + wr * 64 + fr, col0 = u.pn * BM + wc * 32 + 8 * fq, kind = u.pn >> 3;
        const bool nrm = (kind == 1 || kind == 2);
        const int rl0 = wr * 64 + fr;
        f32x4 g0 = {1.f, 1.f, 1.f, 1.f}, g1 = g0;
        if (nrm) { const float* gsrc = (kind == 1 ? gq : gk) + wc * 32 + 8 * fq; const float qs = kind == 1 ? QSCALE : 1.0f; g0 = *(const f32x4*)gsrc * qs; g1 = *(const f32x4*)(gsrc + 4) * qs; }
        if (nrm) {
#pragma unroll
            for (int ai = 0; ai < 2; ++ai)
#pragma unroll
                for (int m = 0; m < 4; ++m) { if (!((rmask >> (ai * 4 + m)) & 1u)) continue;
#pragma unroll
                    for (int bj = 0; bj < 2; ++bj) { const f32x4 a0 = acc[ai][bj][m][0], a1 = acc[ai][bj][m][1];
                        float ss = (a0[0] * a0[0] + a0[1] * a0[1]) + (a0[2] * a0[2] + a0[3] * a0[3]) + (a1[0] * a1[0] + a1[1] * a1[1]) + (a1[2] * a1[2] + a1[3] * a1[3]);
                        ss += swz_xor<16>(ss); ss = half_sum(ss);
                        if (fq == 0) xch[((rl0 + ai * HALF + m * 16) * 2 + bj) * 4 + wc] = ss; } }
            asm volatile("s_waitcnt lgkmcnt(0)" ::: "memory"); __builtin_amdgcn_s_barrier(); asm volatile("" ::: "memory");
        }
#pragma unroll
        for (int ai = 0; ai < 2; ++ai)
#pragma unroll
            for (int m = 0; m < 4; ++m) { if (!((rmask >> (ai * 4 + m)) & 1u)) continue; bf16_t* rowp = O + (size_t)(row0 + ai * HALF + m * 16) * PP + col0;
#pragma unroll
                for (int bj = 0; bj < 2; ++bj) { f32x4 v0 = acc[ai][bj][m][0], v1 = acc[ai][bj][m][1];
                    if (nrm) { const f32x4 p = *(const LAS f32x4*)(xch + ((rl0 + ai * HALF + m * 16) * 2 + bj) * 4);
                        const float rs = __builtin_amdgcn_rsqf(((p[0] + p[1]) + (p[2] + p[3])) * (1.0f / HD) + EPS); v0 = v0 * rs * g0; v1 = v1 * rs * g1; }
                    u32x4 w; w.x = cvt_pk_bf16(v0[0], v0[1]); w.y = cvt_pk_bf16(v0[2], v0[3]); w.z = cvt_pk_bf16(v1[0], v1[1]); w.w = cvt_pk_bf16(v1[2], v1[3]);
                    *(u32x4*)(rowp + bj * HALF) = w;
                    if (kind >= 2) {
                        const int row = row0 + ai * HALF + m * 16;
                        float* op = out + (row < MP ? (kind == 2 ? O_KP : O_VP) + (size_t)row * AW : (kind == 2 ? O_KS : O_VS) + (size_t)(row - MP) * AW) + (col0 - kind * AW) + bj * HALF;
                        *(f32x4*)op = v0; *(f32x4*)(op + 4) = v1; } } }
    }
};
struct EpiPool {
    static constexpr int PREF = 0;
    bf16_t* O; const float* scale;
    __device__ __forceinline__ void operator()(const f32x4 (&acc)[2][2][4][2], const Unit& u, int wr, int wc, int fr, int fq, unsigned rmask = 0xffu) const {
        const int row0 = u.pm * BM + wr * 64 + fr, col0 = u.pn * BM + wc * 32 + 8 * fq;
        f32x4 sv[2][2];
#pragma unroll
        for (int bj = 0; bj < 2; ++bj)
#pragma unroll
            for (int n = 0; n < 2; ++n) sv[bj][n] = *(const f32x4*)(scale + col0 + bj * HALF + 4 * n);
#pragma unroll
        for (int ai = 0; ai < 2; ++ai)
#pragma unroll
            for (int m = 0; m < 4; ++m) { if (!((rmask >> (ai * 4 + m)) & 1u)) continue; bf16_t* rowp = O + (size_t)(row0 + ai * HALF + m * 16) * DM + col0;
#pragma unroll
                for (int bj = 0; bj < 2; ++bj) { const f32x4 v0 = acc[ai][bj][m][0] * sv[bj][0], v1 = acc[ai][bj][m][1] * sv[bj][1];
                    u32x4 w; w.x = cvt_pk_bf16(v0[0], v0[1]); w.y = cvt_pk_bf16(v0[2], v0[3]); w.z = cvt_pk_bf16(v1[0], v1[1]); w.w = cvt_pk_bf16(v1[2], v1[3]);
                    *(u32x4*)(rowp + bj * HALF) = w; } }
    }
};
struct EpiOut {
    static constexpr int PREF = 0;
    const float* xp; const float* xs; bf16_t* X1B; float* rowss;
    __device__ __forceinline__ void operator()(const f32x4 (&acc)[2][2][4][2], const Unit& u, int wr, int wc, int fr, int fq, unsigned rmask = 0xffu) const {
        const int row0 = u.pm * BM + wr * 64 + fr, col0 = u.pn * BM + wc * 32 + 8 * fq;
        const float* xin = (u.pm < MP / BM) ? xp : xs - (size_t)MP * DM;
        f32x4 xa[2][2][2], xb[2][2][2]; u32x4 wq[2][2]; float sq[2];
#define EO_LOAD(xq, q) do { _Pragma("unroll") for (int mm = 0; mm < 2; ++mm) _Pragma("unroll") for (int bj = 0; bj < 2; ++bj) _Pragma("unroll") for (int n = 0; n < 2; ++n) { \
            const int ai_ = (q) >> 1, m_ = 2 * ((q) & 1) + mm; if ((rmask >> (ai_ * 4 + m_)) & 1u) xq[mm][bj][n] = *(const f32x4*)(xin + (size_t)(row0 + ai_ * HALF + m_ * 16) * DM + col0 + bj * HALF + 4 * n); } \
            asm volatile("" ::: "memory"); } while (0)
#define EO_CALC(xq, q) do { _Pragma("unroll") for (int mm = 0; mm < 2; ++mm) { const int ai_ = (q) >> 1, m_ = 2 * ((q) & 1) + mm; float ss = 0.f; \
            _Pragma("unroll") for (int bj = 0; bj < 2; ++bj) { \
                const f32x4 v0 = xq[mm][bj][0] + acc[ai_][bj][m_][0], v1 = xq[mm][bj][1] + acc[ai_][bj][m_][1]; \
                ss += (v0[0] * v0[0] + v0[1] * v0[1]) + (v0[2] * v0[2] + v0[3] * v0[3]) + (v1[0] * v1[0] + v1[1] * v1[1]) + (v1[2] * v1[2] + v1[3] * v1[3]); \
                u32x4 w; w.x = cvt_pk_bf16(v0[0], v0[1]); w.y = cvt_pk_bf16(v0[2], v0[3]); w.z = cvt_pk_bf16(v1[0], v1[1]); w.w = cvt_pk_bf16(v1[2], v1[3]); wq[mm][bj] = w; } \
            ss += swz_xor<16>(ss); sq[mm] = half_sum(ss); } asm volatile("" ::: "memory"); } while (0)
#define EO_STORE(q) do { _Pragma("unroll") for (int mm = 0; mm < 2; ++mm) { const int ai_ = (q) >> 1, m_ = 2 * ((q) & 1) + mm; if (!((rmask >> (ai_ * 4 + m_)) & 1u)) continue; \
            const int row = row0 + ai_ * HALF + m_ * 16; const size_t off = (size_t)row * DM + col0; \
            _Pragma("unroll") for (int bj = 0; bj < 2; ++bj) *(u32x4*)(X1B + off + bj * HALF) = wq[mm][bj]; \
            if (fq == 0) __hip_atomic_fetch_add(rowss + row, sq[mm], __ATOMIC_RELAXED, __HIP_MEMORY_SCOPE_AGENT); } asm volatile("" ::: "memory"); } while (0)
#pragma unroll
        for (int mm = 0; mm < 2; ++mm)
#pragma unroll
            for (int bj = 0; bj < 2; ++bj)
#pragma unroll
                for (int n = 0; n < 2; ++n) { xa[mm][bj][n] = (f32x4){0.f, 0.f, 0.f, 0.f}; xb[mm][bj][n] = (f32x4){0.f, 0.f, 0.f, 0.f}; }
        EO_LOAD(xa, 0); EO_LOAD(xb, 1);
        EO_CALC(xa, 0); EO_LOAD(xa, 2); EO_STORE(0);
        EO_CALC(xb, 1); EO_LOAD(xb, 3); EO_STORE(1);
        EO_CALC(xa, 2); EO_STORE(2);
        EO_CALC(xb, 3); EO_STORE(3);
#undef EO_LOAD
#undef EO_CALC
#undef EO_STORE
    }
};
struct EpiUp {
    static constexpr int PREF = 1;
    bf16_t* O; const float* rowss; LAS float* rsl;
    __device__ __forceinline__ void prefetch(const Unit& u, int par, int wid, int lane) const {
        if (wid < 4) __builtin_amdgcn_global_load_lds((const unsigned*)(rowss + u.pm * BM + wid * 64 + lane), (LAS unsigned*)(rsl + par * 256 + wid * 64), 4, 0, 0);
    }
    __device__ __forceinline__ void operator()(const f32x4 (&acc)[2][2][4][2], const Unit& u, int wr, int wc, int fr, int fq, unsigned rmask = 0xffu, int par = -1) const {
        const int row0 = u.pm * BM + wr * 64 + fr, col0 = u.pn * BM + wc * 32 + 8 * fq;
#pragma unroll
        for (int ai = 0; ai < 2; ++ai)
#pragma unroll
            for (int m = 0; m < 4; ++m) { if (!((rmask >> (ai * 4 + m)) & 1u)) continue; const int row = row0 + ai * HALF + m * 16; bf16_t* rowp = O + (size_t)row * DFF + col0;
                const float ssq = par >= 0 ? rsl[par * 256 + wr * 64 + fr + ai * HALF + m * 16] : rowss[row];
                const float rs = __builtin_amdgcn_rsqf(ssq * (1.0f / DM) + EPS);
#pragma unroll
                for (int bj = 0; bj < 2; ++bj) { f32x4 v0 = acc[ai][bj][m][0] * rs, v1 = acc[ai][bj][m][1] * rs;
#pragma unroll
                    for (int j = 0; j < 4; ++j) { v0[j] = fmaxf(v0[j], 0.f); v1[j] = fmaxf(v1[j], 0.f); }
                    v0 = v0 * v0; v1 = v1 * v1;
                    u32x4 w; w.x = cvt_pk_bf16(v0[0], v0[1]); w.y = cvt_pk_bf16(v0[2], v0[3]); w.z = cvt_pk_bf16(v1[0], v1[1]); w.w = cvt_pk_bf16(v1[2], v1[3]);
                    *(u32x4*)(rowp + bj * HALF) = w; } }
    }
};
struct EpiDown {
    static constexpr int PREF = 0;
    const bf16_t* X1B; float* Y;
    __device__ __forceinline__ void operator()(const f32x4 (&acc)[2][2][4][2], const Unit& u, int wr, int wc, int fr, int fq, unsigned rmask = 0xffu) const {
        const int row0 = u.pm * BM + wr * 64 + fr, col0 = u.pn * BM + wc * 32 + 8 * fq;
        u32x4 xv[2][4][2];
#pragma unroll
        for (int ai = 0; ai < 2; ++ai)
#pragma unroll
            for (int m = 0; m < 4; ++m)
#pragma unroll
                for (int bj = 0; bj < 2; ++bj) if ((rmask >> (ai * 4 + m)) & 1u) xv[ai][m][bj] = *(const u32x4*)(X1B + (size_t)(row0 + ai * HALF + m * 16) * DM + col0 + bj * HALF);
#pragma unroll
        for (int ai = 0; ai < 2; ++ai)
#pragma unroll
            for (int m = 0; m < 4; ++m)
#pragma unroll
                for (int bj = 0; bj < 2; ++bj) { if (!((rmask >> (ai * 4 + m)) & 1u)) continue; const u32x4 w = xv[ai][m][bj]; float* p = Y + (size_t)(row0 + ai * HALF + m * 16) * DM + col0 + bj * HALF;
                    *(f32x4*)p = (f32x4){bf_lo(w.x), bf_hi(w.x), bf_lo(w.y), bf_hi(w.y)} + acc[ai][bj][m][0];
                    *(f32x4*)(p + 4) = (f32x4){bf_lo(w.z), bf_hi(w.z), bf_lo(w.w), bf_hi(w.w)} + acc[ai][bj][m][1]; }
    }
};
}

namespace att {
constexpr int D = 128, NW = 8, QBLK = 32, KVBLK = 64, QB = NW * QBLK;
constexpr int SHM_V = KVBLK * D * 2, SHM_K = KVBLK * D * 2;
constexpr int OFF_K = 2 * SHM_V, OFF_WS = 2 * SHM_V + 2 * SHM_K, OFF_CB = OFF_WS + NW * 64 * 4, LDS_NEED = OFF_CB + 8192 * 4;
constexpr int PO = DM;
constexpr float THR2 = 8.f * LOG2E;
typedef LAS char* lptr;
#define KSWZ(row, colB) ((row) * 256 + ((colB) ^ (((row) & 7) << 4)))
#define SBAR() __builtin_amdgcn_sched_barrier(0)
__device__ __forceinline__ int v_st(int k, int c) { const int kk = (k & ~0xC) | ((k & 4) << 1) | ((k & 8) >> 1); return ((kk >> 3) * 4 + (c >> 5)) * 512 + ((kk & 7) * 32 + (c & 31)) * 2; }
__device__ __forceinline__ int v_rd_base(int lane) { return ((lane & 3) << 3) | (((lane >> 2) & 3) << 6) | (((lane >> 4) & 1) << 5) | (((lane >> 5) & 1) << 8); }
constexpr int v_rd_off(int d0, int ks, int half) { return d0 * 512 + ks * 4096 + half * 2048; }
__device__ __forceinline__ int crow(int r, int hi) { return (r & 3) + 8 * (r >> 2) + 4 * hi; }
__device__ __forceinline__ bf16x8 load8(const bf16_t* p) { return *reinterpret_cast<const bf16x8*>(p); }
__device__ __forceinline__ void mask_tile(f32x16& p0, f32x16& p1, int dq) {
    const float NEG = -__builtin_inff();
#pragma unroll
    for (int r = 0; r < 16; ++r) { const int c = (r & 3) + 8 * (r >> 2);
        if (dq - c < 0) p0[r] = NEG;
        if (dq - c - 32 < 0) p1[r] = NEG; }
}
__device__ __forceinline__ void partialSM(f32x16& p0, f32x16& p1, float& m_reg, float& mn, float& alpha) {
    float pmax = p0[0];
#pragma unroll
    for (int r = 1; r < 16; ++r) pmax = fmaxf(pmax, p0[r]);
#pragma unroll
    for (int r = 0; r < 16; ++r) pmax = fmaxf(pmax, p1[r]);
    { auto rr = __builtin_amdgcn_permlane32_swap(__float_as_uint(pmax), __float_as_uint(pmax), false, false);
      pmax = fmaxf(__uint_as_float(rr[0]), __uint_as_float(rr[1])); }
    if (__builtin_expect(__all((pmax - m_reg) <= THR2), 1)) { mn = m_reg; alpha = 1.f; }
    else { mn = fmaxf(m_reg, pmax); alpha = __builtin_amdgcn_exp2f(m_reg - mn); m_reg = mn; }
#pragma unroll
    for (int r = 0; r < 16; ++r) p0[r] = p0[r] - mn;
#pragma unroll
    for (int r = 0; r < 16; ++r) p1[r] = p1[r] - mn;
#pragma unroll
    for (int r = 0; r < 16; ++r) p0[r] = __builtin_amdgcn_exp2f(p0[r]);
}
__device__ __forceinline__ void finishSM(f32x16& p0, f32x16& p1, float alpha, float& l_reg, bf16x8& pa0, bf16x8& pa1, bf16x8& pa2, bf16x8& pa3) {
#pragma unroll
    for (int r = 0; r < 16; ++r) p1[r] = __builtin_amdgcn_exp2f(p1[r]);
    float ps = 0;
#pragma unroll
    for (int r = 0; r < 16; ++r) ps += p0[r];
#pragma unroll
    for (int r = 0; r < 16; ++r) ps += p1[r];
    { auto rr = __builtin_amdgcn_permlane32_swap(__float_as_uint(ps), __float_as_uint(ps), false, false);
      ps = __uint_as_float(rr[0]) + __uint_as_float(rr[1]); }
    l_reg = l_reg * alpha + ps;
#define PK4(P, B_, OUT) do { unsigned a0 = cvt_pk_bf16(P[B_+0], P[B_+1]), a1 = cvt_pk_bf16(P[B_+2], P[B_+3]);                          \
        unsigned b0 = cvt_pk_bf16(P[B_+4], P[B_+5]), b1 = cvt_pk_bf16(P[B_+6], P[B_+7]);                                             \
        auto r0 = __builtin_amdgcn_permlane32_swap(a0, b0, false, false); auto r1 = __builtin_amdgcn_permlane32_swap(a1, b1, false, false); \
        u32x4 w = {r0[0], r1[0], r0[1], r1[1]}; OUT = __builtin_bit_cast(bf16x8, w); } while (0)
    PK4(p0, 0, pa0); PK4(p0, 8, pa1); PK4(p1, 0, pa2); PK4(p1, 8, pa3);
}
template <int KB>
__device__ __forceinline__ void qkt(f32x16& p0, f32x16& p1, lptr K_lds, const LAS float* cbt, int r32, int hi, const bf16x8* qr) {
#pragma unroll
    for (int i = 0; i < 4; ++i) { const f32x4 b0 = *(const LAS f32x4*)(cbt + 8 * i), b1 = *(const LAS f32x4*)(cbt + 32 + 8 * i);
        p0[4 * i] = b0[0]; p0[4 * i + 1] = b0[1]; p0[4 * i + 2] = b0[2]; p0[4 * i + 3] = b0[3];
        p1[4 * i] = b1[0]; p1[4 * i + 1] = b1[1]; p1[4 * i + 2] = b1[2]; p1[4 * i + 3] = b1[3]; }
    lptr kb[4];
#pragma unroll
    for (int dd = 0; dd < 4; ++dd) kb[dd] = K_lds + KB * SHM_K + KSWZ(r32, (dd * 16 + hi * 8) * 2);
#pragma unroll
    for (int d0 = 0; d0 < 8; ++d0) { lptr a = kb[d0 & 3] + (d0 >> 2) * 128;
        bf16x8 b0 = *reinterpret_cast<const LAS bf16x8*>(a);
        bf16x8 b1 = *reinterpret_cast<const LAS bf16x8*>(a + 32 * 256);
        p0 = __builtin_amdgcn_mfma_f32_32x32x16_bf16(b0, qr[d0], p0, 0, 0, 0);
        p1 = __builtin_amdgcn_mfma_f32_32x32x16_bf16(b1, qr[d0], p1, 0, 0, 0); }
}
template <int VB>
__device__ __forceinline__ void pv_tile(f32x16* o, int vb0, bf16x8 pa0, bf16x8 pa1, bf16x8 pa2, bf16x8 pa3) {
#define TRRD(dst, off) asm volatile("ds_read_b64_tr_b16 %0, %1 offset:%2" : "=&v"(dst) : "v"(vb0), "i"(off) : "memory")
#define PV_D0(d0) do { s16x4 l0, l1, l2, l3, h0, h1, h2, h3; constexpr int b_ = VB * SHM_V + v_rd_off(d0, 0, 0);   \
        TRRD(l0, b_); TRRD(h0, b_ + 2048); TRRD(l1, b_ + 4096); TRRD(h1, b_ + 6144); TRRD(l2, b_ + 8192); TRRD(h2, b_ + 10240); TRRD(l3, b_ + 12288); TRRD(h3, b_ + 14336); \
        asm volatile("s_waitcnt lgkmcnt(0)" ::: "memory"); SBAR();   \
        o[d0] = __builtin_amdgcn_mfma_f32_32x32x16_bf16(pa0, (bf16x8){l0[0], l0[1], l0[2], l0[3], h0[0], h0[1], h0[2], h0[3]}, o[d0], 0, 0, 0);   \
        o[d0] = __builtin_amdgcn_mfma_f32_32x32x16_bf16(pa1, (bf16x8){l1[0], l1[1], l1[2], l1[3], h1[0], h1[1], h1[2], h1[3]}, o[d0], 0, 0, 0);   \
        o[d0] = __builtin_amdgcn_mfma_f32_32x32x16_bf16(pa2, (bf16x8){l2[0], l2[1], l2[2], l2[3], h2[0], h2[1], h2[2], h2[3]}, o[d0], 0, 0, 0);   \
        o[d0] = __builtin_amdgcn_mfma_f32_32x32x16_bf16(pa3, (bf16x8){l3[0], l3[1], l3[2], l3[3], h3[0], h3[1], h3[2], h3[3]}, o[d0], 0, 0, 0); } while (0)
    PV_D0(0); PV_D0(1); PV_D0(2); PV_D0(3);
#undef PV_D0
#undef TRRD
}
struct Blk { int h, qb, jlo; };
struct Seam { bf16x8 qr[8]; bf16x8 st_v0, st_v1, st_k0, st_k1; };
#define VMW() asm volatile("s_waitcnt vmcnt(0)" ::: "memory")
#define VMWN(n) asm volatile("s_waitcnt vmcnt(%0)" :: "i"(n) : "memory")
#define SLOAD_H(hh, k0) do { const bf16_t* kt_ = PROJ + (size_t)(k0) * PP + (PW + AW) + (hh) * HD;                                         \
                         S.st_v0 = load8(kt_ + AW + toff); S.st_v1 = load8(kt_ + AW + 32 * PP + toff);                                      \
                         S.st_k0 = load8(kt_ + toff); S.st_k1 = load8(kt_ + 32 * PP + toff); } while (0)
#define QLOAD(hh, qq) do { const bf16_t* qt_ = PROJ + (size_t)((qq) * QB + wid * QBLK) * PP + PW + (hh) * HD;                                \
                         _Pragma("unroll") for (int d0 = 0; d0 < 8; ++d0) S.qr[d0] = load8(qt_ + qoff + d0 * 16); } while (0)
#define SWRITE_HK(bf) do { *(LAS bf16x8*)(K_lds + (bf) * SHM_K + kws) = S.st_k0; *(LAS bf16x8*)(K_lds + (bf) * SHM_K + kws + 32 * 256) = S.st_k1; } while (0)
#define SWRITE_HV(bf) do { *(LAS bf16x8*)(V_lds + (bf) * SHM_V + vst0) = S.st_v0; *(LAS bf16x8*)(V_lds + (bf) * SHM_V + vst1) = S.st_v1; } while (0)
#define SWRITE_H(bf) do { SWRITE_HV(bf); SWRITE_HK(bf); } while (0)
__device__ __forceinline__ void attn_prime(const Blk cur, const bf16_t* PROJ, lptr lds, Seam& S, const int wid) {
    const int lane = fresh_lane(), tid = wid * 64 + lane, r32 = lane & 31, hi = lane >> 5;
    const int sr = tid >> 4, sc = (tid & 15) * 8, kws = KSWZ(sr, sc * 2); lptr K_lds = lds + OFF_K;
    const unsigned toff = (unsigned)(sr * PP + sc), qoff = (unsigned)(r32 * PP + hi * 8);
    QLOAD(cur.h, cur.qb);
    SLOAD_H(cur.h, cur.jlo * KVBLK); VMW(); SWRITE_HK(0);
    __syncthreads();
}
__device__ __forceinline__ void attn_block(const Blk cur, const Blk nxt, const bf16_t* PROJ, bf16_t* MIX, const float* CB, lptr lds, Seam& S, const int wid) {
    const int lane = fresh_lane(), tid = wid * 64 + lane, r32 = lane & 31, hi = lane >> 5;
    const int P0 = cur.qb * QB, j_lo = cur.jlo, j_hi = (P0 + QB - 1) / KVBLK + 1;
    const int NT = j_hi - j_lo;
    const int qlo = P0 + wid * QBLK, qm = qlo + r32 - 4 * hi;
    lptr V_lds = lds; lptr K_lds = lds + OFF_K;
    LAS float* ws = (LAS float*)(lds + OFF_WS) + wid * 64; LAS float* li_l = ws; LAS float* al_l = ws + 32;
    LAS float* cb = (LAS float*)(lds + OFF_CB);
    float m_reg = -1e30f, l_reg = 0; f32x16 o[4] = {};
    const int sr = tid >> 4, sc = (tid & 15) * 8, vst0 = v_st(sr, sc), vst1 = v_st(32 + sr, sc), kws = KSWZ(sr, sc * 2);
    const unsigned toff = (unsigned)(sr * PP + sc);
    const int vb0 = (int)(unsigned)(size_t)V_lds + v_rd_base(lane);
    const int hh = cur.h;
    { const float* c2 = CB + (size_t)hh * SEQ; const float cref = c2[P0]; const float* csrc = c2 + j_lo * KVBLK;
      for (int i = tid * 4; i < NT * KVBLK; i += 2048) { const f32x4 c = *(const f32x4*)(csrc + i); *(LAS f32x4*)(cb + i) = cref - c; }
      __syncthreads(); }
    const LAS float* cbl = cb + 4 * hi;
#define RESC(a) do { if (__any((a) < 1.f)) { if (hi == 0) al_l[r32] = (a); asm volatile("s_waitcnt lgkmcnt(0)" ::: "memory");              \
                     _Pragma("unroll") for (int d_ = 0; d_ < 4; ++d_) _Pragma("unroll") for (int r = 0; r < 16; ++r) o[d_][r] *= al_l[crow(r, hi)]; } } while (0)
#define KBASE(t) ((j_lo + (t)) * KVBLK)
#define MASKT(P0_, P1_, t) do { const int kb_ = KBASE(t); if (kb_ + KVBLK - 1 > qlo) mask_tile(P0_, P1_, qm - kb_); } while (0)
#define SEAM_K0() do { VMWN(8); SWRITE_HK(0); SBAR(); } while (0)
    f32x16 pA0, pA1, pB0, pB1; float mnA, mnB, alA, alB; bf16x8 pa0, pa1, pa2, pa3;
    SWRITE_HV(0); SBAR();
    if (NT > 1) { SLOAD_H(hh, KBASE(1)); }
    SBAR(); qkt<0>(pA0, pA1, K_lds, cbl, r32, hi, S.qr);
    MASKT(pA0, pA1, 0); partialSM(pA0, pA1, m_reg, mnA, alA);
    if (NT > 1) { VMW(); SWRITE_H(1); }
    __syncthreads();
#define HALF_STEP(PX0, PX1, mnX, alX, PY0, PY1, alY, t, KB, VB, SB) do {                                                      \
        SBAR(); qkt<KB>(PX0, PX1, K_lds, cbl + (t) * KVBLK, r32, hi, S.qr);                                                   \
        finishSM(PY0, PY1, alY, l_reg, pa0, pa1, pa2, pa3); SBAR();                                                           \
        if ((t) + 1 < NT) { SLOAD_H(hh, KBASE((t) + 1)); SBAR(); }                                                            \
        pv_tile<VB>(o, vb0, pa0, pa1, pa2, pa3); MASKT(PX0, PX1, (t)); partialSM(PX0, PX1, m_reg, mnX, alX);                   \
        __syncthreads();                                                                                                      \
        if ((t) + 1 < NT) { VMW(); SWRITE_H(SB); }                                                                            \
        RESC(alX); __syncthreads(); } while (0)
    for (int t = 1; t + 1 < NT; t += 2) {
        HALF_STEP(pB0, pB1, mnB, alB, pA0, pA1, alA, t, 1, 0, 0);
        HALF_STEP(pA0, pA1, mnA, alA, pB0, pB1, alB, t + 1, 0, 1, 1);
    }
    const bool even = (NT & 1) == 0;
    const int l2_ = fresh_lane(), r32b_ = l2_ & 31, hib_ = l2_ >> 5, qmb_ = qlo + r32b_ - 4 * hib_;
    { const int r32 = r32b_, hi = hib_, qm = qmb_;
    if (even) { SBAR(); qkt<1>(pB0, pB1, K_lds, cbl + (NT - 1) * KVBLK, r32, hi, S.qr); SBAR(); }
    SLOAD_H(nxt.h, nxt.jlo * KVBLK); SBAR();
    { const unsigned qoff = (unsigned)(r32 * PP + hi * 8); QLOAD(nxt.h, nxt.qb); }
    SBAR();
    finishSM(pA0, pA1, alA, l_reg, pa0, pa1, pa2, pa3); SBAR();
    pv_tile<0>(o, vb0, pa0, pa1, pa2, pa3);
    if (even) { MASKT(pB0, pB1, NT - 1); partialSM(pB0, pB1, m_reg, mnB, alB); __syncthreads(); RESC(alB);
        finishSM(pB0, pB1, alB, l_reg, pa0, pa1, pa2, pa3); SBAR(); pv_tile<1>(o, vb0, pa0, pa1, pa2, pa3); }
    SBAR(); SEAM_K0();
    if (hi == 0) li_l[r32] = l_reg; asm volatile("s_waitcnt lgkmcnt(0)" ::: "memory");
    bf16_t* Ow = MIX + (size_t)(P0 + wid * QBLK) * PO + PW + hh * HD;
    const unsigned ooff = (unsigned)(4 * hi * PO + r32);
#pragma unroll
    for (int r = 0; r < 16; ++r) { const float rl = __builtin_amdgcn_rcpf(li_l[crow(r, hi)]);
#pragma unroll
        for (int d0 = 0; d0 < 4; ++d0) { const float v = o[d0][r] * rl;
            const float vn = swz_xor<1>(v);
            if ((r32 & 1) == 0) *(unsigned*)(Ow + ooff + (unsigned)(((r & 3) + 8 * (r >> 2)) * PO + d0 * 32)) = cvt_pk_bf16(v, vn); } }
    }
    __syncthreads();
#undef RESC
#undef KBASE
#undef MASKT
#undef SEAM_K0
#undef HALF_STEP
}
#undef QLOAD
#undef SLOAD_H
#undef SWRITE_HK
#undef SWRITE_HV
#undef SWRITE_H

constexpr int SOFF_ML = 0, SOFF_Q = 2048, SOFF_KST = 10240, KST_BYTES = 16 * 1040, SOFF_OT = SOFF_KST  , SLDS_NEED = SOFF_KST + 8 * KST_BYTES;
static_assert(SLDS_NEED <= MISC_OFF && SOFF_OT + 8 * 64 * 32 * 4 <= MISC_OFF, "sample attention LDS map");
template <bool NEWK>
__device__ __forceinline__ bool samp_chunk(const bool vlate, const float* Kc, const float* Vc, const bf16_t* Kn, const bf16_t* Vn, const float* bias, const LAS char* qlds, LAS char* kst, int lane,
                                           float& m_reg, float& l_reg, f32x16* oT, int r32, int hi) {
    f32x4 kr[16]; float vr[2][4][8]; bf16x8 kf[8]; short vn[2][4][8];
    if constexpr (NEWK) {
#pragma unroll
        for (int d0 = 0; d0 < 8; ++d0) kf[d0] = load8(Kn + (size_t)r32 * PP + d0 * 16 + hi * 8);
#pragma unroll
        for (int ks = 0; ks < 2; ++ks)
#pragma unroll
            for (int d0 = 0; d0 < 4; ++d0)
#pragma unroll
                for (int j = 0; j < 8; ++j) vn[ks][d0][j] = (short)Vn[(size_t)(16 * ks + 8 * hi + j) * PP + 32 * d0 + r32];
    } else {
        const float* kp = Kc + (size_t)(lane >> 5) * (NH * HD) + 4 * (lane & 31);
#pragma unroll
        for (int i = 0; i < 16; ++i) kr[i] = __builtin_nontemporal_load((const f32x4*)(kp + (size_t)(2 * i) * (NH * HD)));
        if (!vlate) {
            const float* vp = Vc + (size_t)(8 * hi) * (NH * HD) + r32;
#pragma unroll
            for (int ks = 0; ks < 2; ++ks)
#pragma unroll
                for (int d0 = 0; d0 < 4; ++d0)
#pragma unroll
                    for (int j = 0; j < 8; ++j) vr[ks][d0][j] = __builtin_nontemporal_load(vp + (size_t)(16 * ks + j) * (NH * HD) + 32 * d0);
        }
    }
    asm volatile("" ::: "memory");
    f32x16 s;
#pragma unroll
    for (int i = 0; i < 4; ++i) { const f32x4 b = *(const f32x4*)(bias + 8 * i + 4 * hi); s[4 * i] = b[0]; s[4 * i + 1] = b[1]; s[4 * i + 2] = b[2]; s[4 * i + 3] = b[3]; }
    if constexpr (!NEWK) {
#pragma unroll
        for (int i = 0; i < 16; ++i) *(LAS f32x4*)(kst + i * 1040 + lane * 16) = kr[i];
        const LAS char* kf_src = kst + (r32 >> 1) * 1040 + (r32 & 1) * 512 + hi * 32;
#pragma unroll
        for (int hf = 0; hf < 2; ++hf) {
            bf16x8 kh[4];
#pragma unroll
            for (int d = 0; d < 4; ++d) kh[d] = pack8(*(const LAS f32x4*)(kf_src + (4 * hf + d) * 64), *(const LAS f32x4*)(kf_src + (4 * hf + d) * 64 + 16));
#pragma unroll
            for (int d = 0; d < 4; ++d) s = __builtin_amdgcn_mfma_f32_32x32x16_bf16(kh[d], *(const LAS bf16x8*)(qlds + (4 * hf + d) * 1024), s, 0, 0, 0);
            asm volatile("" ::: "memory"); }
    } else {
#pragma unroll
        for (int d0 = 0; d0 < 8; ++d0) s = __builtin_amdgcn_mfma_f32_32x32x16_bf16(kf[d0], *(const LAS bf16x8*)(qlds + d0 * 1024), s, 0, 0, 0);
    }
    if constexpr (NEWK) {
        const float NEG = -__builtin_inff();
#pragma unroll
        for (int r = 0; r < 16; ++r) if (crow(r, hi) > r32) s[r] = NEG;
    }
    float pmax = s[0];
#pragma unroll
    for (int r = 1; r < 16; ++r) pmax = fmaxf(pmax, s[r]);
    { auto rr = __builtin_amdgcn_permlane32_swap(__float_as_uint(pmax), __float_as_uint(pmax), false, false); pmax = fmaxf(__uint_as_float(rr[0]), __uint_as_float(rr[1])); }
    const float mn = fmaxf(m_reg, pmax), alpha = __builtin_amdgcn_exp2f(m_reg - mn); m_reg = mn;
    float ps = 0.f;
#pragma unroll
    for (int r = 0; r < 16; ++r) { s[r] = __builtin_amdgcn_exp2f(s[r] - mn); ps += s[r]; }
    { auto rr = __builtin_amdgcn_permlane32_swap(__float_as_uint(ps), __float_as_uint(ps), false, false); ps = __uint_as_float(rr[0]) + __uint_as_float(rr[1]); }
    l_reg = l_reg * alpha + ps;
    if (__any(alpha < 1.f)) {
#pragma unroll
        for (int d0 = 0; d0 < 4; ++d0) oT[d0] = oT[d0] * alpha;
    }
    const bool allzero = __all(ps == 0.f);
    if constexpr (!NEWK) {
        if (allzero) return true;
        if (vlate) {
            const float* vp = Vc + (size_t)(8 * hi) * (NH * HD) + r32;
#pragma unroll
            for (int ks = 0; ks < 2; ++ks)
#pragma unroll
                for (int d0 = 0; d0 < 4; ++d0)
#pragma unroll
                    for (int j = 0; j < 8; ++j) vr[ks][d0][j] = __builtin_nontemporal_load(vp + (size_t)(16 * ks + j) * (NH * HD) + 32 * d0);
        }
    }
    bf16x8 pa0, pa1; PK4(s, 0, pa0); PK4(s, 8, pa1);
#pragma unroll
    for (int ks = 0; ks < 2; ++ks) {
#pragma unroll
        for (int d0 = 0; d0 < 4; ++d0) {
            bf16x8 vf;
            if constexpr (NEWK) { const short* e = vn[ks][d0]; vf = (bf16x8){e[0], e[1], e[2], e[3], e[4], e[5], e[6], e[7]}; }
            else { const float* e = vr[ks][d0]; vf = pack8((f32x4){e[0], e[1], e[2], e[3]}, (f32x4){e[4], e[5], e[6], e[7]}); }
            oT[d0] = __builtin_amdgcn_mfma_f32_32x32x16_bf16(vf, ks == 0 ? pa0 : pa1, oT[d0], 0, 0, 0);
        }
    }
    return allzero;
}
#undef PK4
__device__ __forceinline__ void samp_unit(int b, int h, const bf16_t* PROJ, const float* cache_k, const float* cache_v, const float* CS, bf16_t* MIX, lptr lds, const int wid) {
    const int lane = fresh_lane(), tid = wid * 64 + lane, r32 = lane & 31, hi = lane >> 5;
    const bf16_t* Qp = PROJ + (size_t)(MP + b * DS) * PP + PW + h * HD;
    const bf16_t* Kn = PROJ + (size_t)(MP + b * DS) * PP + PW + AW + h * HD;
    const bf16_t* Vn = PROJ + (size_t)(MP + b * DS) * PP + PW + 2 * AW + h * HD;
    const float* bias = CS + (size_t)(b * NH + h) * 2080;
    { const bf16x8 q = load8(Qp + (size_t)r32 * PP + wid * 16 + hi * 8); *(LAS bf16x8*)(lds + SOFF_Q + wid * 1024 + lane * 16) = q; }
    asm volatile("s_waitcnt lgkmcnt(0)" ::: "memory"); __syncthreads();
    const LAS char* qlds = lds + SOFF_Q + lane * 16; LAS char* kst = lds + SOFF_KST + wid * KST_BYTES;
    float m_reg;
    { const bf16_t* qrow = Qp + (size_t)r32 * PP + hi * 64; const bf16_t* krow = Kn + (size_t)r32 * PP + hi * 64; float dsum = 0.f;
#pragma unroll
      for (int j = 0; j < 8; ++j) { const u32x4 qa = *(const u32x4*)(qrow + 8 * j), ka = *(const u32x4*)(krow + 8 * j);
#pragma unroll
          for (int e = 0; e < 4; ++e) dsum += bf_lo(qa[e]) * bf_lo(ka[e]) + bf_hi(qa[e]) * bf_hi(ka[e]); }
      m_reg = half_sum(dsum) + bias[PAST + r32] - 1.0f; }
    float l_reg = 0.f; f32x16 oT[4] = {};
    if (wid == 7) samp_chunk<true>(false, nullptr, nullptr, Kn, Vn, bias + PAST, qlds, kst, lane, m_reg, l_reg, oT, r32, hi);
    bool vlate = false;
    size_t koff = ((size_t)(b * PAST + wid * 32 + 7 * 256) * NH + h) * HD; const float* bp = bias + wid * 32 + 7 * 256;
#pragma unroll 1
    for (int c = 7; c >= 0; --c) {
        vlate = samp_chunk<false>(vlate, cache_k + koff, cache_v + koff, nullptr, nullptr, bp, qlds, kst, lane, m_reg, l_reg, oT, r32, hi) || vlate;
        koff -= (size_t)256 * NH * HD; bp -= 256; }
    LAS float* ML = (LAS float*)(lds + SOFF_ML); LAS float* OT = (LAS float*)(lds + SOFF_OT);
    if (hi == 0) { ML[(wid * 32 + r32) * 2] = m_reg; ML[(wid * 32 + r32) * 2 + 1] = l_reg; }
    __syncthreads();
    float Mx = -1e30f;
#pragma unroll
    for (int w = 0; w < 8; ++w) Mx = fmaxf(Mx, ML[(w * 32 + r32) * 2]);
    float L = 0.f;
#pragma unroll
    for (int w = 0; w < 8; ++w) L += ML[(w * 32 + r32) * 2 + 1] * __builtin_amdgcn_exp2f(ML[(w * 32 + r32) * 2] - Mx);
    const float f = __builtin_amdgcn_exp2f(m_reg - Mx) / L;
#pragma unroll
    for (int half = 0; half < 2; ++half) {
#pragma unroll
        for (int dd = 0; dd < 2; ++dd)
#pragma unroll
            for (int r = 0; r < 16; ++r) OT[(wid * 64 + dd * 32 + crow(r, hi)) * 32 + r32] = oT[half * 2 + dd][r] * f;
        __syncthreads();
        float acc4[4] = {0.f, 0.f, 0.f, 0.f};
#pragma unroll
        for (int w = 0; w < 8; ++w)
#pragma unroll
            for (int j = 0; j < 4; ++j) acc4[j] += OT[(w * 64 + 8 * wid + 4 * hi + j) * 32 + r32];
        u32x2 o2; o2.x = cvt_pk_bf16(acc4[0], acc4[1]); o2.y = cvt_pk_bf16(acc4[2], acc4[3]);
        *(u32x2*)(MIX + (size_t)(MP + b * DS + r32) * DM + PW + h * HD + half * 64 + 8 * wid + 4 * hi) = o2;
        __syncthreads();
    }
}
}

#define XB_TMO      128
#define XB_XCNT(j)  (256  + 64 * (j))
#define XB_XSUB(j)  (1280 + 64 * (j))
#define XB_XGEN(j)  (2304 + 64 * (j))
#define XB_TOP      3328
#define XB_TOPGEN   3392
#define XCD_BAR_WORDS 3456
#define XB_SPIN_CAP (1u << 22)
__device__ __forceinline__ unsigned xb_ld(unsigned* p)              { return __hip_atomic_load(p, __ATOMIC_RELAXED, __HIP_MEMORY_SCOPE_AGENT); }
__device__ __forceinline__ unsigned xb_add(unsigned* p, unsigned v) { return __hip_atomic_fetch_add(p, v, __ATOMIC_RELAXED, __HIP_MEMORY_SCOPE_AGENT); }
__device__ __forceinline__ unsigned xb_xcc_id() { return (unsigned)__builtin_amdgcn_s_getreg((3 << 11) | 20) & 0xFu; }
#define XB_SPIN(cond, bar) do { unsigned _sp = 0; while (cond) { __builtin_amdgcn_s_sleep(1); \
    if ((++_sp & 255u) == 0u) { if (xb_ld(&(bar)[XB_TMO])) break; if (_sp > XB_SPIN_CAP) { atomicAdd(&(bar)[XB_TMO], 1u); break; } } } } while (0)
struct XcdBarrier { unsigned* bar; unsigned x; volatile LAS unsigned* st; };
__device__ __forceinline__ XcdBarrier xcd_barrier_post(unsigned* bar, volatile LAS unsigned* st, bool leader) {
    XcdBarrier b; b.bar = bar; b.x = xb_xcc_id(); b.st = st;
    if (leader) (void)xb_add(&bar[XB_XCNT(b.x)], 1u);
    return b;
}
__device__ __forceinline__ void xcd_barrier_complete(unsigned* bar, unsigned x, unsigned& nloc, unsigned& nx) {
    const unsigned G = gridDim.x * gridDim.y * gridDim.z;
    unsigned sum, cnt, mine, sp = 0u;
    for (;;) {
        sum = 0u; cnt = 0u; mine = 0u;
#pragma unroll
        for (unsigned j = 0; j < 16; ++j) { const unsigned c = xb_ld(&bar[XB_XCNT(j)]); sum += c; cnt += (c > 0u) ? 1u : 0u; mine = (j == x) ? c : mine; }
        if (sum == G) break;
        __builtin_amdgcn_s_sleep(1);
        if ((++sp & 255u) == 0u) { if (xb_ld(&bar[XB_TMO])) break; if (sp > XB_SPIN_CAP) { atomicAdd(&bar[XB_TMO], 1u); break; } }
    }
    nloc = mine > 0u ? mine : 1u; nx = cnt > 0u ? cnt : 1u;
}
__device__ __forceinline__ void xcd_barrier(const XcdBarrier& b, bool leader) {
    asm volatile("s_waitcnt vmcnt(0)" ::: "memory");
    __syncthreads();
    if (leader) {
        unsigned* bar = b.bar;
        __builtin_amdgcn_s_waitcnt(0);
        unsigned nloc = b.st[0], nx = b.st[1];
        if (nloc == 0u) { xcd_barrier_complete(bar, b.x, nloc, nx); b.st[0] = nloc; b.st[1] = nx; }
        const unsigned old = xb_add(&bar[XB_XSUB(b.x)], 1u);
        const unsigned gen = old / nloc;
        if (old + 1u == (gen + 1u) * nloc) {
            __builtin_amdgcn_fence(__ATOMIC_RELEASE, "agent");
            asm volatile("s_waitcnt vmcnt(0)" ::: "memory");
            const unsigned og = xb_add(&bar[XB_TOP], 1u);
            const unsigned tg = og / nx;
            if (og + 1u == (tg + 1u) * nx) xb_add(&bar[XB_TOPGEN], 1u);
            else XB_SPIN(xb_ld(&bar[XB_TOPGEN]) == tg, bar);
            __builtin_amdgcn_fence(__ATOMIC_ACQUIRE, "agent");
            xb_add(&bar[XB_XGEN(b.x)], 1u);
            asm volatile("s_waitcnt vmcnt(0)" ::: "memory");
        } else {
            XB_SPIN(xb_ld(&bar[XB_XGEN(b.x)]) == gen, bar);
            __builtin_amdgcn_fence(__ATOMIC_ACQUIRE, "agent");
            asm volatile("s_waitcnt vmcnt(0)" ::: "memory");
        }
    }
    __syncthreads();
}

#ifndef PHASES
#define PHASES 0xfff
#endif
#ifndef TPROBE
#define TPROBE 0
#endif
#ifndef PROBE
#define PROBE 0
#endif
#define REPS(id) for (int rep_ = 0; rep_ < ((PROBE == (id)) ? 2 : 1); ++rep_)
struct Args {
    const float *x_prompt, *x_sample, *cache_k, *cache_v, *cache_logf, *state_pool, *attn_norm_g, *w_in, *b_f, *q_norm_g, *k_norm_g, *w_pool, *pool_scale, *w_out, *mlp_norm_g, *w_up, *w_down;
    float* out; unsigned char* ws;
};
__device__ __forceinline__ float wave_sum(float v) { v += swz_xor<1>(v); v += swz_xor<2>(v); v += swz_xor<4>(v); v += swz_xor<8>(v); v += swz_xor<16>(v); return half_sum(v); }
__device__ __forceinline__ float wave_max(float v) { v = fmaxf(v, swz_xor<1>(v)); v = fmaxf(v, swz_xor<2>(v)); v = fmaxf(v, swz_xor<4>(v)); v = fmaxf(v, swz_xor<8>(v)); v = fmaxf(v, swz_xor<16>(v)); return half_max(v); }
constexpr int TR_LDS = 64 * 33 * 4;
struct TrTile { const float* W; bf16_t* WT; const float* kscale; int K, N, kb, nb; };
__device__ __forceinline__ void tr_load(const TrTile& t, int lane, f32x4 (&ra)[8], f32x4 (&rb)[8]) {
    const int k0 = 64 * t.kb, n0 = 64 * t.nb, kq = lane >> 4, n4 = lane & 15;
    const bool okc = n0 + 4 * n4 < t.N;
    const float* src = t.W + (size_t)(k0 + 2 * kq) * t.N + n0 + 4 * n4;
#pragma unroll
    for (int j = 0; j < 8; ++j) {
        ra[j] = okc ? __builtin_nontemporal_load((const f32x4*)(src + (size_t)(8 * j) * t.N)) : (f32x4){0.f, 0.f, 0.f, 0.f};
        rb[j] = okc ? __builtin_nontemporal_load((const f32x4*)(src + (size_t)(8 * j + 1) * t.N)) : (f32x4){0.f, 0.f, 0.f, 0.f}; }
}
__device__ __forceinline__ void tr_store(const TrTile& t, int lane, const f32x4 (&ra)[8], const f32x4 (&rb)[8], LAS unsigned* scr) {
    const int k0 = 64 * t.kb, n0 = 64 * t.nb, kq = lane >> 4, n4 = lane & 15;
#pragma unroll
    for (int j = 0; j < 8; ++j) { const f32x2 gg = t.kscale ? *(const f32x2*)(t.kscale + k0 + 8 * j + 2 * kq) : (f32x2){1.f, 1.f};
#pragma unroll
        for (int e = 0; e < 4; ++e) scr[(4 * n4 + e) * 33 + 4 * j + kq] = cvt_pk_bf16(ra[j][e] * gg.x, rb[j][e] * gg.y); }
    const int c = lane & 7;
#pragma unroll
    for (int i = 0; i < 8; ++i) { const int n = (lane >> 3) + 8 * i; const LAS unsigned* p = scr + n * 33 + 4 * c;
        u32x4 o; o.x = p[0]; o.y = p[1]; o.z = p[2]; o.w = p[3];
        if (n0 + n < t.N) __builtin_nontemporal_store(o, (u32x4*)(t.WT + (size_t)(n0 + n) * t.K + k0 + 8 * c)); }
}
template <class F> __device__ __forceinline__ void transpose_stream(F tile_of, int first, int stride, int total, LAS unsigned* scr, int lane) {
    if (first >= total) return;
    f32x4 ra[8], rb[8], na[8], nb[8];
    TrTile ta = tile_of(first), tb = ta; tr_load(ta, lane, ra, rb);
    bool hb = first + stride < total; if (hb) { tb = tile_of(first + stride); tr_load(tb, lane, na, nb); }
    for (int it = first + 2 * stride;; it += 2 * stride) {
        tr_store(ta, lane, ra, rb, scr);
        const bool ha = it < total; if (ha) { ta = tile_of(it); tr_load(ta, lane, ra, rb); }
        if (hb) tr_store(tb, lane, na, nb, scr);
        if (!ha) break;
        hb = it + stride < total; if (hb) { tb = tile_of(it + stride); tr_load(tb, lane, na, nb); }
    }
}

template <int W>
__device__ __forceinline__ void pool_task16(const bf16_t* PROJ, const float* state_pool, bf16_t* DP, int r0, int g, int lane) {
    const bool samp = r0 >= MP; const int b = samp ? (r0 - MP) / DS : 0, s0 = samp ? (r0 - MP) % DS : r0;
    const int col = g * PG + 8 * lane;
    u32x4 R[W + 15];
#pragma unroll
    for (int i = 0; i < W + 15; ++i) { const int se = s0 - (W - 1) + i;
        if (se >= 0) R[i] = *(const u32x4*)(PROJ + (size_t)(r0 - (W - 1) + i) * PP + col);
        else if (samp) { const float* sp = state_pool + ((size_t)b * PH + (PH + se)) * PW + col; const f32x4 x0 = *(const f32x4*)sp, x1 = *(const f32x4*)(sp + 4);
            R[i] = (u32x4){cvt_pk_bf16(x0[0], x0[1]), cvt_pk_bf16(x0[2], x0[3]), cvt_pk_bf16(x1[0], x1[1]), cvt_pk_bf16(x1[2], x1[3])}; }
        else R[i] = (u32x4){0u, 0u, 0u, 0u}; }
    float Sx[8];
#pragma unroll
    for (int i = 0; i < 8; ++i) Sx[i] = 0.f;
#pragma unroll
    for (int i = 0; i < W - 1; ++i)
#pragma unroll
        for (int c = 0; c < 4; ++c) { Sx[2 * c] += bf_lo(R[i][c]); Sx[2 * c + 1] += bf_hi(R[i][c]); }
#pragma unroll
    for (int e = 0; e < 16; ++e) {
        float cur[8], d[8];
#pragma unroll
        for (int c = 0; c < 4; ++c) { cur[2 * c] = bf_lo(R[W - 1 + e][c]); cur[2 * c + 1] = bf_hi(R[W - 1 + e][c]); }
#pragma unroll
        for (int i = 0; i < 8; ++i) Sx[i] += cur[i];
        float ic = 1.0f / (float)W; if (!samp && s0 + e + 1 < W) ic = 1.0f / (float)(s0 + e + 1);
#pragma unroll
        for (int i = 0; i < 8; ++i) d[i] = Sx[i] * ic - cur[i];
        u32x4 o; o.x = cvt_pk_bf16(d[0], d[1]); o.y = cvt_pk_bf16(d[2], d[3]); o.z = cvt_pk_bf16(d[4], d[5]); o.w = cvt_pk_bf16(d[6], d[7]);
        *(u32x4*)(DP + (size_t)(r0 + e) * PW + col) = o;
#pragma unroll
        for (int c = 0; c < 4; ++c) { Sx[2 * c] -= bf_lo(R[e][c]); Sx[2 * c + 1] -= bf_hi(R[e][c]); }
    }
}
__device__ __forceinline__ float log_sigmoid(float x) { return fminf(x, 0.f) - log1pf(__expf(-fabsf(x))); }

typedef const __attribute__((address_space(4))) Args* ArgP;
__device__ __forceinline__ ArgP argp() { ArgP p = (ArgP)__builtin_amdgcn_kernarg_segment_ptr(); asm volatile("" : "+s"(p)); return p; }
__global__ void __launch_bounds__(512, 2) hymba_fwd(Args a) {
    extern __shared__ __attribute__((aligned(16))) unsigned char lds_raw[];
    LAS unsigned char* lds = (LAS unsigned char*)lds_raw;
    volatile LAS unsigned* MISC = (volatile LAS unsigned*)(lds + MISC_OFF);
    const int wave = __builtin_amdgcn_readfirstlane((int)threadIdx.x >> 6);
    const int G = gridDim.x; const int bx = blockIdx.x; const int vcu = (G % 8 == 0) ? (bx % 8) * (G / 8) + bx / 8 : bx;
    ArgP AP = argp();
    unsigned char* ws = AP->ws;
    unsigned* ctl = (unsigned*)(ws + WS_CTL);
    bf16_t* WI = (bf16_t*)(ws + WS_WI); bf16_t* WP = (bf16_t*)(ws + WS_WP); bf16_t* WO = (bf16_t*)(ws + WS_WO); bf16_t* WU = (bf16_t*)(ws + WS_WU); bf16_t* WD = (bf16_t*)(ws + WS_WD);
    bf16_t* XN = (bf16_t*)(ws + WS_XN); bf16_t* PROJ = (bf16_t*)(ws + WS_PROJ); float* FL = (float*)(ws + WS_FL); float* CB = (float*)(ws + WS_CB); float* CS = (float*)(ws + WS_CS);
    bf16_t* DP = (bf16_t*)(ws + WS_DP); bf16_t* MIX = (bf16_t*)(ws + WS_MIX); bf16_t* X1G = (bf16_t*)(ws + WS_X1G); bf16_t* HID = (bf16_t*)(ws + WS_HID); float* PART = (float*)(ws + WS_PART);
    int* JLO = (int*)(ctl + CW_JLO); float* RSS = (float*)(ctl + CW_RSS);
    float* out = AP->out;
    for (int u = wave * 64 + fresh_lane(); u < (LDS_BYTES - 131072) / 4; u += 512) ((LAS unsigned*)(lds + 131072))[u] = 0u;
    __syncthreads();
    XcdBarrier bar = xcd_barrier_post(ctl + CW_BAR, MISC + 8, wave == 0 && fresh_lane() == 0);
    const int gw = vcu * 8 + wave, NGW = G * 8;
    if (TPROBE != 0 && wave == 0 && fresh_lane() == 0) { volatile LAS unsigned long long* stw = (volatile LAS unsigned long long*)(lds + 143424); stw[16] = (unsigned long long)wall_clock64(); }

    AP = argp();
    REPS(1) {
        const int lane = fresh_lane();
        LAS unsigned* scr = (LAS unsigned*)(lds + wave * TR_LDS);
        constexpr int NB_I = (NPROJ + 63) / 64, I_I = (DM / 64) * NB_I, I_P = 4 * (PG / 64) * (PG / 64), I_O = (DM / 64) * (DM / 64);
        constexpr int NITEMS = I_I + I_P + I_O;
        transpose_stream([&](int it) { TrTile t; int r = it;
            t.kscale = nullptr;
            if (r < I_I) { t.W = AP->w_in; t.WT = WI; t.K = DM; t.N = NPROJ; t.kb = r / NB_I; t.nb = r % NB_I; return t; } r -= I_I;
            if (r < I_P) { const int g = r / ((PG / 64) * (PG / 64)), q = r % ((PG / 64) * (PG / 64)); t.W = AP->w_pool + (size_t)g * PG * PG; t.WT = WP + (size_t)g * PG * PG; t.K = PG; t.N = PG; t.kb = q / (PG / 64); t.nb = q % (PG / 64); return t; } r -= I_P;
            t.W = AP->w_out; t.WT = WO; t.K = DM; t.N = DM; t.kb = r / (DM / 64); t.nb = r % (DM / 64); return t; }, gw, NGW, NITEMS, scr, lane);
        {
            const int m0 = gw + ((NITEMS - gw + NGW - 1) / NGW) * NGW - NITEMS;
            f32x4 v[16], vn[16], gv[16];
#pragma unroll
            for (int j = 0; j < 16; ++j) gv[j] = *(const f32x4*)(AP->attn_norm_g + 256 * j + 4 * lane);
            if (m0 < M) { const float* xrow = (m0 < MP) ? AP->x_prompt + (size_t)m0 * DM : AP->x_sample + (size_t)(m0 - MP) * DM;
#pragma unroll
                for (int j = 0; j < 16; ++j) v[j] = __builtin_nontemporal_load((const f32x4*)(xrow + 256 * j + 4 * lane)); }
            for (int m = m0; m < M; m += NGW) {
                const int mn = m + NGW;
                if (mn < M) { const float* xrow = (mn < MP) ? AP->x_prompt + (size_t)mn * DM : AP->x_sample + (size_t)(mn - MP) * DM;
#pragma unroll
                    for (int j = 0; j < 16; ++j) vn[j] = __builtin_nontemporal_load((const f32x4*)(xrow + 256 * j + 4 * lane)); }
                float s = 0.f;
#pragma unroll
                for (int j = 0; j < 16; ++j) s += (v[j][0] * v[j][0] + v[j][1] * v[j][1]) + (v[j][2] * v[j][2] + v[j][3] * v[j][3]);
                const float rstd = __builtin_amdgcn_rsqf(wave_sum(s) * (1.0f / DM) + EPS);
#pragma unroll
                for (int j = 0; j < 16; ++j) { const f32x4 y = v[j] * rstd * gv[j];
                    u32x2 o; o.x = cvt_pk_bf16(y[0], y[1]); o.y = cvt_pk_bf16(y[2], y[3]); *(u32x2*)(XN + (size_t)m * DM + 256 * j + 4 * lane) = o; }
#pragma unroll
                for (int j = 0; j < 16; ++j) v[j] = vn[j];
            }
        }
    }
    xcd_barrier(bar, wave == 0 && fresh_lane() == 0);
    if (TPROBE != 0 && wave == 0 && fresh_lane() == 0) { volatile LAS unsigned long long* stw = (volatile LAS unsigned long long*)(lds + 143424); stw[16 + 1] = (unsigned long long)wall_clock64(); }

    AP = argp();
    REPS(2) {
        {
            const int lane = fresh_lane(), fr = lane & 15, fq = lane >> 4;
            {
                const int tid = wave * 64 + lane; u32x4 wreg[16];
#pragma unroll
                for (int i = 0; i < 16; ++i) wreg[i] = *(const u32x4*)(WI + (size_t)(PW + 3 * AW + i) * DM + tid * 8);
#pragma unroll
                for (int i = 0; i < 16; ++i) *(LAS u32x4*)(lds + i * 8208 + tid * 16) = wreg[i];
                __syncthreads();
            }
            f32x4 pend = {0.f, 0.f, 0.f, 0.f}; size_t poff = 0; bool hp = false;
            for (int t = gw; t < (M / 16) * 4; t += NGW) {
                const int rg = t >> 2, kq = t & 3;
                const bf16_t* xa = XN + (size_t)(rg * 16 + fr) * DM + kq * 1024 + 8 * fq;
                const LAS unsigned char* wl = lds + fr * 8208 + (kq * 1024 + 8 * fq) * 2;
                bf16x8 xr[32];
#pragma unroll
                for (int k = 0; k < 32; ++k) xr[k] = *(const bf16x8*)(xa + 32 * k);
                asm volatile("" ::: "memory");
                if (hp) *(f32x4*)(FL + poff) = pend;
                f32x4 acc = {0.f, 0.f, 0.f, 0.f}, acc1 = acc;
#pragma unroll
                for (int k = 0; k < 32; k += 2) { const bf16x8 wv = *(const LAS bf16x8*)(wl + 64 * k), wv1 = *(const LAS bf16x8*)(wl + 64 * k + 64);
                    acc = __builtin_amdgcn_mfma_f32_16x16x32_bf16(xr[k], wv, acc, 0, 0, 0);
                    acc1 = __builtin_amdgcn_mfma_f32_16x16x32_bf16(xr[k + 1], wv1, acc1, 0, 0, 0); }
                pend = acc + acc1; poff = (size_t)(kq * NH + fr) * M + rg * 16 + 4 * fq; hp = true;
            }
            if (hp) *(f32x4*)(FL + poff) = pend;
            __syncthreads();
        }
        pg8::Gemm g{XN, WI, M, PP, DM, DM, 1 << 30}; pg8::SplitOrder S; S.init(M, PP, DM, G, bx, PART, ctl + CW_SPLIT + (0 + 4 * rep_) * 8192); if (S.r && S.nfull == 32 * S.nN && (S.nN & 15) == 0) S.mode = 1;
        pg8::EpiProj E{PROJ, AP->q_norm_g, AP->k_norm_g, (LAS float*)(lds + 131072), out};
        const int ncls = (S.r && G == 256) ? S.nfull / G + 1 : 1, cls = (bx >> 3) % ncls;
#pragma unroll 1
        for (int seg = 0; seg < 2; ++seg) {
            S.ibeg = seg == 0 ? 0 : cls; S.iend = seg == 0 ? cls : (1 << 30);
            pg8::gemm_phase<pg8::EpiProj, pg8::SplitOrder>(lds, g, S, E, wave, seg == 1);
            if (seg == 0) {
                const int lane = fresh_lane(); LAS unsigned* scr = (LAS unsigned*)(lds + wave * TR_LDS);
                constexpr int I_U = (DM / 64) * (DFF / 64), I_D = (DFF / 64) * (DM / 64);
                transpose_stream([&](int it) { TrTile t;
                    t.kscale = nullptr;
                    if (it < I_U) { const int x = it % (DFF / 64); t.kscale = AP->mlp_norm_g; t.W = AP->w_up; t.WT = WU; t.K = DM; t.N = DFF; t.kb = it / (DFF / 64); t.nb = ((x & 7) << 5) | (x >> 3); }
                    else { const int r = it - I_U, x = r % (DM / 64); t.W = AP->w_down; t.WT = WD; t.K = DFF; t.N = DM; t.kb = r / (DM / 64); t.nb = ((x & 7) << 3) | (x >> 3); }
                    return t; }, gw, NGW, I_U + I_D, scr, lane);
                asm volatile("s_waitcnt vmcnt(0) lgkmcnt(0)" ::: "memory"); __syncthreads();
            }
        }
    }
    xcd_barrier(bar, wave == 0 && fresh_lane() == 0);
    if (TPROBE != 0 && wave == 0 && fresh_lane() == 0) { volatile LAS unsigned long long* stw = (volatile LAS unsigned long long*)(lds + 143424); stw[16 + 2] = (unsigned long long)wall_clock64(); }

    AP = argp();
    {
        const int lane = fresh_lane(), tid = wave * 64 + lane;
        const bool solo = G >= 64;
        const bool worker = !(solo && vcu < 32);
        const int gw2 = solo ? (vcu - 32) * 8 + wave : gw, NGW2 = solo ? (G - 32) * 8 : NGW;
#define FLS(tok, h) ((FL[(size_t)(h) * M + (tok)] + FL[(size_t)(NH + (h)) * M + (tok)]) + (FL[(size_t)(2 * NH + (h)) * M + (tok)] + FL[(size_t)(3 * NH + (h)) * M + (tok)]))
        if (vcu < 16) {
            const int h = vcu; LAS float* cl = (LAS float*)lds; LAS double* wtot = (LAS double*)(lds + 65536);
            const float bf = AP->b_f[h]; float lf[16]; double run = 0.0;
            float thr = 0.f;
            if (tid < 64) { float gq = fmaxf(fabsf(AP->q_norm_g[tid]), fabsf(AP->q_norm_g[tid + 64])), gk = fmaxf(fabsf(AP->k_norm_g[tid]), fabsf(AP->k_norm_g[tid + 64]));
                gq = wave_max(gq); gk = wave_max(gk); thr = -(2.f * 11.3137085f * gq * gk + PRUNE_T); }
#pragma unroll
            for (int i = 0; i < 16; ++i) lf[i] = FLS(i * 512 + tid, h);
#pragma unroll
            for (int i = 0; i < 16; ++i) { const int tok = i * 512 + tid; const float v = log_sigmoid(lf[i] + bf); out[O_FP + (size_t)tok * NH + h] = v; cl[tok + (tok >> 4)] = v; }
            __syncthreads();
#pragma unroll
            for (int j = 0; j < 16; ++j) { lf[j] = cl[tid * 17 + j]; run += (double)lf[j]; }
            double inc = run;
#pragma unroll
            for (int d = 1; d < 64; d <<= 1) { const int src = ((lane - d) & 63) << 2;
                const int lo = __builtin_amdgcn_ds_bpermute(src, __double2loint(inc)), hi = __builtin_amdgcn_ds_bpermute(src, __double2hiint(inc));
                if (lane >= d) inc += __hiloint2double(hi, lo); }
            if (lane == 63) wtot[wave] = inc;
            __syncthreads();
            double c = inc - run; for (int w = 0; w < wave; ++w) c += wtot[w];
#pragma unroll
            for (int j = 0; j < 16; ++j) { c += (double)lf[j]; cl[tid * 17 + j] = (float)c; }
            __syncthreads();
#pragma unroll
            for (int i = 0; i < 16; ++i) { const int tok = i * 512 + tid; CB[(size_t)h * SEQ + tok] = cl[tok + (tok >> 4)] * LOG2E; }
            if (tid < 64) {
                if (tid < 32) { const int qb = tid; const float cP = cl[qb * 256 + qb * 16]; int lo = 0, hi = 4 * qb;
                    while (lo < hi) { const int mid = (lo + hi) >> 1, t = 64 * mid + 63; if ((cP - cl[t + (t >> 4)]) < thr) lo = mid + 1; else hi = mid; }
                    JLO[h * 32 + qb] = lo; }
            }
            __syncthreads();
        } else if (vcu < 32) {
            const int b = vcu - 16, h = tid & 15, seg = tid >> 4;
            LAS float* Lc = (LAS float*)lds; LAS double* tot = (LAS double*)(lds + 135424); LAS float* lnew = (LAS float*)(lds + 139520);
            const float* lsrc = AP->cache_logf + ((size_t)b * PAST + seg * 64) * NH + h;
            float lv[64];
#pragma unroll
            for (int j = 0; j < 64; ++j) lv[j] = lsrc[(size_t)j * NH];
            const float bf = AP->b_f[h];
            const float lmine = log_sigmoid(FLS(MP + b * DS + seg, h) + bf);
            out[O_FS + (size_t)(b * DS + seg) * NH + h] = lmine; lnew[seg * 16 + h] = lmine;
            double run = 0.0;
#pragma unroll
            for (int j = 0; j < 64; ++j) run += (double)lv[j];
            tot[tid] = run; __syncthreads();
            double c = 0.0, ctot = 0.0, cn = 0.0;
#pragma unroll
            for (int s = 0; s < 32; ++s) { const double v = tot[s * 16 + h]; ctot += v; if (s < seg) c += v; const double n = (double)lnew[s * 16 + h]; if (s <= seg) cn += n; }
            const double cref = ctot + (double)lnew[h];
            LAS float* rowp = Lc + h * 2116 + seg * 65;
#pragma unroll
            for (int j = 0; j < 64; ++j) { c += (double)lv[j]; rowp[j] = (float)(cref - c) * LOG2E; }
            Lc[h * 2116 + 2080 + seg] = (float)(cref - (ctot + cn)) * LOG2E;
            __syncthreads();
            float* csd = CS + (size_t)b * NH * 2080;
#pragma unroll 4
            for (int hh = 0; hh < NH; ++hh)
                for (int p = tid; p < 2080; p += 512) csd[hh * 2080 + p] = Lc[hh * 2116 + p + (p >> 6)];
            __syncthreads();
        }
#undef FLS
        if (worker) {
        for (int task = gw2; task < (M / 16) * 4; task += NGW2) {
            const int g = task < 3 * (M / 16) ? 1 + task / (M / 16) : 0, r0 = (task % (M / 16)) * 16;
            if (g == 0) pool_task16<2>(PROJ, AP->state_pool, DP, r0, 0, lane);
            else if (g == 1) pool_task16<4>(PROJ, AP->state_pool, DP, r0, 1, lane);
            else if (g == 2) pool_task16<8>(PROJ, AP->state_pool, DP, r0, 2, lane);
            else pool_task16<16>(PROJ, AP->state_pool, DP, r0, 3, lane);
        }
        for (int t = gw2 + (((M / 16) * 4 - gw2 + NGW2 - 1) / NGW2) * NGW2 - (M / 16) * 4; t < PH * (1 + DB); t += NGW2) {
            const int s = t / PH, j = t % PH;
            const int row = (s == 0) ? (MP - PH + j) : (MP + (s - 1) * DS + (DS - PH) + j);
            float* dst = (s == 0) ? out + O_HP + (size_t)j * PW : out + O_HS + ((size_t)(s - 1) * PH + j) * PW;
            u32x4 wr4[4];
#pragma unroll
            for (int i = 0; i < 4; ++i) wr4[i] = *(const u32x4*)(PROJ + (size_t)row * PP + 32 * lane + 8 * i);
#pragma unroll
            for (int i = 0; i < 4; ++i) { const u32x4 wv = wr4[i];
                *(f32x4*)(dst + 32 * lane + 8 * i) = (f32x4){bf_lo(wv[0]), bf_hi(wv[0]), bf_lo(wv[1]), bf_hi(wv[1])};
                *(f32x4*)(dst + 32 * lane + 8 * i + 4) = (f32x4){bf_lo(wv[2]), bf_hi(wv[2]), bf_lo(wv[3]), bf_hi(wv[3])}; }
        }
        }
    }
    xcd_barrier(bar, wave == 0 && fresh_lane() == 0);
    if (TPROBE != 0 && wave == 0 && fresh_lane() == 0) { volatile LAS unsigned long long* stw = (volatile LAS unsigned long long*)(lds + 143424); stw[16 + 3] = (unsigned long long)wall_clock64(); }

    AP = argp();
    REPS(3) {
        const int cls3 = (G == 256) ? (vcu >> 4) % 3 : 2;
#define SAMP_JOB() do { for (int u = vcu; u < DB * NH; u += G) att::samp_unit(u >> 4, u & 15, PROJ, AP->cache_k, AP->cache_v, CS, MIX, (att::lptr)lds, wave); \
                        asm volatile("s_waitcnt vmcnt(0)" ::: "memory"); __syncthreads(); } while (0)
        if (cls3 == 0) SAMP_JOB();
        {
            const int l3 = bx >> 3, cpool = (G == 256) ? (bx & 7) + 8 * (l3 == 0 ? 0 : l3 == 16 ? 1 : l3 < 16 ? l3 + 1 : l3) : bx;
            pg8::Gemm g{DP, WP, M, PW, PG, PW, 2}; pg8::SplitOrder S; S.init(M, PW, PG, G, cpool, nullptr, nullptr);
            pg8::EpiPool E{MIX, AP->pool_scale};
            pg8::gemm_phase<pg8::EpiPool, pg8::SplitOrder>(lds, g, S, E, wave);
        }
        if (cls3 == 1) SAMP_JOB();
        {
            int nblk = 0; for (int it = vcu; it < 256; it += G) nblk += 2;
            auto ref = [&](int i) { const int item = vcu + (i >> 1) * G, h = item >> 4, x = item & 15, qb = (i & 1) ? 31 - x : x;
                att::Blk r; r.h = h; r.qb = qb; r.jlo = JLO[h * 32 + qb]; return r; };
            if (nblk > 0) {
                att::Seam S; att::Blk cur = ref(0);
                att::attn_prime(cur, PROJ, (att::lptr)lds, S, wave);
                for (int i = 0; i < nblk; ++i) { const att::Blk nxt = (i + 1 < nblk) ? ref(i + 1) : cur; att::attn_block(cur, nxt, PROJ, MIX, CB, (att::lptr)lds, S, wave); cur = nxt; }
            }
            asm volatile("s_waitcnt vmcnt(0)" ::: "memory"); __syncthreads();
        }
        if (cls3 == 2) SAMP_JOB();
#undef SAMP_JOB
    }
    xcd_barrier(bar, wave == 0 && fresh_lane() == 0);
    if (TPROBE != 0 && wave == 0 && fresh_lane() == 0) { volatile LAS unsigned long long* stw = (volatile LAS unsigned long long*)(lds + 143424); stw[16 + 4] = (unsigned long long)wall_clock64(); }

    AP = argp();
    REPS(6) {
        pg8::Gemm g{MIX, WO, M, DM, DM, DM, 1 << 30}; pg8::SplitOrder S; S.init(M, DM, DM, G, bx, PART, ctl + CW_SPLIT + (1 + 4 * rep_) * 8192); if (S.r && S.nfull == 32 * S.nN && (S.nN & 15) == 0) S.mode = 1; if (S.r) S.plast = (bx / S.s) & 1;
        pg8::EpiOut E{AP->x_prompt, AP->x_sample, X1G, rep_ ? RSS + 16384 : RSS};
        pg8::gemm_phase<pg8::EpiOut, pg8::SplitOrder>(lds, g, S, E, wave);
    }
    xcd_barrier(bar, wave == 0 && fresh_lane() == 0);
    if (TPROBE != 0 && wave == 0 && fresh_lane() == 0) { volatile LAS unsigned long long* stw = (volatile LAS unsigned long long*)(lds + 143424); stw[16 + 5] = (unsigned long long)wall_clock64(); }

    AP = argp();
    REPS(7) {
        pg8::Gemm g{X1G, WU, M, DFF, DM, DM, 1 << 30}; pg8::SplitOrder S; S.init(M, DFF, DM, G, bx, PART, ctl + CW_SPLIT + (2 + 4 * rep_) * 8192); if (S.r && S.nfull == 32 * S.nN && (S.nN & 15) == 0) S.mode = 1; if (S.r) S.plast = (bx / S.s) & 1;
        pg8::EpiUp E{HID, RSS, (LAS float*)(lds + 131072)};
        const unsigned long long tw0_ = (TPROBE != 0) ? wall_clock64() : 0ull;
        pg8::gemm_phase<pg8::EpiUp, pg8::SplitOrder, (TPROBE != 0)>(lds, g, S, E, wave);
        if (TPROBE != 0 && wave == 0 && fresh_lane() == 0) {
            const unsigned dt = (unsigned)(wall_clock64() - tw0_);
            atomicMax(ctl + 200000, dt); atomicMax(ctl + 200064, 0xffffffffu - dt); atomicAdd(ctl + 200128, dt);
            atomicMax((unsigned long long*)(ctl + 200192), ((unsigned long long)dt << 32) | (unsigned)bx);
        }
    }
    xcd_barrier(bar, wave == 0 && fresh_lane() == 0);
    if (TPROBE != 0 && wave == 0 && fresh_lane() == 0) { volatile LAS unsigned long long* stw = (volatile LAS unsigned long long*)(lds + 143424); stw[16 + 6] = (unsigned long long)wall_clock64(); }

    AP = argp();
    REPS(8) {
        pg8::Gemm g{HID, WD, M, DM, DFF, DFF, 1 << 30}; pg8::SplitOrder S; S.init(M, DM, DFF, G, bx, PART, ctl + CW_SPLIT + (3 + 4 * rep_) * 8192); if (S.r && S.nfull == 32 * S.nN && (S.nN & 15) == 0) S.mode = 1; if (S.r) S.plast = (bx / S.s) & 1;
        pg8::EpiDown E{X1G, rep_ ? (float*)(ws + WS_END) : out};
        pg8::gemm_phase<pg8::EpiDown, pg8::SplitOrder>(lds, g, S, E, wave);
    }
    if (TPROBE != 0 && bx == 0 && wave == 0) {
        volatile LAS unsigned long long* stw = (volatile LAS unsigned long long*)(lds + 143424);
        const unsigned long long c0 = stw[0], w0 = stw[1], c1 = stw[2], w1 = stw[3], c2 = stw[4], w2 = stw[5];
        unsigned long long D = 0;
        if (TPROBE == 1) D = (c1 - c0) / 64 * 40;
        if (TPROBE == 2) D = (c1 - c0) * 1000 / (w1 - w0) * 50;
        if (TPROBE == 2) D /= 1000 / 100;
        if (TPROBE == 3) D = (c2 - c1);
        if (TPROBE == 4) D = (w1 - w0) * 10;
        if (TPROBE == 20) D = __hip_atomic_load(ctl + 200000, __ATOMIC_RELAXED, __HIP_MEMORY_SCOPE_AGENT);
        if (TPROBE == 21) D = 0xffffffffu - __hip_atomic_load(ctl + 200064, __ATOMIC_RELAXED, __HIP_MEMORY_SCOPE_AGENT);
        if (TPROBE == 22) D = __hip_atomic_load(ctl + 200128, __ATOMIC_RELAXED, __HIP_MEMORY_SCOPE_AGENT) / 256;
        if (TPROBE == 23) D = (__hip_atomic_load((unsigned long long*)(ctl + 200192), __ATOMIC_RELAXED, __HIP_MEMORY_SCOPE_AGENT) & 0xffffffffull) * 1000;
        if (TPROBE == 5) D = (stw[9] - stw[7]);
        if (TPROBE >= 10 && TPROBE < 17) { const int k = TPROBE - 10; const unsigned long long mul[7] = {5, 2, 5, 5, 2, 1, 1}; D = (k < 6 ? stw[17 + k] - stw[16 + k] : wall_clock64() - stw[22]) * mul[k]; }
        const unsigned long long t0 = wall_clock64();
        if (D > 400000) D = 400000;
        while (wall_clock64() - t0 < D) __builtin_amdgcn_s_sleep(8);
    }
}

extern "C" void kernel_launch(void* const* d_in, const int* in_sizes, int n_in, void* d_out, int out_size, void* d_ws, size_t ws_size, hipStream_t stream) {
    static int grid = 0;
    if (grid == 0) {
        if (n_in != 17 || in_sizes[0] != MP * DM || (size_t)out_size != O_END || ws_size < WS_END + (PROBE == 8 ? (size_t)M * DM * 4 : 0)) {
            fprintf(stderr, "kernel_launch: shape mismatch (n_in %d, in0 %d, out %d, ws %zu; need 17, %d, %zu, >= %zu)\n", n_in, n_in > 0 ? in_sizes[0] : -1, out_size, ws_size, MP * DM, (size_t)O_END, (size_t)WS_END);
            grid = -1; return; }
        int dev = 0, cus = 0, per_cu = 0;
        if (hipGetDevice(&dev) != hipSuccess || hipDeviceGetAttribute(&cus, hipDeviceAttributeMultiprocessorCount, dev) != hipSuccess) { grid = -1; return; }
        if (hipFuncSetAttribute((const void*)hymba_fwd, hipFuncAttributeMaxDynamicSharedMemorySize, LDS_BYTES) != hipSuccess) { fprintf(stderr, "kernel_launch: hipFuncSetAttribute failed\n"); grid = -1; return; }
        if (hipOccupancyMaxActiveBlocksPerMultiprocessor(&per_cu, (const void*)hymba_fwd, 512, LDS_BYTES) != hipSuccess || per_cu < 1) { fprintf(stderr, "kernel_launch: occupancy query says %d\n", per_cu); }
        (void)hipGetLastError();
        grid = cus;
    }
    if (grid < 0) return;
    if (hipMemsetAsync((char*)d_ws + WS_CTL, 0, CTL_ZERO_BYTES, stream) != hipSuccess) { fprintf(stderr, "kernel_launch: memset failed\n"); return; }
    Args a{};
    a.x_prompt = (const float*)d_in[0]; a.x_sample = (const float*)d_in[1]; a.cache_k = (const float*)d_in[2]; a.cache_v = (const float*)d_in[3]; a.cache_logf = (const float*)d_in[4];
    a.state_pool = (const float*)d_in[5]; a.attn_norm_g = (const float*)d_in[6]; a.w_in = (const float*)d_in[7]; a.b_f = (const float*)d_in[8]; a.q_norm_g = (const float*)d_in[9];
    a.k_norm_g = (const float*)d_in[10]; a.w_pool = (const float*)d_in[11]; a.pool_scale = (const float*)d_in[12]; a.w_out = (const float*)d_in[13]; a.mlp_norm_g = (const float*)d_in[14];
    a.w_up = (const float*)d_in[15]; a.w_down = (const float*)d_in[16];
    a.out = (float*)d_out; a.ws = (unsigned char*)d_ws;
    hipLaunchKernelGGL(hymba_fwd, dim3(grid), dim3(512), LDS_BYTES, stream, a);
    const hipError_t le = hipPeekAtLastError();
    if (le != hipSuccess) fprintf(stderr, "kernel_launch: launch failed: %s\n", hipGetErrorName(le));
}
```
